# Optimizing an MI355X kernel written in HIP

```python
import math
import jax
import jax.numpy as jnp
from jax import lax
import numpy as np

D_MODEL = 1024
BATCH = 8
SEQ = 8192
DEPTH = 2

GRID_W = 64
HEAD_DIM = 64
Q_BLOCK = 128
EPS = 1e-6
A_Q_HEADS = 8
A_KV_HEADS = 2
ROPE_THETA = 10000.0
B_HEADS = 4
B_HEAD_DIM = 128
B_CHUNK = 128
C_HEADS = 8
NA_ROWS = 8
NA_COLS = 16
D_HEADS = 4
D_QK_DIM = 64
D_V_DIM = 2 * D_QK_DIM
T5_BUCKETS = 32
T5_MAX_DIST = 128
MEM_LEN = 256
CA_HEADS = 4
CA_HEAD_DIM = 128
D_FF = 2816
CONV_W = 3

EV_SIZES = (A_Q_HEADS * HEAD_DIM, A_KV_HEADS * HEAD_DIM, A_KV_HEADS * HEAD_DIM,
            B_HEADS * B_HEAD_DIM, B_HEADS * B_HEAD_DIM, B_HEADS * B_HEAD_DIM, B_HEADS * B_HEAD_DIM,
            4 * B_HEADS)
OD_SIZES = (C_HEADS * HEAD_DIM, C_HEADS * HEAD_DIM, C_HEADS * HEAD_DIM,
            2 * D_HEADS * D_QK_DIM, 2 * D_HEADS * D_QK_DIM, D_HEADS * D_V_DIM)
EV_MIX = A_Q_HEADS * HEAD_DIM + B_HEADS * B_HEAD_DIM
OD_MIX = C_HEADS * HEAD_DIM + D_HEADS * D_V_DIM

kernel_name = "hybrid_bidir_grid_encoder"


def rms_norm(x, gain):
    xf = x.astype(jnp.float32)
    y = xf * lax.rsqrt(jnp.mean(xf * xf, axis=-1, keepdims=True) + EPS)
    return (y * gain.astype(jnp.float32)).astype(x.dtype)


def heads(t, n_heads):
    b, n, _ = t.shape
    return t.reshape(b, n, n_heads, -1).transpose(0, 2, 1, 3)


def merge(t):
    b, h, n, d = t.shape
    return t.transpose(0, 2, 1, 3).reshape(b, n, h * d)


def split_cols(t, sizes):
    return jnp.split(t, np.cumsum(sizes)[:-1].tolist(), axis=-1)


def rope_1d(t, pos):
    d = t.shape[-1]
    inv = ROPE_THETA ** (-jnp.arange(0, d, 2, dtype=jnp.float32) / d)
    ang = pos.astype(jnp.float32)[:, None] * inv[None, :]
    cos, sin = jnp.cos(ang), jnp.sin(ang)
    t1, t2 = jnp.split(t.astype(jnp.float32), 2, axis=-1)
    return jnp.concatenate([t1 * cos - t2 * sin, t1 * sin + t2 * cos], axis=-1)


def axial_rope(t, rows, cols):
    half = t.shape[-1] // 2
    out = jnp.concatenate([rope_1d(t[..., :half], rows), rope_1d(t[..., half:], cols)], axis=-1)
    return out.astype(t.dtype)


def t5_bucket(rel):
    nb = T5_BUCKETS // 2
    max_exact = nb // 2
    n = jnp.abs(rel)
    log_ratio = jnp.log(jnp.maximum(n, 1).astype(jnp.float32) / max_exact) / math.log(T5_MAX_DIST / max_exact)
    large = jnp.minimum(max_exact + (log_ratio * (nb - max_exact)).astype(jnp.int32), nb - 1)
    return jnp.where(rel > 0, nb, 0) + jnp.where(n < max_exact, n, large)


def gqa_attention(q, k, v):
    b, hq, n, d = q.shape
    hkv = k.shape[1]
    rep = hq // hkv
    nb = n // Q_BLOCK
    qb = q.reshape(b, hkv, rep, nb, Q_BLOCK, d).transpose(3, 0, 1, 2, 4, 5)

    def block(qi):
        sc = jnp.einsum('bgrqd,bgkd->bgrqk', qi, k, preferred_element_type=jnp.float32)
        p = jax.nn.softmax(sc, axis=-1).astype(v.dtype)
        return jnp.einsum('bgrqk,bgkd->bgrqd', p, v)

    out = lax.map(block, qb)
    return out.transpose(1, 2, 3, 0, 4, 5).reshape(b, hq, n, d)


def mlstm_chunkwise(q, k, v, ig, lf):
    b, h, n, dk = q.shape
    dv = v.shape[-1]
    L = B_CHUNK
    nc = n // L

    def to_chunks(t):
        t = t.astype(jnp.float32)
        return jnp.moveaxis(t.reshape((b, h, nc, L) + t.shape[3:]), 2, 0)

    xs = (to_chunks(q), to_chunks(k), to_chunks(v), to_chunks(ig), to_chunks(lf))
    tril = jnp.tril(jnp.ones((L, L), dtype=bool))

    def step(carry, inp):
        c_st, n_st, m_st = carry
        qc, kc, vc, ic, fc = inp
        bcum = jnp.cumsum(fc, axis=-1)
        g = bcum[..., -1]
        log_d = jnp.where(tril, bcum[..., :, None] - bcum[..., None, :] + ic[..., None, :], -jnp.inf)
        m_inter = bcum + m_st[..., None]
        m_t = jnp.maximum(jnp.max(log_d, axis=-1), m_inter)
        dmat = jnp.exp(log_d - m_t[..., None])
        sc = jnp.einsum('bhtd,bhsd->bhts', qc, kc) * dmat
        inter = jnp.exp(m_inter - m_t)
        num = jnp.einsum('bhts,bhsv->bhtv', sc, vc) + inter[..., None] * jnp.einsum('bhtd,bhdv->bhtv', qc, c_st)
        den = jnp.sum(sc, axis=-1) + inter * jnp.einsum('bhtd,bhd->bht', qc, n_st)
        h_out = num / jnp.maximum(jnp.abs(den), jnp.exp(-m_t))[..., None]
        a = g[..., None] - bcum + ic
        m_new = jnp.maximum(g + m_st, jnp.max(a, axis=-1))
        w = jnp.exp(a - m_new[..., None])
        decay = jnp.exp(g + m_st - m_new)
        c_new = decay[..., None, None] * c_st + jnp.einsum('bhs,bhsd,bhsv->bhdv', w, kc, vc)
        n_new = decay[..., None] * n_st + jnp.einsum('bhs,bhsd->bhd', w, kc)
        return (c_new, n_new, m_new), h_out

    init = (jnp.zeros((b, h, dk, dv), jnp.float32), jnp.zeros((b, h, dk), jnp.float32),
            jnp.zeros((b, h), jnp.float32))
    _, hs = lax.scan(step, init, xs)
    return jnp.moveaxis(hs, 0, 2).reshape(b, h, n, dv)


def neighbourhood_attention(q, k, v, rpb):
    b, h, n, d = q.shape
    rows = n // GRID_W
    kr = min(NA_ROWS, rows)
    kc = NA_COLS
    kg = k.reshape(b, h, rows, GRID_W, d)
    vg = v.reshape(b, h, rows, GRID_W, d)
    qg = jnp.moveaxis(q.reshape(b, h, rows, GRID_W, d), 2, 0)
    col = jnp.arange(GRID_W)
    c0 = jnp.clip(col - kc // 2, 0, GRID_W - kc)
    in_win = (col[None, :] >= c0[:, None]) & (col[None, :] < c0[:, None] + kc)
    dc_idx = jnp.clip(col[None, :] - col[:, None] + NA_COLS - 1, 0, 2 * NA_COLS - 2)
    table = rpb.astype(jnp.float32)

    def row_block(args):
        r, qr = args
        r0 = jnp.clip(r - kr // 2, 0, rows - kr)
        kb = lax.dynamic_slice_in_dim(kg, r0, kr, axis=2).reshape(b, h, kr * GRID_W, d)
        vb = lax.dynamic_slice_in_dim(vg, r0, kr, axis=2).reshape(b, h, kr * GRID_W, d)
        dr_idx = r0 + jnp.arange(kr) - r + NA_ROWS - 1
        bias = table[:, dr_idx[:, None, None], dc_idx[None, :, :]]
        bias = jnp.where(in_win[None, None], bias, -jnp.inf)
        bias = bias.transpose(0, 2, 1, 3).reshape(h, GRID_W, kr * GRID_W)
        sc = jnp.einsum('bhqd,bhkd->bhqk', qr, kb, preferred_element_type=jnp.float32) + bias
        p = jax.nn.softmax(sc, axis=-1).astype(vb.dtype)
        return jnp.einsum('bhqk,bhkd->bhqd', p, vb)

    out = lax.map(row_block, (jnp.arange(rows), qg))
    return jnp.moveaxis(out, 0, 2).reshape(b, h, n, d)


def differential_attention(q1, q2, k1, k2, v, lam, t5_table):
    b, h, n, d = q1.shape
    nb = n // Q_BLOCK
    kpos = jnp.arange(n)
    table = t5_table.astype(jnp.float32)

    def blocks(t):
        return jnp.moveaxis(t.reshape(b, h, nb, Q_BLOCK, d), 2, 0)

    def block(args):
        i, a1, a2 = args
        qpos = i * Q_BLOCK + jnp.arange(Q_BLOCK)
        bias = table[t5_bucket(kpos[None, :] - qpos[:, None])].transpose(2, 0, 1)
        s1 = jnp.einsum('bhqd,bhkd->bhqk', a1, k1, preferred_element_type=jnp.float32) + bias
        s2 = jnp.einsum('bhqd,bhkd->bhqk', a2, k2, preferred_element_type=jnp.float32) + bias
        p = jax.nn.softmax(s1, axis=-1) - lam * jax.nn.softmax(s2, axis=-1)
        return jnp.einsum('bhqk,bhkd->bhqd', p.astype(v.dtype), v)

    out = lax.map(block, (jnp.arange(nb), blocks(q1), blocks(q2)))
    return jnp.moveaxis(out, 0, 2).reshape(b, h, n, v.shape[-1])


def even_mixer(h, w_in, gate_bias, attn_qk_gain, mlstm_gain, w_out):
    b, n, _ = h.shape
    pos = jnp.arange(n)
    rows, cols = pos // GRID_W, pos % GRID_W
    qa, ka, va, qm, km, vm, om, gates = split_cols(h @ w_in, EV_SIZES)
    qa = axial_rope(rms_norm(heads(qa, A_Q_HEADS), attn_qk_gain[0]), rows, cols) * (HEAD_DIM ** -0.5)
    ka = axial_rope(rms_norm(heads(ka, A_KV_HEADS), attn_qk_gain[1]), rows, cols)
    ya = gqa_attention(qa, ka, heads(va, A_KV_HEADS))
    qm = heads(qm, B_HEADS)
    km = heads(km, B_HEADS) * (B_HEAD_DIM ** -0.5)
    vm = heads(vm, B_HEADS)
    g = (gates.astype(jnp.float32) + gate_bias.astype(jnp.float32)).reshape(b, n, 4, B_HEADS).transpose(2, 0, 3, 1)
    h_fwd = mlstm_chunkwise(qm, km, vm, g[0], jax.nn.log_sigmoid(g[1]))
    flip = lambda t: jnp.flip(t, axis=2)
    h_bwd = flip(mlstm_chunkwise(flip(qm), flip(km), flip(vm), flip(g[2]), flip(jax.nn.log_sigmoid(g[3]))))
    hm = rms_norm(h_fwd + h_bwd, mlstm_gain.reshape(B_HEADS, 1, B_HEAD_DIM)).astype(h.dtype)
    ym = hm * jax.nn.sigmoid(heads(om, B_HEADS))
    return jnp.concatenate([merge(ya), merge(ym)], axis=-1) @ w_out


def odd_mixer(h, w_in, na_qk_gain, na_rpb, diff_qk_gain, diff_lambda, diff_gain, w_out, t5_table, layer_idx):
    b, n, _ = h.shape
    qc, kc, vc, qd, kd, vd = split_cols(h @ w_in, OD_SIZES)
    qc = rms_norm(heads(qc, C_HEADS), na_qk_gain[0]) * (HEAD_DIM ** -0.5)
    kc = rms_norm(heads(kc, C_HEADS), na_qk_gain[1])
    yc = neighbourhood_attention(qc, kc, heads(vc, C_HEADS), na_rpb)
    def pair_heads(t):
        return t.reshape(b, n, D_HEADS, 2, D_QK_DIM).transpose(3, 0, 2, 1, 4)
    q12 = rms_norm(pair_heads(qd), diff_qk_gain[0]) * (D_QK_DIM ** -0.5)
    k12 = rms_norm(pair_heads(kd), diff_qk_gain[1])
    lam_init = 0.8 - 0.6 * math.exp(-0.3 * layer_idx)
    lv = diff_lambda.astype(jnp.float32)
    lam = jnp.exp(jnp.sum(lv[0] * lv[1])) - jnp.exp(jnp.sum(lv[2] * lv[3])) + lam_init
    yd = differential_attention(q12[0], q12[1], k12[0], k12[1], heads(vd, D_HEADS), lam, t5_table)
    yd = rms_norm(yd, diff_gain.reshape(D_HEADS, 1, D_V_DIM)) * (1.0 - lam_init)
    return jnp.concatenate([merge(yc), merge(yd)], axis=-1) @ w_out


def memory_cross_attention(h, m, w_q, w_kv, qk_gain, w_o):
    q = rms_norm(heads(h @ w_q, CA_HEADS), qk_gain[0]) * (CA_HEAD_DIM ** -0.5)
    k, v = jnp.split(m @ w_kv, 2, axis=-1)
    k = rms_norm(heads(k, CA_HEADS), qk_gain[1])
    v = heads(v, CA_HEADS)
    sc = jnp.einsum('bhqd,bhkd->bhqk', q, k, preferred_element_type=jnp.float32)
    p = jax.nn.softmax(sc, axis=-1).astype(v.dtype)
    return merge(jnp.einsum('bhqk,bhkd->bhqd', p, v)) @ w_o


def conv_ffn(h, w_up, conv_w, conv_b, w_down):
    n = h.shape[1]
    u = h @ w_up
    half = CONV_W // 2
    u_pad = jnp.pad(u, ((0, 0), (half, half), (0, 0)))
    c = conv_b + u_pad[:, 0:n] * conv_w[0]
    for j in range(1, CONV_W):
        c = c + u_pad[:, j:j + n] * conv_w[j]
    gate, val = jnp.split(c, 2, axis=-1)
    return (jax.nn.silu(gate) * val) @ w_down


def setup_inputs(seed: int = 0) -> dict:
    key = jax.random.key(seed)
    ks = iter(jax.random.split(key, 40))
    ne, no = (DEPTH + 1) // 2, DEPTH // 2
    f32 = jnp.float32

    def nrm(shape, scale):
        return jax.random.normal(next(ks), shape, f32) * scale

    def gain(shape):
        return 1.0 + nrm(shape, 0.02)

    lin = jnp.linspace(3.0, 6.0, B_HEADS, dtype=f32)
    zero = jnp.zeros((B_HEADS,), f32)
    gate_base = jnp.stack([zero, lin, zero, lin]).reshape(-1)
    ev_in, od_in = sum(EV_SIZES), sum(OD_SIZES)
    return {
        "x": nrm((BATCH, SEQ, D_MODEL), 1.0),
        "mem": nrm((BATCH, MEM_LEN, D_MODEL), 1.0),
        "t5_table": nrm((T5_BUCKETS, D_HEADS), 0.1),
        "norm_mix": gain((DEPTH, D_MODEL)),
        "norm_cross": gain((DEPTH, D_MODEL)),
        "norm_mem": gain((DEPTH, D_MODEL)),
        "norm_ffn": gain((DEPTH, D_MODEL)),
        "ev_w_in": nrm((ne, D_MODEL, ev_in), D_MODEL ** -0.5),
        "ev_gate_bias": gate_base[None] + nrm((ne, 4 * B_HEADS), 0.1),
        "ev_attn_qk_gain": gain((ne, 2, HEAD_DIM)),
        "ev_mlstm_gain": gain((ne, B_HEADS * B_HEAD_DIM)),
        "ev_w_out": nrm((ne, EV_MIX, D_MODEL), EV_MIX ** -0.5),
        "od_w_in": nrm((no, D_MODEL, od_in), D_MODEL ** -0.5),
        "od_na_qk_gain": gain((no, 2, HEAD_DIM)),
        "od_na_rpb": nrm((no, C_HEADS, 2 * NA_ROWS - 1, 2 * NA_COLS - 1), 0.1),
        "od_diff_qk_gain": gain((no, 2, D_QK_DIM)),
        "od_diff_lambda": nrm((no, 4, D_QK_DIM), 0.1),
        "od_diff_gain": gain((no, D_HEADS * D_V_DIM)),
        "od_w_out": nrm((no, OD_MIX, D_MODEL), OD_MIX ** -0.5),
        "ca_w_q": nrm((DEPTH, D_MODEL, CA_HEADS * CA_HEAD_DIM), D_MODEL ** -0.5),
        "ca_w_kv": nrm((DEPTH, D_MODEL, 2 * CA_HEADS * CA_HEAD_DIM), D_MODEL ** -0.5),
        "ca_qk_gain": gain((DEPTH, 2, CA_HEAD_DIM)),
        "ca_w_o": nrm((DEPTH, CA_HEADS * CA_HEAD_DIM, D_MODEL), (CA_HEADS * CA_HEAD_DIM) ** -0.5),
        "ffn_w_up": nrm((DEPTH, D_MODEL, 2 * D_FF), D_MODEL ** -0.5),
        "ffn_conv_w": nrm((DEPTH, CONV_W, 2 * D_FF), CONV_W ** -0.5),
        "ffn_conv_b": nrm((DEPTH, 2 * D_FF), 0.02),
        "ffn_w_down": nrm((DEPTH, D_FF, D_MODEL), D_FF ** -0.5),
    }


def reference(x, mem, t5_table, norm_mix, norm_cross, norm_mem, norm_ffn,
              ev_w_in, ev_gate_bias, ev_attn_qk_gain, ev_mlstm_gain, ev_w_out,
              od_w_in, od_na_qk_gain, od_na_rpb, od_diff_qk_gain, od_diff_lambda, od_diff_gain, od_w_out,
              ca_w_q, ca_w_kv, ca_qk_gain, ca_w_o,
              ffn_w_up, ffn_conv_w, ffn_conv_b, ffn_w_down):
    for l in range(DEPTH):
        h = rms_norm(x, norm_mix[l])
        if l % 2 == 0:
            e = l // 2
            x = x + even_mixer(h, ev_w_in[e], ev_gate_bias[e], ev_attn_qk_gain[e], ev_mlstm_gain[e], ev_w_out[e])
        else:
            o = l // 2
            x = x + odd_mixer(h, od_w_in[o], od_na_qk_gain[o], od_na_rpb[o], od_diff_qk_gain[o],
                              od_diff_lambda[o], od_diff_gain[o], od_w_out[o], t5_table, l)
        x = x + memory_cross_attention(rms_norm(x, norm_cross[l]), rms_norm(mem, norm_mem[l]),
                                       ca_w_q[l], ca_w_kv[l], ca_qk_gain[l], ca_w_o[l])
        x = x + conv_ffn(rms_norm(x, norm_ffn[l]), ffn_w_up[l], ffn_conv_w[l], ffn_conv_b[l], ffn_w_down[l])
    return x
```

```cpp
#include <hip/hip_runtime.h>
#include <hip/hip_cooperative_groups.h>
#include <cstdio>
#include <cstdint>
namespace cg = cooperative_groups;
namespace pg8 {
#define PG8_LAS __attribute__((address_space(3)))
typedef unsigned short bf16_t;
typedef short bf16x8 __attribute__((ext_vector_type(8)));
typedef float f32x4 __attribute__((ext_vector_type(4)));
typedef unsigned u32x4 __attribute__((ext_vector_type(4)));
constexpr int BM = 256, BK = 64, HALF = 128, HTB = HALF * BK * 2  , STAGE_BYTES = 8 * HTB, NXCD = 8, WGM = 8;

__host__ __device__ __forceinline__ int lds_byte(int r, int c) { const int st = (r >> 4) * 2 + (c >> 5), rr = r & 15, cc = c & 31, ob = rr * 64 + cc * 2; return st * 1024 + (ob ^ (((ob >> 9) & 1) << 5)); }
__host__ __device__ __forceinline__ void stage_rc(int b, int& R, int& C) { const int st = b / 1024, sb = b % 1024, swz = sb ^ (((sb >> 9) & 1) << 5); R = (st >> 1) * 16 + swz / 64; C = (st & 1) * 32 + (swz % 64) / 2; }
__host__ __device__ __forceinline__ int perm32(int rho) { const int n = rho >> 4, i = rho & 15; return 8 * (i >> 2) + 4 * n + (i & 3); }

struct Unit { int pm, pn; };
struct Gemm { const bf16_t* A; const bf16_t* Bt; int M, N, K; };

struct StaticOrder {
    int nM, nN, nwg, G, c;
    __host__ __device__ void init(int M, int N, int G_, int c_) { nM = M / BM; nN = N / BM; nwg = nM * nN; G = G_; c = c_; }
    __host__ __device__ bool next(int i, Unit& u) const {
        const long L = (long)i * G + c; if (L >= nwg) return false;
        int wgid = (int)L; { const int q = nwg / NXCD, r = nwg % NXCD, xcd = wgid % NXCD, off = wgid / NXCD; wgid = (xcd < r ? xcd * (q + 1) : r * (q + 1) + (xcd - r) * q) + off; }
        const int nig = WGM * nN, gid = wgid / nig, fm = gid * WGM, gsz = (nM - fm) < WGM ? (nM - fm) : WGM;
        u.pm = fm + ((wgid % nig) % gsz); u.pn = (wgid % nig) / gsz; return true;
    }
    __device__ __forceinline__ void a_ready(const Unit&) const {}
    __device__ __forceinline__ void done(const Unit&) const {}
};

__device__ __forceinline__ unsigned cvt_pk_bf16(float lo, float hi) { unsigned r; asm volatile("v_cvt_pk_bf16_f32 %0, %1, %2" : "=v"(r) : "v"(lo), "v"(hi)); return r; }
typedef float f32x2 __attribute__((ext_vector_type(2)));
template <class Epi, class Sched, bool ALIGN_EPI = false, bool SP2 = false>
__device__ __forceinline__ void gemm_phase(PG8_LAS unsigned char* lds, const Gemm g, const Sched& S, const Epi& E, int tid_in) {
    int tid_l = tid_in; asm volatile("" : "+v"(tid_l)); const int tid = tid_l, wid = __builtin_amdgcn_readfirstlane(tid >> 6), lane = tid & 63, wr = wid >> 2, wc = wid & 3, fr = lane & 15, fq = lane >> 4;
    const int K = g.K, nt = K / BK;
    unsigned voffA[2], voffB[2];
#pragma unroll
    for (int i = 0; i < 2; ++i) { int R, C; stage_rc(tid * 16 + i * 8192, R, C); const int Rb = Epi::PERM ? ((R & ~31) + perm32(R & 31)) : R;
        voffA[i] = (unsigned)(R * K + C) * 2u; voffB[i] = (unsigned)(Rb * K + C) * 2u; }
    const size_t kstep = (size_t)(BK * 2);
    const size_t hstep = (size_t)HALF * K * 2;
    const size_t tstep = 2 * hstep;
    const unsigned ldsw = (unsigned)wid * 1024u;
    const int aoff = lds_byte(wr * 64 + fr, fq * 8), boff = lds_byte(wc * 32 + fr, fq * 8);
#define PG8_SA(b, h) (((b) * 2 + (h)) * HTB)
#define PG8_SB(b, h) ((4 + (b) * 2 + (h)) * HTB)
#define PG8_STAGE(bufoff, gbase, voff) do { _Pragma("unroll") for (int _i = 0; _i < 2; ++_i) \
        __builtin_amdgcn_global_load_lds((const unsigned*)((const char*)(gbase) + (voff)[_i]), (PG8_LAS unsigned*)(lds + (bufoff) + ldsw + _i * 8192), 16, 0, 0); } while (0)
#define PG8_LDA(dst, b, h) do { _Pragma("unroll") for (int m = 0; m < 4; ++m) _Pragma("unroll") for (int k = 0; k < 2; ++k) dst[m][k] = *(const PG8_LAS bf16x8*)(lds + PG8_SA(b, h) + aoff + m * 2048 + k * 1024); } while (0)
#define PG8_LDB(dst, b, h) do { _Pragma("unroll") for (int n = 0; n < 2; ++n) _Pragma("unroll") for (int k = 0; k < 2; ++k) dst[n][k] = *(const PG8_LAS bf16x8*)(lds + PG8_SB(b, h) + boff + n * 2048 + k * 1024); } while (0)
#define PG8_MMA(ai, bj, At, Bt) do { __builtin_amdgcn_s_setprio(1); _Pragma("unroll") for (int m = 0; m < 4; ++m) _Pragma("unroll") for (int n = 0; n < 2; ++n) _Pragma("unroll") for (int k = 0; k < 2; ++k) \
        acc[ai][bj][m][n] = __builtin_amdgcn_mfma_f32_16x16x32_bf16(Bt[n][k], At[m][k], acc[ai][bj][m][n], 0, 0, 0); __builtin_amdgcn_s_setprio(0); } while (0)
#define PG8_WAIT_V(n) asm volatile("s_waitcnt vmcnt(" #n ")" ::: "memory")
#define PG8_WAIT_L(n) asm volatile("s_waitcnt lgkmcnt(" #n ")" ::: "memory")
#define PG8_BAR __builtin_amdgcn_s_barrier()
#define PG8_SCHED __builtin_amdgcn_sched_barrier(0)
    Unit cur, nxt; int ui = 0;
    if (!S.next(0, cur)) return;
    f32x4 acc[2][2][4][2];
#pragma unroll
    for (int a = 0; a < 2; ++a)
#pragma unroll
        for (int b = 0; b < 2; ++b)
#pragma unroll
            for (int m = 0; m < 4; ++m)
#pragma unroll
                for (int n = 0; n < 2; ++n) acc[a][b][m][n] = (f32x4){0.f, 0.f, 0.f, 0.f};
    bf16x8 At[4][2], B0[2][2], B1[2][2];
    const char* cA = (const char*)g.A + (size_t)cur.pm * tstep; const char* cB = (const char*)g.Bt + (size_t)cur.pn * tstep;
    S.a_ready(cur);
    if constexpr (SP2) {
        PG8_STAGE(PG8_SB(0, 0), cB, voffB); PG8_STAGE(PG8_SB(0, 1), cB + hstep, voffB); PG8_STAGE(PG8_SA(0, 0), cA, voffA); PG8_STAGE(PG8_SA(0, 1), cA + hstep, voffA);
        if (wr == 1) PG8_BAR;
        PG8_WAIT_V(2); PG8_BAR;
        PG8_STAGE(PG8_SB(1, 0), cB + kstep, voffB); PG8_STAGE(PG8_SA(1, 0), cA + kstep, voffA); PG8_STAGE(PG8_SB(1, 1), cB + hstep + kstep, voffB);
        PG8_WAIT_V(6); PG8_BAR;
    } else {
        PG8_STAGE(PG8_SB(0, 0), cB, voffB); PG8_STAGE(PG8_SA(0, 0), cA, voffA); PG8_STAGE(PG8_SB(0, 1), cB + hstep, voffB); PG8_STAGE(PG8_SA(0, 1), cA + hstep, voffA);
        if (wr == 1) PG8_BAR;
        PG8_WAIT_V(4); PG8_BAR;
        PG8_STAGE(PG8_SB(1, 0), cB + kstep, voffB); PG8_STAGE(PG8_SA(1, 0), cA + kstep, voffA); PG8_STAGE(PG8_SB(1, 1), cB + hstep + kstep, voffB);
        PG8_WAIT_V(6); PG8_BAR;
    }
    for (;;) {
        const bool has_next = S.next(ui + 1, nxt);
        const char* nA = has_next ? (const char*)g.A + (size_t)nxt.pm * tstep : cA; const char* nB = has_next ? (const char*)g.Bt + (size_t)nxt.pn * tstep : cB;
        for (int t = 0; t < nt; t += 2) {
            const bool last = (t == nt - 2);
            const char* a1 = cA + (size_t)(t + 1) * kstep;
            const char* a2 = last ? nA : cA + (size_t)(t + 2) * kstep; const char* b2 = last ? nB : cB + (size_t)(t + 2) * kstep;
            const char* a3 = a2 + kstep; const char* b3 = b2 + kstep;
            if (last && has_next) S.a_ready(nxt);
            if constexpr (SP2) {
            PG8_LDB(B0, 0, 0); PG8_LDB(B1, 0, 1); PG8_SCHED; PG8_LDA(At, 0, 0); PG8_STAGE(PG8_SA(1, 1), a1 + hstep, voffA);
            PG8_WAIT_V(8); PG8_WAIT_L(0); PG8_BAR; PG8_MMA(0, 0, At, B0); PG8_MMA(0, 1, At, B1); PG8_BAR; PG8_SCHED;
            PG8_LDA(At, 0, 1); PG8_STAGE(PG8_SB(0, 0), b2, voffB); PG8_STAGE(PG8_SB(0, 1), b2 + hstep, voffB); PG8_STAGE(PG8_SA(0, 0), a2, voffA);
            PG8_WAIT_V(8); PG8_WAIT_L(0); PG8_BAR; PG8_MMA(1, 0, At, B0); PG8_MMA(1, 1, At, B1); PG8_BAR; PG8_SCHED;
            PG8_LDB(B0, 1, 0); PG8_LDB(B1, 1, 1); PG8_SCHED; PG8_LDA(At, 1, 0); PG8_STAGE(PG8_SA(0, 1), a2 + hstep, voffA);
            PG8_WAIT_V(8); PG8_WAIT_L(0); PG8_BAR; PG8_MMA(0, 0, At, B0); PG8_MMA(0, 1, At, B1); PG8_BAR; PG8_SCHED;
            PG8_LDA(At, 1, 1); PG8_STAGE(PG8_SB(1, 0), b3, voffB); PG8_STAGE(PG8_SB(1, 1), b3 + hstep, voffB); PG8_STAGE(PG8_SA(1, 0), a3, voffA);
            PG8_WAIT_V(8); PG8_WAIT_L(0); PG8_BAR; PG8_MMA(1, 0, At, B0); PG8_MMA(1, 1, At, B1); PG8_BAR; PG8_SCHED;
            } else {
            PG8_LDB(B0, 0, 0); PG8_SCHED; PG8_LDA(At, 0, 0); PG8_STAGE(PG8_SA(1, 1), a1 + hstep, voffA);
            PG8_WAIT_L(8); PG8_BAR; PG8_WAIT_L(0); PG8_MMA(0, 0, At, B0); PG8_BAR; PG8_SCHED;
            PG8_LDB(B1, 0, 1); PG8_STAGE(PG8_SB(0, 0), b2, voffB);
            PG8_BAR; PG8_WAIT_L(0); PG8_MMA(0, 1, At, B1); PG8_BAR;
            PG8_LDA(At, 0, 1); PG8_STAGE(PG8_SA(0, 0), a2, voffA);
            PG8_BAR; PG8_WAIT_L(0); PG8_MMA(1, 0, At, B0); PG8_BAR; PG8_SCHED;
            PG8_STAGE(PG8_SB(0, 1), b2 + hstep, voffB);
            PG8_WAIT_V(6); PG8_BAR; PG8_MMA(1, 1, At, B1); PG8_BAR;
            PG8_LDB(B0, 1, 0); PG8_SCHED; PG8_LDA(At, 1, 0); PG8_STAGE(PG8_SA(0, 1), a2 + hstep, voffA);
            PG8_WAIT_L(8); PG8_BAR; PG8_WAIT_L(0); PG8_MMA(0, 0, At, B0); PG8_BAR; PG8_SCHED;
            PG8_LDB(B1, 1, 1); PG8_STAGE(PG8_SB(1, 0), b3, voffB);
            PG8_BAR; PG8_WAIT_L(0); PG8_MMA(0, 1, At, B1); PG8_BAR;
            PG8_LDA(At, 1, 1); PG8_STAGE(PG8_SA(1, 0), a3, voffA);
            PG8_BAR; PG8_WAIT_L(0); PG8_MMA(1, 0, At, B0); PG8_BAR; PG8_SCHED;
            PG8_STAGE(PG8_SB(1, 1), b3 + hstep, voffB);
            PG8_WAIT_V(6); PG8_BAR; PG8_MMA(1, 1, At, B1); PG8_BAR;
            }
        }
        if constexpr (ALIGN_EPI) { if (wr == 0) PG8_BAR; }
        if constexpr (!Epi::AFTER_DRAIN) { E(acc, cur, wr, wc, fr, fq); S.done(cur); }
        if (!has_next) break;
#pragma unroll
        for (int a = 0; a < 2; ++a)
#pragma unroll
            for (int b = 0; b < 2; ++b)
#pragma unroll
                for (int m = 0; m < 4; ++m)
#pragma unroll
                    for (int n = 0; n < 2; ++n) acc[a][b][m][n] = (f32x4){0.f, 0.f, 0.f, 0.f};
        cur = nxt; cA = nA; cB = nB; ++ui;
        if constexpr (ALIGN_EPI) { if (wr == 1) PG8_BAR; }
    }
    PG8_WAIT_V(0);
    if constexpr (!ALIGN_EPI) { if (wr == 0) PG8_BAR; }
    PG8_BAR;
    if constexpr (Epi::AFTER_DRAIN) { E.fused(acc, cur, wr, wc, fr, fq, lds, wid, lane); S.done(cur); }
#undef PG8_SA
#undef PG8_SB
#undef PG8_STAGE
#undef PG8_LDA
#undef PG8_LDB
#undef PG8_MMA
#undef PG8_WAIT_V
#undef PG8_WAIT_L
#undef PG8_BAR
#undef PG8_SCHED
}
}
#define LAS __attribute__((address_space(3)))
typedef unsigned short bf16_t;
typedef short bf16x8 __attribute__((ext_vector_type(8)));
typedef short s16x4 __attribute__((ext_vector_type(4)));
typedef float f32x16 __attribute__((ext_vector_type(16)));
typedef float f32x4 __attribute__((ext_vector_type(4)));
typedef float f32x2 __attribute__((ext_vector_type(2)));
typedef unsigned u32x4 __attribute__((ext_vector_type(4)));
typedef unsigned u32x2 __attribute__((ext_vector_type(2)));
typedef LAS unsigned char* ldsp_t;

constexpr int BATCH = 8, SEQ = 8192, DM = 1024, MTOK = BATCH * SEQ, MEMLEN = 256, DFF = 2816;
constexpr float EPS = 1e-6f, LOG2E = 1.4426950408889634f;
constexpr size_t MiB = 1ull << 20;
constexpr int NWAVES = 8, NTHR = 512;
constexpr int LDS_BYTES = 163840;
constexpr int QKVP = 3072;
constexpr size_t WS_WIN0 = 1 * MiB, WS_WOUT0 = 7 * MiB, WS_WIN1 = 9 * MiB, WS_WOUT1 = 15 * MiB, WS_WQ = 17 * MiB, WS_WKV = 19 * MiB, WS_WO = 23 * MiB,
                 WS_WUP = 25 * MiB, WS_WDN = 47 * MiB, WS_T5 = 59 * MiB, WS_ROPE = 59 * MiB + 512 * 1024;
constexpr size_t WS_HN = 64 * MiB;
constexpr size_t WS_QKV = 192 * MiB;
constexpr size_t WS_VT = 576 * MiB;
constexpr size_t WS_Y = 720 * MiB;
constexpr size_t WS_CST = 848 * MiB;
constexpr size_t WS_G = 976 * MiB, WS_NST = 980 * MiB, WS_SC = 982 * MiB, WS_MST = 983 * MiB;
constexpr size_t WS_QC = 192 * MiB, WS_OC = 272 * MiB, WS_KVC = 994 * MiB, WS_VTC = 1002 * MiB;
constexpr size_t WS_RS = 984 * MiB, WS_MEMN = 986 * MiB;
constexpr size_t WS_ACT = 192 * MiB, WS_SIDE = 544 * MiB;

struct Args { const float* in[27]; float* out; unsigned char* ws; };

#define GAS __attribute__((address_space(1)))
#define LDS_FENCE() asm volatile("s_waitcnt lgkmcnt(0)" ::: "memory")
__device__ __forceinline__ unsigned pk2(float lo, float hi) { typedef __bf16 b2 __attribute__((ext_vector_type(2))); f32x2 v = {lo, hi}; b2 b = __builtin_convertvector(v, b2); return __builtin_bit_cast(unsigned, b); }
__device__ __forceinline__ float bflo(unsigned w) { return __uint_as_float(w << 16); }
__device__ __forceinline__ float bfhi(unsigned w) { return __uint_as_float(w & 0xffff0000u); }
__device__ __forceinline__ float bf1(bf16_t v) { return __uint_as_float(((unsigned)v) << 16); }
__device__ __forceinline__ int lane_id() { int l; asm volatile("v_mbcnt_lo_u32_b32 %0, -1, 0\n\tv_mbcnt_hi_u32_b32 %0, -1, %0" : "=v"(l)); return l; }
__device__ __forceinline__ float bperm(float v, int src) { return __builtin_bit_cast(float, __builtin_amdgcn_ds_bpermute(src << 2, __builtin_bit_cast(int, v))); }
__device__ __forceinline__ float shx(float v, int o) { return bperm(v, lane_id() ^ o); }
__device__ __forceinline__ float shup(float v, int o) { const int l = lane_id(); return bperm(v, l >= o ? l - o : l); }
__device__ __forceinline__ float shdn(float v, int o) { const int l = lane_id(); return bperm(v, l + o < 64 ? l + o : l); }
__device__ __forceinline__ float shl_(float v, int k) { return bperm(v, k); }
__device__ __forceinline__ float wave_sum(float v) {
#pragma unroll
    for (int o = 1; o < 64; o <<= 1) v += shx(v, o);
    return v;
}
__device__ __forceinline__ float ex2(float x) { return __builtin_amdgcn_exp2f(x); }
__device__ __forceinline__ float logsig(float x) { return fminf(x, 0.f) - __logf(1.f + __expf(-fabsf(x))); }
__device__ __forceinline__ int crow(int r, int hi) { return (r & 3) + 8 * (r >> 2) + 4 * hi; }
__device__ __forceinline__ int clampi(int v, int lo, int hi) { return v < lo ? lo : (v > hi ? hi : v); }

struct EpiBf16G {
    static constexpr bool PERM = true, AFTER_DRAIN = false;
    bf16_t* O; int ldc; float* G; const float* gbias; int gcol0; const float* RS;
    __device__ __forceinline__ void operator()(const pg8::f32x4 (&acc)[2][2][4][2], const pg8::Unit& u, int wr, int wc, int fr, int fq) const {
        const int row0 = u.pm * 256 + wr * 64 + fr, col0 = u.pn * 256 + wc * 32 + 8 * fq;
#pragma unroll
        for (int ai = 0; ai < 2; ++ai)
#pragma unroll
            for (int m = 0; m < 4; ++m) {
                const size_t row = (size_t)(row0 + ai * 128 + m * 16);
                const float rstd = RS ? rsqrtf(RS[row] * (1.f / DM) + EPS) : 1.f;
#pragma unroll
                for (int bj = 0; bj < 2; ++bj) {
                    const int col = col0 + bj * 128;
                    const pg8::f32x4 v0 = acc[ai][bj][m][0] * rstd, v1 = acc[ai][bj][m][1] * rstd;
                    if (G != nullptr && col >= gcol0) {
                        if (col < gcol0 + 16) {
                            float* gp = G + row * 16 + (col - gcol0); const float* bp = gbias + (col - gcol0);
                            gp[0] = v0[0] + bp[0]; gp[1] = v0[1] + bp[1]; gp[2] = v0[2] + bp[2]; gp[3] = v0[3] + bp[3];
                            gp[4] = v1[0] + bp[4]; gp[5] = v1[1] + bp[5]; gp[6] = v1[2] + bp[6]; gp[7] = v1[3] + bp[7];
                        }
                    } else {
                        u32x4 w; w.x = pk2(v0[0], v0[1]); w.y = pk2(v0[2], v0[3]); w.z = pk2(v1[0], v1[1]); w.w = pk2(v1[2], v1[3]);
                        *(GAS u32x4*)(O + row * ldc + col) = w;
                    }
                }
            }
    }
};
struct EpiResid {
    static constexpr bool PERM = false, AFTER_DRAIN = false;
    const void* R; int r_bf; void* Out; int o_bf; int ldc; bf16_t* XG; const float* gain; float* RS;
    __device__ __forceinline__ void operator()(const pg8::f32x4 (&acc)[2][2][4][2], const pg8::Unit& u, int wr, int wc, int fr, int fq) const {
        const int row0 = u.pm * 256 + wr * 64 + fr, col0 = u.pn * 256 + wc * 32 + 4 * fq;
        pg8::f32x4 gv[2][2];
        if (XG) {
#pragma unroll
            for (int bj = 0; bj < 2; ++bj)
#pragma unroll
                for (int n = 0; n < 2; ++n) gv[bj][n] = *(const GAS pg8::f32x4*)(gain + col0 + bj * 128 + n * 16);
        }
#pragma unroll
        for (int ai = 0; ai < 2; ++ai)
#pragma unroll
            for (int m = 0; m < 4; ++m) {
                const int row = row0 + ai * 128 + m * 16;
                const size_t off = (size_t)row * ldc + col0;
                float ss = 0.f;
#pragma unroll
                for (int bj = 0; bj < 2; ++bj)
#pragma unroll
                    for (int n = 0; n < 2; ++n) {
                        const size_t o2 = off + bj * 128 + n * 16;
                        pg8::f32x4 r;
                        if (r_bf) { const u32x2 rw = *(const GAS u32x2*)((const bf16_t*)R + o2); r = (pg8::f32x4){bflo(rw.x), bfhi(rw.x), bflo(rw.y), bfhi(rw.y)}; }
                        else r = *(const GAS pg8::f32x4*)((const float*)R + o2);
                        const pg8::f32x4 v = r + acc[ai][bj][m][n];
                        if (o_bf) { u32x2 w; w.x = pk2(v[0], v[1]); w.y = pk2(v[2], v[3]); *(GAS u32x2*)((bf16_t*)Out + o2) = w; }
                        else *(GAS pg8::f32x4*)((float*)Out + o2) = v;
                        if (XG) {
                            ss += (v[0] * v[0] + v[1] * v[1]) + (v[2] * v[2] + v[3] * v[3]);
                            const pg8::f32x4 g = gv[bj][n]; u32x2 w; w.x = pk2(v[0] * g[0], v[1] * g[1]); w.y = pk2(v[2] * g[2], v[3] * g[3]);
                            *(GAS u32x2*)(XG + o2) = w;
                        }
                    }
                if (XG) {
                    ss += shx(ss, 16); ss += shx(ss, 32);
                    if (fq == 0) __hip_atomic_fetch_add(RS + row, ss, __ATOMIC_RELAXED, __HIP_MEMORY_SCOPE_AGENT);
                }
            }
    }
};
#ifndef RESID_ALIGN
#define RESID_ALIGN true
#endif
template <class Epi> struct EpiAlign { static constexpr bool value = true; };
template <> struct EpiAlign<EpiResid> { static constexpr bool value = RESID_ALIGN; };
template <class Epi> __device__ __forceinline__ void run_gemm(ldsp_t lds, const bf16_t* A, const bf16_t* Bt, int M, int N, int K, const Epi& E, int tid, int Bx, int Gd) {
    pg8::Gemm g{A, Bt, M, N, K}; pg8::StaticOrder S; S.init(M, N, Gd, Bx);
    pg8::gemm_phase<Epi, pg8::StaticOrder, EpiAlign<Epi>::value, true>(lds, g, S, E, tid);
}
template <int CTRL> __device__ __forceinline__ float dppf(float x) { return __builtin_bit_cast(float, __builtin_amdgcn_update_dpp(0, __builtin_bit_cast(int, x), CTRL, 0xf, 0xf, true)); }
struct EpiConvAct {
    static constexpr bool PERM = true, AFTER_DRAIN = false;
    bf16_t* ACT; float* SIDE; const float* cw; const float* cb; const float* RS;
    __device__ __forceinline__ void operator()(const pg8::f32x4 (&acc)[2][2][4][2], const pg8::Unit& u, int wr_, int wc_, int fr_, int fq_) const {
        int wr = wr_, wc = wc_, fr = fr_, fq = fq_; asm volatile("" : "+s"(wr), "+s"(wc), "+v"(fr), "+v"(fq));
        const int ch0 = u.pn * 128 + wc * 32 + 8 * fq;
#pragma unroll
        for (int ai = 0; ai < 2; ++ai) {
            const int rowb = u.pm * 256 + ai * 128 + wr * 64, slab = rowb >> 6;
            float rs[4], rsp[4], rsn[4];
#pragma unroll
            for (int m = 0; m < 4; ++m) rs[m] = rsqrtf(RS[rowb + 16 * m + fr] * (1.f / DM) + EPS);
            { float mir[4];
#pragma unroll
              for (int m = 0; m < 4; ++m) mir[m] = dppf<0x140>(rs[m]);
#pragma unroll
              for (int m = 0; m < 4; ++m) { const float a = dppf<0x111>(rs[m]), b = dppf<0x101>(rs[m]); rsp[m] = fr > 0 ? a : mir[m > 0 ? m - 1 : 0]; rsn[m] = fr < 15 ? b : mir[m < 3 ? m + 1 : 3]; } }
#pragma unroll
            for (int mm = 0; mm < 2; ++mm) {
                const int m = mm ? 3 : 0; const int k = mm ? (fr == 14 ? 2 : fr == 15 ? 3 : -1) : (fr == 0 ? 0 : fr == 1 ? 1 : -1);
                if (k >= 0) {
                    float* sp = SIDE + ((size_t)(slab * 4 + k) * 2) * DFF + ch0;
                    *(GAS pg8::f32x4*)sp = acc[ai][0][m][0] * rs[m]; *(GAS pg8::f32x4*)(sp + 4) = acc[ai][0][m][1] * rs[m];
                    *(GAS pg8::f32x4*)(sp + DFF) = acc[ai][1][m][0] * rs[m]; *(GAS pg8::f32x4*)(sp + DFF + 4) = acc[ai][1][m][1] * rs[m];
                }
            }
#pragma unroll
            for (int eh = 0; eh < 2; ++eh) {
                const int chh = ch0 + 4 * eh;
                const pg8::f32x4 W0g = *(const GAS pg8::f32x4*)(cw + chh), W1g = *(const GAS pg8::f32x4*)(cw + 2 * DFF + chh), W2g = *(const GAS pg8::f32x4*)(cw + 4 * DFF + chh), Bg = *(const GAS pg8::f32x4*)(cb + chh);
                const pg8::f32x4 W0v = *(const GAS pg8::f32x4*)(cw + DFF + chh), W1v = *(const GAS pg8::f32x4*)(cw + 3 * DFF + chh), W2v = *(const GAS pg8::f32x4*)(cw + 5 * DFF + chh), Bv = *(const GAS pg8::f32x4*)(cb + DFF + chh);
#pragma unroll
                for (int m = 0; m < 4; ++m) {
                    float r4[4];
#pragma unroll
                    for (int ei = 0; ei < 4; ++ei) {
                        const float xg = acc[ai][0][m][eh][ei], xv = acc[ai][1][m][eh][ei];
                        const float mgp = dppf<0x140>(acc[ai][0][m > 0 ? m - 1 : 0][eh][ei]), mgn = dppf<0x140>(acc[ai][0][m < 3 ? m + 1 : 3][eh][ei]);
                        const float mvp = dppf<0x140>(acc[ai][1][m > 0 ? m - 1 : 0][eh][ei]), mvn = dppf<0x140>(acc[ai][1][m < 3 ? m + 1 : 3][eh][ei]);
                        const float sg = dppf<0x111>(xg), lg = dppf<0x101>(xg), sv = dppf<0x111>(xv), lv = dppf<0x101>(xv);
                        const float pg_ = fr > 0 ? sg : mgp, ng_ = fr < 15 ? lg : mgn, pv_ = fr > 0 ? sv : mvp, nv_ = fr < 15 ? lv : mvn;
                        const float gte = Bg[ei] + W0g[ei] * (pg_ * rsp[m]) + W1g[ei] * (xg * rs[m]) + W2g[ei] * (ng_ * rsn[m]);
                        const float val = Bv[ei] + W0v[ei] * (pv_ * rsp[m]) + W1v[ei] * (xv * rs[m]) + W2v[ei] * (nv_ * rsn[m]);
                        r4[ei] = gte / (1.f + __expf(-gte)) * val;
                    }
                    const int s_ = 16 * m + fr;
                    if (s_ != 0 && s_ != 63) { u32x2 o; o.x = pk2(r4[0], r4[1]); o.y = pk2(r4[2], r4[3]); *(GAS u32x2*)(ACT + (size_t)(rowb + s_) * DFF + chh) = o; }
                }
                asm volatile("" ::: "memory");
            }
        }
    }
};
__device__ __forceinline__ void ffn_fixup(int pm, bf16_t* ACT, const float* SIDE, const float* cw, const float* cb, int tid) {
    for (int idx = tid; idx < 8 * (DFF / 8); idx += NTHR) {
        const int ri = idx / (DFF / 8), ch = (idx % (DFF / 8)) * 8, slab = pm * 4 + (ri >> 1), last = ri & 1, row = slab * 64 + (last ? 63 : 0), t = row % SEQ;
        const float* sc = SIDE + ((size_t)(slab * 4 + (last ? 3 : 0)) * 2) * DFF + ch;
        const float* sp = last ? SIDE + ((size_t)(slab * 4 + 2) * 2) * DFF + ch : SIDE + ((size_t)((slab - 1) * 4 + 3) * 2) * DFF + ch;
        const float* sn = last ? SIDE + ((size_t)((slab + 1) * 4 + 0) * 2) * DFF + ch : SIDE + ((size_t)(slab * 4 + 1) * 2) * DFF + ch;
        const bool hp = last || t > 0, hn = !last || t < SEQ - 1;
        float r[8];
#pragma unroll
        for (int hlf = 0; hlf < 2; ++hlf) {
            const f32x4 z = {0.f, 0.f, 0.f, 0.f};
            const f32x4 cg = *(const GAS f32x4*)(sc + 4 * hlf), cv = *(const GAS f32x4*)(sc + DFF + 4 * hlf);
            const f32x4 pg_ = hp ? *(const GAS f32x4*)(sp + 4 * hlf) : z, pv_ = hp ? *(const GAS f32x4*)(sp + DFF + 4 * hlf) : z;
            const f32x4 ng_ = hn ? *(const GAS f32x4*)(sn + 4 * hlf) : z, nv_ = hn ? *(const GAS f32x4*)(sn + DFF + 4 * hlf) : z;
#pragma unroll
            for (int i = 0; i < 4; ++i) {
                const int c = ch + 4 * hlf + i;
                const float gte = cb[c] + cw[c] * pg_[i] + cw[2 * DFF + c] * cg[i] + cw[4 * DFF + c] * ng_[i];
                const float val = cb[DFF + c] + cw[DFF + c] * pv_[i] + cw[3 * DFF + c] * cv[i] + cw[5 * DFF + c] * nv_[i];
                r[4 * hlf + i] = gte / (1.f + __expf(-gte)) * val;
            }
        }
        u32x4 o; o.x = pk2(r[0], r[1]); o.y = pk2(r[2], r[3]); o.z = pk2(r[4], r[5]); o.w = pk2(r[6], r[7]);
        *(GAS u32x4*)(ACT + (size_t)row * DFF + ch) = o;
    }
}
template <class Epi> __device__ __forceinline__ void run_gemm_fix(ldsp_t lds, const bf16_t* A, const bf16_t* Bt, int M, int N, int K, const Epi& E, int tid, int Bx, int Gd,
                                                                  bf16_t* ACT, const float* SIDE, const float* cw, const float* cb) {
    pg8::Gemm g{A, Bt, M, N, K}; pg8::StaticOrder S; S.init(M, N, Gd, Bx);
    { pg8::Unit u; int last_pm = -1; for (int i = 0; S.next(i, u); ++i) { if (u.pm != last_pm) ffn_fixup(u.pm, ACT, SIDE, cw, cb, tid); last_pm = u.pm; } }
    asm volatile("s_waitcnt vmcnt(0)" ::: "memory"); __syncthreads();
    pg8::gemm_phase<Epi, pg8::StaticOrder, EpiAlign<Epi>::value, true>(lds, g, S, E, tid);
}
#define XB_TMO      128
#define XB_XCNT(j)  (256  + 64 * (j))
#define XB_XSUB(j)  (1280 + 64 * (j))
#define XB_XGEN(j)  (2304 + 64 * (j))
#define XB_TOP      3328
#define XB_TOPGEN   3392
#define XB_SPIN_CAP (1u << 20)
__device__ __forceinline__ unsigned xb_ld(unsigned* p)              { return __hip_atomic_load(p, __ATOMIC_RELAXED, __HIP_MEMORY_SCOPE_AGENT); }
__device__ __forceinline__ unsigned xb_add(unsigned* p, unsigned v) { return __hip_atomic_fetch_add(p, v, __ATOMIC_RELAXED, __HIP_MEMORY_SCOPE_AGENT); }
__device__ __forceinline__ unsigned xb_xcc_id() { return (unsigned)__builtin_amdgcn_s_getreg((3 << 11) | 20) & 0xFu; }
#define XB_SPIN(cond, bar) do { unsigned _sp = 0; while (cond) { __builtin_amdgcn_s_sleep(1); \
    if ((++_sp & 255u) == 0u) { if (xb_ld(&(bar)[XB_TMO])) break; if (_sp > XB_SPIN_CAP) { atomicAdd(&(bar)[XB_TMO], 1u); break; } } } } while (0)
__device__ __forceinline__ void xb_post(unsigned* bar, int wave_s) {
    if (wave_s == 0 && lane_id() == 0) (void)xb_add(&bar[XB_XCNT(xb_xcc_id())], 1u);
}
__device__ __forceinline__ void xb_complete(unsigned* bar, unsigned x, unsigned& nloc, unsigned& nx) {
    const unsigned G = gridDim.x;
    unsigned sum, cnt, mine, sp = 0u;
    for (;;) {
        sum = 0u; cnt = 0u; mine = 0u;
#pragma unroll
        for (unsigned j = 0; j < 16; ++j) { const unsigned c = xb_ld(&bar[XB_XCNT(j)]); sum += c; cnt += (c > 0u) ? 1u : 0u; mine = (j == x) ? c : mine; }
        if (sum == G) break;
        __builtin_amdgcn_s_sleep(1);
        if ((++sp & 255u) == 0u) { if (xb_ld(&bar[XB_TMO])) break; if (sp > XB_SPIN_CAP) { atomicAdd(&bar[XB_TMO], 1u); break; } }
    }
    nloc = mine > 0u ? mine : 1u; nx = cnt > 0u ? cnt : 1u;
}
__device__ __forceinline__ void gbar(unsigned* bar, volatile LAS unsigned* st, int wave_s) {
    asm volatile("s_waitcnt vmcnt(0) lgkmcnt(0)" ::: "memory");
    __syncthreads();
    if (wave_s == 0 && lane_id() == 0) {
        const unsigned x = xb_xcc_id();
        unsigned nloc = st[0], nx = st[1];
        if (nloc == 0u) { xb_complete(bar, x, nloc, nx); st[0] = nloc; st[1] = nx; }
        const unsigned old = xb_add(&bar[XB_XSUB(x)], 1u);
        const unsigned gen = old / nloc;
        if (old + 1u == (gen + 1u) * nloc) {
            __builtin_amdgcn_fence(__ATOMIC_RELEASE, "agent");
            asm volatile("s_waitcnt vmcnt(0)" ::: "memory");
            const unsigned og = xb_add(&bar[XB_TOP], 1u);
            const unsigned tg = og / nx;
            if (og + 1u == (tg + 1u) * nx) xb_add(&bar[XB_TOPGEN], 1u);
            else XB_SPIN(xb_ld(&bar[XB_TOPGEN]) == tg, bar);
            __builtin_amdgcn_fence(__ATOMIC_ACQUIRE, "agent");
            xb_add(&bar[XB_XGEN(x)], 1u);
            asm volatile("s_waitcnt vmcnt(0)" ::: "memory");
        } else {
            XB_SPIN(xb_ld(&bar[XB_XGEN(x)]) == gen, bar);
            __builtin_amdgcn_fence(__ATOMIC_ACQUIRE, "agent");
            asm volatile("s_waitcnt vmcnt(0)" ::: "memory");
        }
    }
    __syncthreads();
}

__device__ __forceinline__ int rowmap_up(int n) { const int ch = n < DFF ? n : n - DFF; return ((ch >> 7) << 8) + (n < DFF ? 0 : 128) + (ch & 127); }
__device__ __forceinline__ void wt_matrix(const float* W, int K, int N, bf16_t* WT, bool upmap, LAS float* scrf, int gw, int NGW, int lane, int& goff) {
    LAS bf16_t* scr = (LAS bf16_t*)scrf;
    const int nblk = (N + 63) / 64, nitems = (K / 64) * nblk;
    const int first = ((gw - goff) % NGW + NGW) % NGW; goff = (goff + nitems) % NGW;
    for (int item = first; item < nitems; item += NGW) {
        const int kb = item / nblk, nb = item % nblk, k0 = 64 * kb, n0 = 64 * nb;
        const int n4 = (lane & 15) * 4, kq = lane >> 4;
        f32x4 v[16];
#pragma unroll
        for (int i = 0; i < 16; ++i) { v[i] = (f32x4){0.f, 0.f, 0.f, 0.f}; if (n0 + n4 < N) v[i] = *(const GAS f32x4*)(W + (size_t)(k0 + 4 * i + kq) * N + n0 + n4); }
#pragma unroll
        for (int i = 0; i < 16; ++i) { LAS unsigned* d = (LAS unsigned*)(scr + (4 * i + kq) * 66 + n4); d[0] = pk2(v[i].x, v[i].y); d[1] = pk2(v[i].z, v[i].w); }
        LDS_FENCE();
        const int c = lane & 7;
#pragma unroll
        for (int j = 0; j < 8; ++j) {
            const int nl = (lane >> 3) + 8 * j, n = n0 + nl;
            const LAS bf16_t* s = scr + (8 * c) * 66 + nl;
            u32x4 o; o.x = (unsigned)s[0] | ((unsigned)s[66] << 16); o.y = (unsigned)s[132] | ((unsigned)s[198] << 16); o.z = (unsigned)s[264] | ((unsigned)s[330] << 16); o.w = (unsigned)s[396] | ((unsigned)s[462] << 16);
            if (n < N) { const int rr = upmap ? rowmap_up(n) : n; *(GAS u32x4*)(WT + (size_t)rr * K + k0 + 8 * c) = o; }
        }
        LDS_FENCE();
    }
}

__device__ __forceinline__ void rms_rows(const float* X, const float* gain, bf16_t* O, int nrows, int gw, int NGW, int lane) {
    for (int m = gw; m < nrows; m += NGW) {
        const GAS f32x4* xr = (const GAS f32x4*)(X + (size_t)m * DM) + lane;
        f32x4 v[4]; float s = 0.f;
#pragma unroll
        for (int j = 0; j < 4; ++j) { v[j] = xr[64 * j]; s += (v[j].x * v[j].x + v[j].y * v[j].y) + (v[j].z * v[j].z + v[j].w * v[j].w); }
        const float rstd = rsqrtf(wave_sum(s) * (1.f / DM) + EPS);
        GAS u32x2* o8 = (GAS u32x2*)(O + (size_t)m * DM) + lane;
#pragma unroll
        for (int j = 0; j < 4; ++j) { const f32x4 g = ((const f32x4*)gain)[lane + 64 * j]; u32x2 w; w.x = pk2(v[j].x * rstd * g.x, v[j].y * rstd * g.y); w.y = pk2(v[j].z * rstd * g.z, v[j].w * rstd * g.w); o8[64 * j] = w; }
    }
}

template <int GD, bool ROPE>
__device__ __forceinline__ void qknorm_rows(bf16_t* X, int pitch, int c0, int ncols, int nrows, int nq_cols, const float* gq, const float* gk, float sq, float sk,
                                            const float* ropeC, const float* ropeS, int gw, int NGW, int lane) {
    constexpr int LPG = GD / 8;
    const int nchunks = (ncols + 511) / 512;
    const int total = nrows * nchunks;
    for (int it0 = gw; it0 < total; it0 += 4 * NGW) {
      u32x4 raws[4];
#pragma unroll
      for (int j = 0; j < 4; ++j) {
          const int it = it0 + j * NGW; raws[j] = (u32x4){0u, 0u, 0u, 0u};
          if (it < total) { const int row = it / nchunks, ch = it % nchunks, c = ch * 512 + lane * 8; if (c < ncols) raws[j] = *(const GAS u32x4*)(X + (size_t)row * pitch + c0 + c); }
      }
#pragma unroll
      for (int j = 0; j < 4; ++j) {
        const int it = it0 + j * NGW; if (it >= total) break;
        const int row = it / nchunks, ch = it % nchunks;
        const int c = ch * 512 + lane * 8; const bool act = c < ncols;
        bf16_t* p = X + (size_t)row * pitch + c0 + c;
        const u32x4 raw = raws[j];
        float v[8]; v[0] = bflo(raw.x); v[1] = bfhi(raw.x); v[2] = bflo(raw.y); v[3] = bfhi(raw.y); v[4] = bflo(raw.z); v[5] = bfhi(raw.z); v[6] = bflo(raw.w); v[7] = bfhi(raw.w);
        float ss = 0.f;
#pragma unroll
        for (int i = 0; i < 8; ++i) ss += v[i] * v[i];
#pragma unroll
        for (int o = 1; o < LPG; o <<= 1) ss += shx(ss, o);
        const float rstd = rsqrtf(ss * (1.f / GD) + EPS);
        const bool isq = c < nq_cols; const float* g = (isq ? gq : gk) + (c % GD); const float sc = isq ? sq : sk;
        const f32x4 g0 = *(const f32x4*)g, g1 = *(const f32x4*)(g + 4);
        v[0] *= rstd * g0.x; v[1] *= rstd * g0.y; v[2] *= rstd * g0.z; v[3] *= rstd * g0.w; v[4] *= rstd * g1.x; v[5] *= rstd * g1.y; v[6] *= rstd * g1.z; v[7] *= rstd * g1.w;
        if (ROPE) {
            const int d = c & 63, half = d >> 5, dd = d & 31, t = row % SEQ, pos = half ? (t & 63) : (t >> 6), j0 = dd & 15; const bool second = dd >= 16;
#pragma unroll
            for (int i = 0; i < 8; ++i) {
                const float xp = shx(v[i], 2); const float cs = ropeC[pos * 16 + j0 + i], sn = ropeS[pos * 16 + j0 + i];
                v[i] = second ? (xp * sn + v[i] * cs) : (v[i] * cs - xp * sn);
            }
        }
        u32x4 o; o.x = pk2(v[0] * sc, v[1] * sc); o.y = pk2(v[2] * sc, v[3] * sc); o.z = pk2(v[4] * sc, v[5] * sc); o.w = pk2(v[6] * sc, v[7] * sc);
        if (act) *(GAS u32x4*)p = o;
      }
    }
}

__device__ __forceinline__ void transpose_cols(const bf16_t* X, int pitch, int c0, int C, int Sx, int nb, bf16_t* T, LAS bf16_t* scr, int gw, int NGW, int lane) {
    const int tt = Sx / 64, ct = C / 64, nitems = nb * tt * ct;
    for (int it = gw; it < nitems; it += NGW) {
        const int cti = it % ct, r = it / ct, tti = r % tt, b = r / tt;
        const bf16_t* src = X + (size_t)(b * Sx + tti * 64) * pitch + c0 + cti * 64;
#pragma unroll
        for (int i = 0; i < 8; ++i) {
            const int tok = 8 * i + (lane >> 3), chn = lane & 7;
            const u32x4 v = *(const GAS u32x4*)(src + (size_t)tok * pitch + chn * 8);
            LAS unsigned* d = (LAS unsigned*)(scr + tok * 66 + chn * 8);
            d[0] = v.x; d[1] = v.y; d[2] = v.z; d[3] = v.w;
        }
        LDS_FENCE();
#pragma unroll
        for (int i = 0; i < 8; ++i) {
            const int col = 8 * i + (lane >> 3), chn = lane & 7;
            const LAS bf16_t* s = scr + (chn * 8) * 66 + col;
            u32x4 o; o.x = (unsigned)s[0] | ((unsigned)s[66] << 16); o.y = (unsigned)s[132] | ((unsigned)s[198] << 16); o.z = (unsigned)s[264] | ((unsigned)s[330] << 16); o.w = (unsigned)s[396] | ((unsigned)s[462] << 16);
            *(GAS u32x4*)(T + (size_t)(b * C + cti * 64 + col) * Sx + tti * 64 + chn * 8) = o;
        }
        LDS_FENCE();
    }
}

__device__ __forceinline__ float bfsel(const u32x4& v, int i) { const unsigned w = i < 2 ? v.x : i < 4 ? v.y : i < 6 ? v.z : v.w; return (i & 1) ? bfhi(w) : bflo(w); }
__device__ __forceinline__ void conv_gate(const bf16_t* U, bf16_t* ACT, int nrows, const float* cw, const float* cb, int gtid, int nthreads) {
    constexpr int nchunk = DFF / 8, RB = 16;
    const int nitems = (nrows / RB) * nchunk;
    for (int idx = gtid; idx < nitems; idx += nthreads) {
        const int rb = idx / nchunk, chk = idx % nchunk, ch = chk * 8, row0 = rb * RB, t0 = row0 % SEQ;
        const int ucol = ((ch >> 7) << 8) + (ch & 127);
        float wg[3][8], wv[3][8], bg[8], bv[8];
#pragma unroll
        for (int j = 0; j < 3; ++j) {
            const f32x4 a0 = *(const GAS f32x4*)(cw + j * 2 * DFF + ch), a1 = *(const GAS f32x4*)(cw + j * 2 * DFF + ch + 4);
            const f32x4 c0 = *(const GAS f32x4*)(cw + j * 2 * DFF + DFF + ch), c1 = *(const GAS f32x4*)(cw + j * 2 * DFF + DFF + ch + 4);
#pragma unroll
            for (int i = 0; i < 4; ++i) { wg[j][i] = a0[i]; wg[j][4 + i] = a1[i]; wv[j][i] = c0[i]; wv[j][4 + i] = c1[i]; }
        }
        { const f32x4 a0 = *(const GAS f32x4*)(cb + ch), a1 = *(const GAS f32x4*)(cb + ch + 4), c0 = *(const GAS f32x4*)(cb + DFF + ch), c1 = *(const GAS f32x4*)(cb + DFF + ch + 4);
#pragma unroll
          for (int i = 0; i < 4; ++i) { bg[i] = a0[i]; bg[4 + i] = a1[i]; bv[i] = c0[i]; bv[4 + i] = c1[i]; } }
        const bf16_t* up = U + (size_t)row0 * (2 * DFF) + ucol;
        const u32x4 z = {0u, 0u, 0u, 0u};
        u32x4 gp = z, vp = z;
        if (t0 > 0) { gp = *(const GAS u32x4*)(up - 2 * DFF); vp = *(const GAS u32x4*)(up - 2 * DFF + 128); }
        u32x4 gc = *(const GAS u32x4*)up, vc = *(const GAS u32x4*)(up + 128);
#pragma unroll 4
        for (int rr = 0; rr < RB; ++rr) {
            u32x4 gn = z, vn = z;
            if (rr < RB - 1 || t0 + RB < SEQ) { gn = *(const GAS u32x4*)(up + (size_t)(rr + 1) * (2 * DFF)); vn = *(const GAS u32x4*)(up + (size_t)(rr + 1) * (2 * DFF) + 128); }
            float r[8];
#pragma unroll
            for (int i = 0; i < 8; ++i) {
                const float gte = bg[i] + bfsel(gp, i) * wg[0][i] + bfsel(gc, i) * wg[1][i] + bfsel(gn, i) * wg[2][i];
                const float val = bv[i] + bfsel(vp, i) * wv[0][i] + bfsel(vc, i) * wv[1][i] + bfsel(vn, i) * wv[2][i];
                r[i] = gte / (1.f + __expf(-gte)) * val;
            }
            u32x4 o; o.x = pk2(r[0], r[1]); o.y = pk2(r[2], r[3]); o.z = pk2(r[4], r[5]); o.w = pk2(r[6], r[7]);
            *(GAS u32x4*)(ACT + (size_t)(row0 + rr) * DFF + ch) = o;
            gp = gc; vp = vc; gc = gn; vc = vn;
        }
    }
}

#define MFMA32(a, b, c) __builtin_amdgcn_mfma_f32_32x32x16_bf16((a), (b), (c), 0, 0, 0)
constexpr int VSTR = 144, ATT_VOFF = 17408;
template <int DQK> __device__ __forceinline__ void tile_qk(f32x16& p0, f32x16& p1, const bf16x8* qf, const LAS unsigned char* Ks, int r32, int hi, float cinit) {
    constexpr int KSTR = (DQK + 8) * 2;
#pragma unroll
    for (int r = 0; r < 16; ++r) { p0[r] = cinit; p1[r] = cinit; }
    const int pr = (r32 & 0x13) | ((r32 & 4) << 1) | ((r32 & 8) >> 1);
    const LAS unsigned char* kb = Ks + pr * KSTR + hi * 16;
#pragma unroll
    for (int d0 = 0; d0 < DQK / 16; ++d0) {
        const bf16x8 a0 = *(const LAS bf16x8*)(kb + d0 * 32), a1 = *(const LAS bf16x8*)(kb + 32 * KSTR + d0 * 32);
        p0 = MFMA32(a0, qf[d0], p0); p1 = MFMA32(a1, qf[d0], p1);
    }
}
template <int DV> __device__ __forceinline__ void tile_softmax_pv(f32x16& p0, f32x16& p1, float& m, float& l, f32x16* o, const LAS unsigned char* Vts, int r32, int hi) {
    float mx = fmaxf(p0[0], p1[0]);
#pragma unroll
    for (int r = 1; r < 16; ++r) mx = fmaxf(mx, fmaxf(p0[r], p1[r]));
    mx = fmaxf(mx, shx(mx, 32));
    const float mn = fmaxf(m, mx), alpha = ex2(m - mn); m = mn;
    float s = 0.f;
#pragma unroll
    for (int r = 0; r < 16; ++r) { p0[r] = ex2(p0[r] - mn); p1[r] = ex2(p1[r] - mn); s += p0[r] + p1[r]; }
    l = l * alpha + s;
    if (__any(alpha != 1.0f)) {
#pragma unroll
        for (int d0 = 0; d0 < DV / 32; ++d0) o[d0] = o[d0] * alpha;
    }
    u32x4 w[4];
    w[0] = (u32x4){pk2(p0[0], p0[1]), pk2(p0[2], p0[3]), pk2(p0[4], p0[5]), pk2(p0[6], p0[7])};
    w[1] = (u32x4){pk2(p0[8], p0[9]), pk2(p0[10], p0[11]), pk2(p0[12], p0[13]), pk2(p0[14], p0[15])};
    w[2] = (u32x4){pk2(p1[0], p1[1]), pk2(p1[2], p1[3]), pk2(p1[4], p1[5]), pk2(p1[6], p1[7])};
    w[3] = (u32x4){pk2(p1[8], p1[9]), pk2(p1[10], p1[11]), pk2(p1[12], p1[13]), pk2(p1[14], p1[15])};
    const LAS unsigned char* vb = Vts + r32 * VSTR + hi * 16;
#pragma unroll
    for (int j = 0; j < 4; ++j) {
        const bf16x8 pb = __builtin_bit_cast(bf16x8, w[j]);
#pragma unroll
        for (int d0 = 0; d0 < DV / 32; ++d0) {
            const bf16x8 a = *(const LAS bf16x8*)(vb + d0 * 32 * VSTR + j * 32);
            o[d0] = MFMA32(a, pb, o[d0]);
        }
    }
}
template <int DV> __device__ __forceinline__ void tile_exp_pv(f32x16& p0, f32x16& p1, f32x16& oe, f32x16* o, const LAS unsigned char* Vts, int r32, int hi) {
#pragma unroll
    for (int r = 0; r < 16; ++r) { p0[r] = ex2(p0[r]); p1[r] = ex2(p1[r]); }
    u32x4 w[4];
    w[0] = (u32x4){pk2(p0[0], p0[1]), pk2(p0[2], p0[3]), pk2(p0[4], p0[5]), pk2(p0[6], p0[7])};
    w[1] = (u32x4){pk2(p0[8], p0[9]), pk2(p0[10], p0[11]), pk2(p0[12], p0[13]), pk2(p0[14], p0[15])};
    w[2] = (u32x4){pk2(p1[0], p1[1]), pk2(p1[2], p1[3]), pk2(p1[4], p1[5]), pk2(p1[6], p1[7])};
    w[3] = (u32x4){pk2(p1[8], p1[9]), pk2(p1[10], p1[11]), pk2(p1[12], p1[13]), pk2(p1[14], p1[15])};
    const u32x4 onesw = {0x3f803f80u, 0x3f803f80u, 0x3f803f80u, 0x3f803f80u};
    const bf16x8 ones = __builtin_bit_cast(bf16x8, onesw);
    const LAS unsigned char* vb = Vts + r32 * VSTR + hi * 16;
#pragma unroll
    for (int j = 0; j < 4; ++j) {
        const bf16x8 pb = __builtin_bit_cast(bf16x8, w[j]);
        oe = MFMA32(ones, pb, oe);
#pragma unroll
        for (int d0 = 0; d0 < DV / 32; ++d0) {
            const bf16x8 a = *(const LAS bf16x8*)(vb + d0 * 32 * VSTR + j * 32);
            o[d0] = MFMA32(a, pb, o[d0]);
        }
    }
}
template <int D> __device__ __forceinline__ float score_bound(const float* gq, const float* gk, int lane) {
    float a = fabsf(gq[lane & (D - 1)]), b = fabsf(gk[lane & (D - 1)]);
    if (D == 128) { a = fmaxf(a, fabsf(gq[64 + lane])); b = fmaxf(b, fabsf(gk[64 + lane])); }
#pragma unroll
    for (int o = 1; o < 64; o <<= 1) { a = fmaxf(a, shx(a, o)); b = fmaxf(b, shx(b, o)); }
    return (D == 64 ? 8.0f : 11.3137085f) * a * b * LOG2E * 1.02f;
}
template <int DQK, int DV> struct KVRegs { u32x4 k[DQK / 64]; u32x4 v[DV / 64]; };
template <int DQK, int DV> __device__ __forceinline__ void kv_load(KVRegs<DQK, DV>& R, const bf16_t* Kt, int kpitch, const bf16_t* Vt, int vtpitch, int tid) {
#pragma unroll
    for (int i = 0; i < DQK / 64; ++i) { const int ci = tid + 512 * i, row = ci / (DQK / 8), cc = ci % (DQK / 8); R.k[i] = *(const GAS u32x4*)(Kt + (size_t)row * kpitch + cc * 8); }
#pragma unroll
    for (int i = 0; i < DV / 64; ++i) { const int ci = tid + 512 * i, d = ci >> 3, cc = ci & 7; R.v[i] = *(const GAS u32x4*)(Vt + (size_t)d * vtpitch + cc * 8); }
}
template <int DQK, int DV> __device__ __forceinline__ void kv_store(const KVRegs<DQK, DV>& R, LAS unsigned char* Ks, LAS unsigned char* Vts, int tid) {
    constexpr int KSTR = (DQK + 8) * 2;
#pragma unroll
    for (int i = 0; i < DQK / 64; ++i) { const int ci = tid + 512 * i, row = ci / (DQK / 8), cc = ci % (DQK / 8); *(LAS u32x4*)(Ks + row * KSTR + cc * 16) = R.k[i]; }
#pragma unroll
    for (int i = 0; i < DV / 64; ++i) { const int ci = tid + 512 * i, d = ci >> 3, cc = ci & 7; *(LAS u32x4*)(Vts + d * VSTR + cc * 16) = R.v[i]; }
}
constexpr int ATT_BUF = 35840;
template <int DQK, int BIAS>
__device__ __forceinline__ void qk_biased(f32x16& p0, f32x16& p1, const bf16x8* qf, const LAS unsigned char* Ks, int t, int q0w, const float* tb, float cneg, float cpos, float sref, int r32, int hi) {
    float cinit = -sref; bool near = false;
    if (BIAS == 1) { const int lo = t * 64 - (q0w + 31), hh = t * 64 + 63 - q0w; if (hh <= -91) cinit = cneg; else if (lo >= 91) cinit = cpos; else near = true; }
    tile_qk<DQK>(p0, p1, qf, Ks, r32, hi, cinit);
    if (BIAS == 1 && near) {
        const GAS float* tq = (const GAS float*)(tb + (t * 64 + 8 * hi - (q0w + r32)));
#pragma unroll
        for (int r = 0; r < 16; ++r) { const int kk = 16 * (r >> 3) + (r & 7); p0[r] += tq[kk]; p1[r] += tq[kk + 32]; }
    }
}
template <int DQK, bool ROPE> __device__ __forceinline__ void qf_norm(bf16x8* qf, const float* qgain, float qscale, int hi, const float* ropeC, const float* ropeS, int prow, int pcol) {
    float v[DQK / 16][8]; float ss = 0.f;
#pragma unroll
    for (int d0 = 0; d0 < DQK / 16; ++d0) { const u32x4 w = __builtin_bit_cast(u32x4, qf[d0]);
        v[d0][0] = bflo(w.x); v[d0][1] = bfhi(w.x); v[d0][2] = bflo(w.y); v[d0][3] = bfhi(w.y); v[d0][4] = bflo(w.z); v[d0][5] = bfhi(w.z); v[d0][6] = bflo(w.w); v[d0][7] = bfhi(w.w);
#pragma unroll
        for (int i = 0; i < 8; ++i) ss += v[d0][i] * v[d0][i]; }
    ss += shx(ss, 32);
    const float rs = rsqrtf(ss * (1.f / DQK) + EPS);
#pragma unroll
    for (int d0 = 0; d0 < DQK / 16; ++d0) { const f32x4 g0 = *(const f32x4*)(qgain + d0 * 16 + hi * 8), g1 = *(const f32x4*)(qgain + d0 * 16 + hi * 8 + 4);
        v[d0][0] *= rs * g0.x; v[d0][1] *= rs * g0.y; v[d0][2] *= rs * g0.z; v[d0][3] *= rs * g0.w; v[d0][4] *= rs * g1.x; v[d0][5] *= rs * g1.y; v[d0][6] *= rs * g1.z; v[d0][7] *= rs * g1.w; }
    if constexpr (ROPE && DQK == 64) {
#pragma unroll
        for (int hf = 0; hf < 2; ++hf) {
            const float* cp = ropeC + (hf ? pcol : prow) * 16 + 8 * hi; const float* sp = ropeS + (hf ? pcol : prow) * 16 + 8 * hi;
            const f32x4 c0 = *(const f32x4*)cp, c1 = *(const f32x4*)(cp + 4), s0 = *(const f32x4*)sp, s1 = *(const f32x4*)(sp + 4);
#pragma unroll
            for (int i = 0; i < 8; ++i) { const float cs = i < 4 ? c0[i & 3] : c1[i & 3], sn = i < 4 ? s0[i & 3] : s1[i & 3]; const float t1 = v[2 * hf][i], t2 = v[2 * hf + 1][i];
                v[2 * hf][i] = t1 * cs - t2 * sn; v[2 * hf + 1][i] = t1 * sn + t2 * cs; }
        }
    }
#pragma unroll
    for (int d0 = 0; d0 < DQK / 16; ++d0) { u32x4 r; r.x = pk2(v[d0][0] * qscale, v[d0][1] * qscale); r.y = pk2(v[d0][2] * qscale, v[d0][3] * qscale); r.z = pk2(v[d0][4] * qscale, v[d0][5] * qscale); r.w = pk2(v[d0][6] * qscale, v[d0][7] * qscale);
        qf[d0] = __builtin_bit_cast(bf16x8, r); }
}
template <int DQK, int DV, int BIAS, bool PIPE, bool FIXED>
__device__ __forceinline__ void attn_pass(const bf16_t* Qw, int qpitch, const bf16_t* Kb, int kpitch, const bf16_t* Vtb, int vtpitch, int ntiles,
                                          int q0w, const float* tb, float cneg, float cpos, ldsp_t lds, float& m, float& l, f32x16* o, int tid, int r32, int hi,
                                          const float* qgain = nullptr, float qscale = 1.f, const float* ropeC = nullptr, const float* ropeS = nullptr, int qprow = 0, int qpcol = 0) {
    bf16x8 qf[DQK / 16];
#pragma unroll
    for (int d0 = 0; d0 < DQK / 16; ++d0) qf[d0] = *(const GAS bf16x8*)(Qw + (size_t)r32 * qpitch + d0 * 16 + hi * 8);
    if (qgain) { if (ropeC) qf_norm<DQK, true>(qf, qgain, qscale, hi, ropeC, ropeS, qprow, qpcol); else qf_norm<DQK, false>(qf, qgain, qscale, hi, nullptr, nullptr, 0, 0); }
    const float sref = FIXED ? m : 0.f;
    if (FIXED) { cneg -= sref; cpos -= sref; }
    m = -1e30f; l = 0.f;
#pragma unroll
    for (int d0 = 0; d0 < DV / 32; ++d0)
#pragma unroll
        for (int r = 0; r < 16; ++r) o[d0][r] = 0.f;
    f32x16 oe;
#pragma unroll
    for (int r = 0; r < 16; ++r) oe[r] = 0.f;
    KVRegs<DQK, DV> R; kv_load<DQK, DV>(R, Kb, kpitch, Vtb, vtpitch, tid);
    __syncthreads();
    kv_store<DQK, DV>(R, lds, lds + ATT_VOFF, tid);
    if (ntiles > 1) kv_load<DQK, DV>(R, Kb + (size_t)64 * kpitch, kpitch, Vtb + 64, vtpitch, tid);
    __syncthreads();
    int cur = 0;
    if constexpr (PIPE) {
    f32x16 pa0, pa1, pb0, pb1;
    qk_biased<DQK, BIAS>(pa0, pa1, qf, lds, 0, q0w, tb, cneg, cpos, sref, r32, hi);
#define ATT_STEP(P0, P1, N0, N1, T) do { \
        const int t_ = (T); const int nxt = cur == 2 * ATT_BUF ? 0 : cur + ATT_BUF; \
        if (t_ + 1 < ntiles) kv_store<DQK, DV>(R, lds + nxt, lds + nxt + ATT_VOFF, tid); \
        __syncthreads(); \
        if (t_ + 2 < ntiles) kv_load<DQK, DV>(R, Kb + (size_t)(t_ + 2) * 64 * kpitch, kpitch, Vtb + (t_ + 2) * 64, vtpitch, tid); \
        if (t_ + 1 < ntiles) qk_biased<DQK, BIAS>(N0, N1, qf, lds + nxt, t_ + 1, q0w, tb, cneg, cpos, sref, r32, hi); \
        if constexpr (FIXED) tile_exp_pv<DV>(P0, P1, oe, o, lds + cur + ATT_VOFF, r32, hi); else tile_softmax_pv<DV>(P0, P1, m, l, o, lds + cur + ATT_VOFF, r32, hi); \
        cur = nxt; } while (0)
#pragma nounroll
    for (int t = 0; t < ntiles; t += 2) {
        ATT_STEP(pa0, pa1, pb0, pb1, t);
        ATT_STEP(pb0, pb1, pa0, pa1, t + 1);
    }
#undef ATT_STEP
    } else {
#pragma nounroll
    for (int t = 0; t < ntiles; ++t) {
        const int nxt = cur == 2 * ATT_BUF ? 0 : cur + ATT_BUF;
        if (t + 1 < ntiles) kv_store<DQK, DV>(R, lds + nxt, lds + nxt + ATT_VOFF, tid);
        __syncthreads();
        if (t + 2 < ntiles) kv_load<DQK, DV>(R, Kb + (size_t)(t + 2) * 64 * kpitch, kpitch, Vtb + (t + 2) * 64, vtpitch, tid);
        f32x16 p0, p1;
        qk_biased<DQK, BIAS>(p0, p1, qf, lds + cur, t, q0w, tb, cneg, cpos, sref, r32, hi);
        if constexpr (FIXED) tile_exp_pv<DV>(p0, p1, oe, o, lds + cur + ATT_VOFF, r32, hi); else tile_softmax_pv<DV>(p0, p1, m, l, o, lds + cur + ATT_VOFF, r32, hi);
        cur = nxt;
    }
    }
    if constexpr (FIXED) l = 0.5f * oe[0];
}
template <int DV> __device__ __forceinline__ void store_o(const f32x16* o, float inv, bf16_t* Ow, int opitch, int r32, int hi) {
#pragma unroll
    for (int d0 = 0; d0 < DV / 32; ++d0)
#pragma unroll
        for (int g = 0; g < 4; ++g) {
            u32x2 w; w.x = pk2(o[d0][4 * g] * inv, o[d0][4 * g + 1] * inv); w.y = pk2(o[d0][4 * g + 2] * inv, o[d0][4 * g + 3] * inv);
            *(GAS u32x2*)(Ow + (size_t)r32 * opitch + 32 * d0 + 8 * g + 4 * hi) = w;
        }
}
__device__ __forceinline__ int vcu_of(int bx, int G) { return (G % 8 == 0) ? (bx % 8) * (G / 8) + bx / 8 : bx; }

__device__ __forceinline__ void gqa_phase(const bf16_t* QKV, const bf16_t* VaT, bf16_t* Y, const float* gqk, const float* ropeC, const float* ropeS, ldsp_t lds, int tid, int wave, int r32, int hi, int Bx, int Gd) {
    const int G = Gd, vcu = vcu_of(Bx, G);
    const float sref = score_bound<64>(gqk, gqk + 64, tid & 63);
    for (int u = vcu; u < BATCH * 8 * 32; u += G) {
        const int qt = u & 31, hq = (u >> 5) & 3, kvh = (u >> 7) & 1, b = u >> 8, hqf = kvh * 4 + hq;
        const size_t row0 = (size_t)b * SEQ + qt * 256 + wave * 32;
        float m = sref, l; f32x16 o[2];
        if (sref < 40.f) attn_pass<64, 64, 0, true, true>(QKV + row0 * QKVP + hqf * 64, QKVP, QKV + (size_t)b * SEQ * QKVP + 512 + kvh * 64, QKVP, VaT + (size_t)((b * 2 + kvh) * 64) * SEQ, SEQ, SEQ / 64,
                             0, nullptr, 0.f, 0.f, lds, m, l, o, tid, r32, hi, gqk, 0.125f * LOG2E, ropeC, ropeS, (qt * 256 + wave * 32 + r32) >> 6, (wave * 32 + r32) & 63);
        else attn_pass<64, 64, 0, false, false>(QKV + row0 * QKVP + hqf * 64, QKVP, QKV + (size_t)b * SEQ * QKVP + 512 + kvh * 64, QKVP, VaT + (size_t)((b * 2 + kvh) * 64) * SEQ, SEQ, SEQ / 64,
                             0, nullptr, 0.f, 0.f, lds, m, l, o, tid, r32, hi, gqk, 0.125f * LOG2E, ropeC, ropeS, (qt * 256 + wave * 32 + r32) >> 6, (wave * 32 + r32) & 63);
        l += shx(l, 32);
        store_o<64>(o, 1.f / l, Y + row0 * DM + hqf * 64, DM, r32, hi);
    }
}
__device__ __forceinline__ void cross_phase(const bf16_t* QC, const bf16_t* KVC, const bf16_t* VTC, bf16_t* OC, const float* gqk, ldsp_t lds, int tid, int wave, int r32, int hi, int Bx, int Gd) {
    const int G = Gd, vcu = vcu_of(Bx, G);
    const float sref = score_bound<128>(gqk, gqk + 128, tid & 63);
    for (int u = vcu; u < BATCH * 4 * 32; u += G) {
        const int qt = u & 31, h = (u >> 5) & 3, b = u >> 7;
        const size_t row0 = (size_t)b * SEQ + qt * 256 + wave * 32;
        float m = sref, l; f32x16 o[4];
        if (sref < 40.f) attn_pass<128, 128, 0, false, true>(QC + row0 * 512 + h * 128, 512, KVC + (size_t)b * MEMLEN * 1024 + h * 128, 1024, VTC + (size_t)((b * 4 + h) * 128) * MEMLEN, MEMLEN, MEMLEN / 64,
                               0, nullptr, 0.f, 0.f, lds, m, l, o, tid, r32, hi, gqk, 0.08838834764831845f * LOG2E);
        else attn_pass<128, 128, 0, false, false>(QC + row0 * 512 + h * 128, 512, KVC + (size_t)b * MEMLEN * 1024 + h * 128, 1024, VTC + (size_t)((b * 4 + h) * 128) * MEMLEN, MEMLEN, MEMLEN / 64,
                               0, nullptr, 0.f, 0.f, lds, m, l, o, tid, r32, hi, gqk, 0.08838834764831845f * LOG2E);
        l += shx(l, 32);
        store_o<128>(o, 1.f / l, OC + row0 * 512 + h * 128, 512, r32, hi);
    }
}
__device__ __forceinline__ void diff_phase(const bf16_t* QKV, const bf16_t* VdT, bf16_t* Y, const float* t5tab, const float* t5raw, const float* lamv, const float* dgain, const float* gqk, float lam_init,
                                           float* stash, ldsp_t lds, int tid, int wave, int lane, int r32, int hi, int Bx, int Gd) {
    const int G = Gd, vcu = vcu_of(Bx, G);
    f32x4* st = (f32x4*)(stash + ((size_t)(Bx * NWAVES + wave) * 64 + lane) * 64);
    float bmax = fmaxf(fabsf(t5raw[lane]), fabsf(t5raw[64 + lane]));
#pragma unroll
    for (int o = 1; o < 64; o <<= 1) bmax = fmaxf(bmax, shx(bmax, o));
    const float sref = score_bound<64>(gqk, gqk + 64, lane) + bmax * LOG2E;
    const float lam = __expf(wave_sum(lamv[lane] * lamv[64 + lane])) - __expf(wave_sum(lamv[128 + lane] * lamv[192 + lane])) + lam_init;
    for (int u = vcu; u < BATCH * 4 * 32; u += G) {
        const int qt = u & 31, h = (u >> 5) & 3, b = u >> 7;
        const int q0w = qt * 256 + wave * 32; const size_t row0 = (size_t)b * SEQ + q0w;
        const float cneg = t5raw[15 * 4 + h] * LOG2E, cpos = t5raw[31 * 4 + h] * LOG2E; const float* tb = t5tab + h * 16384 + 8192;
        const bf16_t* Kb = QKV + (size_t)b * SEQ * QKVP + 2048 + h * 128; const bf16_t* Vt = VdT + (size_t)((b * 4 + h) * 128) * SEQ;
        float m, l; f32x16 o1[4];
        { f32x16 o2[4];
          m = sref;
          if (sref < 40.f) attn_pass<64, 128, 1, false, true>(QKV + row0 * QKVP + 1536 + h * 128 + 64, QKVP, Kb + 64, QKVP, Vt, SEQ, SEQ / 64, q0w, tb, cneg, cpos, lds, m, l, o2, tid, r32, hi, gqk, 0.125f * LOG2E);
          else attn_pass<64, 128, 1, false, false>(QKV + row0 * QKVP + 1536 + h * 128 + 64, QKVP, Kb + 64, QKVP, Vt, SEQ, SEQ / 64, q0w, tb, cneg, cpos, lds, m, l, o2, tid, r32, hi, gqk, 0.125f * LOG2E);
          l += shx(l, 32);
          const float inv = lam / l;
#pragma unroll
          for (int d0 = 0; d0 < 4; ++d0)
#pragma unroll
              for (int g = 0; g < 4; ++g) st[d0 * 4 + g] = (f32x4){o2[d0][4 * g] * inv, o2[d0][4 * g + 1] * inv, o2[d0][4 * g + 2] * inv, o2[d0][4 * g + 3] * inv}; }
        asm volatile("" ::: "memory");
        m = sref;
        if (sref < 40.f) attn_pass<64, 128, 1, false, true>(QKV + row0 * QKVP + 1536 + h * 128, QKVP, Kb, QKVP, Vt, SEQ, SEQ / 64, q0w, tb, cneg, cpos, lds, m, l, o1, tid, r32, hi, gqk, 0.125f * LOG2E);
        else attn_pass<64, 128, 1, false, false>(QKV + row0 * QKVP + 1536 + h * 128, QKVP, Kb, QKVP, Vt, SEQ, SEQ / 64, q0w, tb, cneg, cpos, lds, m, l, o1, tid, r32, hi, gqk, 0.125f * LOG2E);
        l += shx(l, 32);
        float ss = 0.f;
        { const float inv = 1.f / l;
#pragma unroll
          for (int d0 = 0; d0 < 4; ++d0)
#pragma unroll
              for (int g = 0; g < 4; ++g) { const f32x4 sv = st[d0 * 4 + g];
#pragma unroll
                  for (int e = 0; e < 4; ++e) { const float v = o1[d0][4 * g + e] * inv - sv[e]; o1[d0][4 * g + e] = v; ss += v * v; } } }
        asm volatile("" ::: "memory");
        ss += shx(ss, 32);
        const float rstd = rsqrtf(ss * (1.f / 128.f) + EPS) * (1.f - lam_init);
        bf16_t* Ow = Y + row0 * DM + 512 + h * 128;
#pragma unroll
        for (int d0 = 0; d0 < 4; ++d0)
#pragma unroll
            for (int g = 0; g < 4; ++g) {
                const int d = 32 * d0 + 8 * g + 4 * hi; const f32x4 gn = *(const f32x4*)(dgain + h * 128 + d);
                u32x2 w; w.x = pk2(o1[d0][4 * g] * rstd * gn.x, o1[d0][4 * g + 1] * rstd * gn.y); w.y = pk2(o1[d0][4 * g + 2] * rstd * gn.z, o1[d0][4 * g + 3] * rstd * gn.w);
                *(u32x2*)(Ow + (size_t)r32 * DM + d) = w;
            }
    }
}
__device__ __forceinline__ void na_phase(const bf16_t* QKV, const bf16_t* VcT, bf16_t* Y, const float* rpb, const float* gq, const float* gk, ldsp_t lds, int tid, int wave, int r32, int hi, int Bx, int Gd) {
    const int G = Gd, vcu = vcu_of(Bx, G);
    LAS unsigned char* Ks = lds; LAS unsigned char* Vts = lds + ATT_VOFF; LAS float* rpl = (LAS float*)(lds + 3 * ATT_BUF);
    float bmax = 0.f;
    for (int i = (tid & 63); i < 8 * 465; i += 64) bmax = fmaxf(bmax, fabsf(rpb[i]));
#pragma unroll
    for (int o_ = 1; o_ < 64; o_ <<= 1) bmax = fmaxf(bmax, shx(bmax, o_));
    const float sref = score_bound<64>(gq, gk, tid & 63) + bmax * LOG2E;
    const bool fast = sref < 40.f;
    for (int u = vcu; u < BATCH * 8 * 32; u += G) {
        const int rg = u & 31, h = (u >> 5) & 7, b = u >> 8;
        const int R0 = 4 * rg, Rw = R0 + (wave >> 1), qc = 32 * (wave & 1) + r32;
        const int r0w = clampi(Rw - 4, 0, 120), ulo = clampi(R0 - 4, 0, 120), uhi = clampi(R0 - 1, 0, 120) + 7, nt = uhi - ulo + 1;
        const int c0 = clampi(qc - 8, 0, 48);
        __syncthreads();
        if (tid < 465) rpl[tid] = rpb[h * 465 + tid] * LOG2E;
        const size_t row0 = (size_t)b * SEQ + Rw * 64 + 32 * (wave & 1);
        const bf16_t* Qw = QKV + row0 * QKVP + h * 64;
        const bf16_t* Kb = QKV + ((size_t)b * SEQ + ulo * 64) * QKVP + 512 + h * 64;
        const bf16_t* Vtb = VcT + (size_t)((b * 8 + h) * 64) * SEQ + ulo * 64;
        bf16x8 qf[4];
#pragma unroll
        for (int d0 = 0; d0 < 4; ++d0) qf[d0] = *(const GAS bf16x8*)(Qw + (size_t)r32 * QKVP + d0 * 16 + hi * 8);
        qf_norm<64, false>(qf, gq, 0.125f * LOG2E, hi, nullptr, nullptr, 0, 0);
        float m = -1e30f, l = 0.f; f32x16 o[2], oe;
#pragma unroll
        for (int r = 0; r < 16; ++r) oe[r] = 0.f;
#pragma unroll
        for (int d0 = 0; d0 < 2; ++d0)
#pragma unroll
            for (int r = 0; r < 16; ++r) o[d0][r] = 0.f;
        KVRegs<64, 64> R; kv_load<64, 64>(R, Kb, QKVP, Vtb, SEQ, tid);
        for (int t = 0; t < nt; ++t) {
            __syncthreads();
            kv_store<64, 64>(R, Ks, Vts, tid);
            __syncthreads();
            if (t + 1 < nt) kv_load<64, 64>(R, Kb + (size_t)(t + 1) * 64 * QKVP, QKVP, Vtb + (t + 1) * 64, SEQ, tid);
            const int kr = ulo + t;
            if (kr >= r0w && kr < r0w + 8) {
                f32x16 p0, p1; tile_qk<64>(p0, p1, qf, Ks, r32, hi, fast ? -sref : 0.f);
                const LAS float* rp = rpl + (kr - Rw + 7) * 31 + 15 - qc;
#pragma unroll
                for (int r = 0; r < 16; ++r) {
                    const int kc = 16 * (r >> 3) + (r & 7) + 8 * hi, kc2 = kc + 32;
                    p0[r] = (kc >= c0 && kc < c0 + 16) ? p0[r] + rp[kc] : -1e30f;
                    p1[r] = (kc2 >= c0 && kc2 < c0 + 16) ? p1[r] + rp[kc2] : -1e30f;
                }
                if (fast) tile_exp_pv<64>(p0, p1, oe, o, Vts, r32, hi); else tile_softmax_pv<64>(p0, p1, m, l, o, Vts, r32, hi);
            }
        }
        l += shx(l, 32); if (fast) l = oe[0];
        store_o<64>(o, 1.f / l, Y + row0 * DM + h * 64, DM, r32, hi);
    }
}

constexpr float KSCALE = 0.08838834764831845f;
__device__ __forceinline__ void mlstm_a_phase(const float* Gt, const bf16_t* KmT, const bf16_t* VmT, bf16_t* CST, float* NST, float* SC, ldsp_t lds, int tid, int wave, int r32, int hi, int Bx, int Gd) {
    LAS float* fl = (LAS float*)lds; LAS float* ab = fl + 128; LAS float* wv = fl + 256;
    for (int u = Bx; u < BATCH * 4 * 64 * 2; u += Gd) {
        const int dir = u & 1, c = (u >> 1) & 63, h = (u >> 7) & 3, b = u >> 9, chain = (b * 4 + h) * 2 + dir;
        const size_t tok0 = (size_t)b * SEQ + c * 128;
        __syncthreads();
        float gi = 0.f;
        if (tid < 128) { const float* gp = Gt + (tok0 + tid) * 16 + dir * 8 + h; gi = gp[0]; fl[tid] = logsig(gp[4]); }
        __syncthreads();
        if (tid < 128) {
            float cum = 0.f, tot = 0.f;
            for (int s = 0; s < 128; ++s) { const float f = fl[s]; tot += f; if (dir == 0 ? s <= tid : s >= tid) cum += f; }
            ab[tid] = tot - cum + gi;
            if (tid == 0) SC[(chain * 64 + c) * 2] = tot;
        }
        __syncthreads();
        if (tid < 128) {
            float mx = -1e30f;
            for (int s = 0; s < 128; ++s) mx = fmaxf(mx, ab[s]);
            wv[tid] = __expf(ab[tid] - mx) * KSCALE;
            if (tid == 0) SC[(chain * 64 + c) * 2 + 1] = mx;
        }
        __syncthreads();
        const int mi = wave >> 1, nh = wave & 1;
        const bf16_t* vp = VmT + ((size_t)((b * 4 + h) * 128 + 32 * mi + r32)) * SEQ + c * 128 + 8 * hi;
        const bf16_t* kp = KmT + ((size_t)((b * 4 + h) * 128 + 64 * nh + r32)) * SEQ + c * 128 + 8 * hi;
        f32x16 acc[2];
#pragma unroll
        for (int ni = 0; ni < 2; ++ni)
#pragma unroll
            for (int r = 0; r < 16; ++r) acc[ni][r] = 0.f;
#pragma unroll
        for (int ks = 0; ks < 8; ++ks) {
            const bf16x8 a = *(const GAS bf16x8*)(vp + 16 * ks);
            const LAS float* wp = wv + 16 * ks + 8 * hi;
#pragma unroll
            for (int ni = 0; ni < 2; ++ni) {
                const u32x4 kr = *(const GAS u32x4*)(kp + (size_t)(32 * ni) * SEQ + 16 * ks);
                u32x4 kw; kw.x = pk2(bflo(kr.x) * wp[0], bfhi(kr.x) * wp[1]); kw.y = pk2(bflo(kr.y) * wp[2], bfhi(kr.y) * wp[3]);
                kw.z = pk2(bflo(kr.z) * wp[4], bfhi(kr.z) * wp[5]); kw.w = pk2(bflo(kr.w) * wp[6], bfhi(kr.w) * wp[7]);
                acc[ni] = MFMA32(a, __builtin_bit_cast(bf16x8, kw), acc[ni]);
            }
        }
        bf16_t* cp = CST + (size_t)(chain * 64 + c) * 16384;
#pragma unroll
        for (int ni = 0; ni < 2; ++ni)
#pragma unroll
            for (int r = 0; r < 16; ++r) { const int dv = 32 * mi + crow(r, hi), dk = 64 * nh + 32 * ni + r32; cp[dv * 128 + dk] = (bf16_t)(pk2(acc[ni][r], 0.f) & 0xffffu); }
        if (tid < 128) {
            const bf16_t* kq = KmT + ((size_t)((b * 4 + h) * 128 + tid)) * SEQ + c * 128; float s = 0.f;
#pragma unroll 4
            for (int j = 0; j < 16; ++j) { const u32x4 kr = *(const GAS u32x4*)(kq + 8 * j); const LAS float* wp = wv + 8 * j;
                s += bflo(kr.x) * wp[0] + bfhi(kr.x) * wp[1] + bflo(kr.y) * wp[2] + bfhi(kr.y) * wp[3] + bflo(kr.z) * wp[4] + bfhi(kr.z) * wp[5] + bflo(kr.w) * wp[6] + bfhi(kr.w) * wp[7]; }
            NST[(size_t)(chain * 64 + c) * 128 + tid] = s;
        }
    }
}
__device__ __forceinline__ void mlstm_scan_phase(bf16_t* CST, float* NST, const float* SC, float* MST, int gtid, int nthreads) {
    for (int idx = gtid; idx < 64 * 2048; idx += nthreads) {
        const int chain = idx >> 11, e = idx & 2047, dir = chain & 1; const bool hasn = e < 16;
        float C[8], N[8]; float m = 0.f;
#pragma unroll
        for (int i = 0; i < 8; ++i) { C[i] = 0.f; N[i] = 0.f; }
        for (int step = 0; step < 64; ++step) {
            const int c = dir ? 63 - step : step; const int base = chain * 64 + c;
            const float g = SC[base * 2], ml = SC[base * 2 + 1];
            const float mn = fmaxf(g + m, ml), dec = __expf(g + m - mn), sc = __expf(ml - mn);
            GAS u32x4* p = (GAS u32x4*)(CST + (size_t)base * 16384 + e * 8);
            const u32x4 kl = *p;
            u32x4 st; st.x = pk2(C[0], C[1]); st.y = pk2(C[2], C[3]); st.z = pk2(C[4], C[5]); st.w = pk2(C[6], C[7]);
            *p = st;
            if (e == 0) MST[base] = m;
            C[0] = dec * C[0] + sc * bflo(kl.x); C[1] = dec * C[1] + sc * bfhi(kl.x); C[2] = dec * C[2] + sc * bflo(kl.y); C[3] = dec * C[3] + sc * bfhi(kl.y);
            C[4] = dec * C[4] + sc * bflo(kl.z); C[5] = dec * C[5] + sc * bfhi(kl.z); C[6] = dec * C[6] + sc * bflo(kl.w); C[7] = dec * C[7] + sc * bfhi(kl.w);
            if (hasn) {
                GAS f32x4* q = (GAS f32x4*)(NST + (size_t)base * 128 + e * 8);
                const f32x4 n0 = q[0], n1 = q[1];
                q[0] = (f32x4){N[0], N[1], N[2], N[3]}; q[1] = (f32x4){N[4], N[5], N[6], N[7]};
                N[0] = dec * N[0] + sc * n0.x; N[1] = dec * N[1] + sc * n0.y; N[2] = dec * N[2] + sc * n0.z; N[3] = dec * N[3] + sc * n0.w;
                N[4] = dec * N[4] + sc * n1.x; N[5] = dec * N[5] + sc * n1.y; N[6] = dec * N[6] + sc * n1.z; N[7] = dec * N[7] + sc * n1.w;
            }
            m = mn;
        }
    }
}
__device__ __forceinline__ void mlstm_c_phase(const bf16_t* QKV, const float* Gt, const bf16_t* VmT, const bf16_t* CST, const float* NST, const float* MST, const float* mgain, bf16_t* Y,
                                              ldsp_t lds, int tid, int wave, int r32, int hi, int Bx, int Gd) {
    LAS float* bc = (LAS float*)lds; LAS float* rbv = bc + 128; LAS float* aif = bc + 256; LAS float* aib = bc + 384; LAS float* nst = bc + 512; LAS float* hb = bc + 1024;
    const int dir = wave >> 2, tb = wave & 3, t = 32 * tb + r32;
    for (int u = Bx; u < BATCH * 4 * 64; u += Gd) {
        const int c = u & 63, h = (u >> 6) & 3, b = u >> 8;
        const size_t tok0 = (size_t)b * SEQ + c * 128;
        __syncthreads();
        float i_f = 0.f, i_b = 0.f;
        if (tid < 128) { const float* gp = Gt + (tok0 + tid) * 16 + h; i_f = gp[0]; hb[tid] = logsig(gp[4]); i_b = gp[8]; hb[128 + tid] = logsig(gp[12]); }
        else if (tid < 384) { const int d2 = (tid - 128) >> 7, dk = (tid - 128) & 127; nst[d2 * 128 + dk] = NST[(size_t)(((b * 4 + h) * 2 + d2) * 64 + c) * 128 + dk]; }
        __syncthreads();
        if (tid < 128) {
            float cf = 0.f, cb = 0.f;
            for (int s = 0; s < 128; ++s) { if (s <= tid) cf += hb[s]; if (s >= tid) cb += hb[128 + s]; }
            bc[tid] = cf; rbv[tid] = cb; aif[tid] = i_f - cf; aib[tid] = i_b - cb;
        }
        __syncthreads();
        const int chain = (b * 4 + h) * 2 + dir;
        const float mst = MST[chain * 64 + c];
        const float bct = dir ? rbv[t] : bc[t];
        const LAS float* ai = dir ? aib : aif;
        bf16x8 qf[8];
        { const bf16_t* qp = QKV + (tok0 + t) * QKVP + 768 + h * 128 + 8 * hi;
#pragma unroll
          for (int k0 = 0; k0 < 8; ++k0) qf[k0] = *(const GAS bf16x8*)(qp + 16 * k0); }
        float mmax = -1e30f;
        for (int s = hi; s < 128; s += 2) { const bool ok = dir == 0 ? s <= t : s >= t; const float v = bct + ai[s]; if (ok) mmax = fmaxf(mmax, v); }
        mmax = fmaxf(mmax, shx(mmax, 32));
        const float mt = fmaxf(mmax, bct + mst);
        const float inter = __expf(bct + mst - mt);
        f32x16 acc[4];
#pragma unroll
        for (int d0 = 0; d0 < 4; ++d0) {
#pragma unroll
            for (int r = 0; r < 16; ++r) acc[d0][r] = 0.f;
            const bf16_t* cp = CST + (size_t)(chain * 64 + c) * 16384 + (32 * d0 + r32) * 128 + 8 * hi;
#pragma unroll
            for (int k0 = 0; k0 < 8; ++k0) { const bf16x8 cf = *(const GAS bf16x8*)(cp + 16 * k0); acc[d0] = MFMA32(cf, qf[k0], acc[d0]); }
            acc[d0] = acc[d0] * inter;
        }
        float den = 0.f;
#pragma unroll 1
        for (int sb = 0; sb < 4; ++sb) {
            const bool actv = dir == 0 ? sb <= tb : sb >= tb;
            if (!actv) continue;
            f32x16 p;
#pragma unroll
            for (int r = 0; r < 16; ++r) p[r] = 0.f;
            const bf16_t* kp = QKV + (tok0 + 32 * sb + r32) * QKVP + 1280 + h * 128 + 8 * hi;
#pragma unroll
            for (int k0 = 0; k0 < 8; ++k0) { const bf16x8 kf = *(const GAS bf16x8*)(kp + 16 * k0); p = MFMA32(kf, qf[k0], p); }
#pragma unroll
            for (int r = 0; r < 16; ++r) { const int s = 32 * sb + crow(r, hi); const bool ok = dir == 0 ? s <= t : s >= t;
                const float v = ok ? p[r] * KSCALE * __expf(bct + ai[s] - mt) : 0.f; p[r] = v; den += v; }
#pragma unroll
            for (int j = 0; j < 2; ++j) {
                const u32x4 w = {pk2(p[8 * j], p[8 * j + 1]), pk2(p[8 * j + 2], p[8 * j + 3]), pk2(p[8 * j + 4], p[8 * j + 5]), pk2(p[8 * j + 6], p[8 * j + 7])};
                const bf16x8 pb = __builtin_bit_cast(bf16x8, w);
#pragma unroll
                for (int d0 = 0; d0 < 4; ++d0) {
                    const bf16_t* vp = VmT + ((size_t)((b * 4 + h) * 128 + 32 * d0 + r32)) * SEQ + c * 128 + 32 * sb + 16 * j + 4 * hi;
                    const s16x4 lo = *(const GAS s16x4*)vp, h4 = *(const GAS s16x4*)(vp + 8);
                    const bf16x8 a = {lo[0], lo[1], lo[2], lo[3], h4[0], h4[1], h4[2], h4[3]};
                    acc[d0] = MFMA32(a, pb, acc[d0]);
                }
            }
        }
        den += shx(den, 32);
        float qn = 0.f;
#pragma unroll
        for (int k0 = 0; k0 < 8; ++k0) { const u32x4 qw = __builtin_bit_cast(u32x4, qf[k0]); const LAS float* np = nst + dir * 128 + 16 * k0 + 8 * hi;
            qn += bflo(qw.x) * np[0] + bfhi(qw.x) * np[1] + bflo(qw.y) * np[2] + bfhi(qw.y) * np[3] + bflo(qw.z) * np[4] + bfhi(qw.z) * np[5] + bflo(qw.w) * np[6] + bfhi(qw.w) * np[7]; }
        qn += shx(qn, 32);
        den += inter * qn;
        const float rden = 1.f / fmaxf(fabsf(den), __expf(-mt));
        __syncthreads();
        if (dir == 1) {
#pragma unroll
            for (int d0 = 0; d0 < 4; ++d0)
#pragma unroll
                for (int r = 0; r < 16; ++r) hb[(32 * d0 + crow(r, hi)) * 129 + t] = acc[d0][r] * rden;
        }
        __syncthreads();
        if (dir == 0) {
            float ss = 0.f;
#pragma unroll
            for (int d0 = 0; d0 < 4; ++d0)
#pragma unroll
                for (int r = 0; r < 16; ++r) { const float v = acc[d0][r] * rden + hb[(32 * d0 + crow(r, hi)) * 129 + t]; acc[d0][r] = v; ss += v * v; }
            ss += shx(ss, 32);
            const float rstd = rsqrtf(ss * (1.f / 128.f) + EPS);
            const bf16_t* op = QKV + (tok0 + t) * QKVP + 2304 + h * 128; bf16_t* yp = Y + (tok0 + t) * DM + 512 + h * 128;
#pragma unroll
            for (int d0 = 0; d0 < 4; ++d0)
#pragma unroll
                for (int g = 0; g < 4; ++g) {
                    const int d = 32 * d0 + 8 * g + 4 * hi; const f32x4 gn = *(const f32x4*)(mgain + h * 128 + d); const u32x2 ow = *(const u32x2*)(op + d);
                    const float s0 = 1.f / (1.f + __expf(-bflo(ow.x))), s1 = 1.f / (1.f + __expf(-bfhi(ow.x))), s2 = 1.f / (1.f + __expf(-bflo(ow.y))), s3 = 1.f / (1.f + __expf(-bfhi(ow.y)));
                    u32x2 w; w.x = pk2(acc[d0][4 * g] * rstd * gn.x * s0, acc[d0][4 * g + 1] * rstd * gn.y * s1); w.y = pk2(acc[d0][4 * g + 2] * rstd * gn.z * s2, acc[d0][4 * g + 3] * rstd * gn.w * s3);
                    *(u32x2*)(yp + d) = w;
                }
        }
    }
}
constexpr size_t WS_GP = 1008 * MiB, WS_WC = 1016 * MiB;
__device__ __forceinline__ void mlstm_gates_phase(const float* Gt, float* GP, float* WC, float* SC, int gw, int NGW, int lane) {
    for (int u = gw; u < BATCH * 4 * 64; u += NGW) {
        const int c = u & 63, h = (u >> 6) & 3, b = u >> 8;
        const size_t tok0 = (size_t)b * SEQ + c * 128;
        const int t0 = 2 * lane;
        const float* g0 = Gt + (tok0 + t0) * 16 + h; const float* g1 = g0 + 16;
        const float if0 = g0[0], ff0 = logsig(g0[4]), ib0 = g0[8], fb0 = logsig(g0[12]);
        const float if1 = g1[0], ff1 = logsig(g1[4]), ib1 = g1[8], fb1 = logsig(g1[12]);
        const float sf = ff0 + ff1, sb = fb0 + fb1;
        float xf = sf, xb = sb;
#pragma unroll
        for (int o = 1; o < 64; o <<= 1) { const float yf = shup(xf, o), yb = shup(xb, o); if (lane >= o) { xf += yf; xb += yb; } }
        const float totf = shl_(xf, 63), totb = shl_(xb, 63);
        const float bc0 = (xf - sf) + ff0, bc1 = bc0 + ff1;
        const float cb0 = (xb - sb) + fb0, cb1 = cb0 + fb1;
        const float rb0 = totb - cb0 + fb0, rb1 = totb - cb1 + fb1;
        const float aif0 = if0 - bc0, aif1 = if1 - bc1, aib0 = ib0 - rb0, aib1 = ib1 - rb1;
        float px = fmaxf(aif0, aif1);
#pragma unroll
        for (int o = 1; o < 64; o <<= 1) { const float y = shup(px, o); if (lane >= o) px = fmaxf(px, y); }
        float pe = shup(px, 1); if (lane == 0) pe = -3.0e38f;
        const float pmf0 = fmaxf(pe, aif0), pmf1 = fmaxf(pmf0, aif1);
        float sx = fmaxf(aib0, aib1);
#pragma unroll
        for (int o = 1; o < 64; o <<= 1) { const float y = shdn(sx, o); if (lane + o < 64) sx = fmaxf(sx, y); }
        float se = shdn(sx, 1); if (lane == 63) se = -3.0e38f;
        const float pmb1 = fmaxf(se, aib1), pmb0 = fmaxf(pmb1, aib0);
        const float mxf = shl_(px, 63), mxb = shl_(sx, 0);
        const float wf0 = __expf(aif0 - mxf) * KSCALE, wf1 = __expf(aif1 - mxf) * KSCALE, wb0 = __expf(aib0 - mxb) * KSCALE, wb1 = __expf(aib1 - mxb) * KSCALE;
        GAS f32x4* gp = (GAS f32x4*)(GP + ((size_t)(b * 4 + h) * SEQ + c * 128 + t0) * 8);
        gp[0] = (f32x4){bc0, rb0, aif0, aib0}; gp[1] = (f32x4){wf0, wb0, pmf0, pmb0}; gp[2] = (f32x4){bc1, rb1, aif1, aib1}; gp[3] = (f32x4){wf1, wb1, pmf1, pmb1};
        const int chf = (b * 4 + h) * 2;
        *(GAS f32x2*)(WC + (size_t)(chf * 64 + c) * 128 + t0) = (f32x2){wf0, wf1};
        *(GAS f32x2*)(WC + (size_t)((chf + 1) * 64 + c) * 128 + t0) = (f32x2){wb0, wb1};
        if (lane == 0) { SC[(chf * 64 + c) * 2] = totf; SC[(chf * 64 + c) * 2 + 1] = totf + mxf; SC[((chf + 1) * 64 + c) * 2] = totb; SC[((chf + 1) * 64 + c) * 2 + 1] = totb + mxb; }
    }
}
__device__ __forceinline__ void mlstm_a2_phase(const float* WC, const bf16_t* KmT, const bf16_t* VmT, bf16_t* CST, float* NST, int gw, int NGW, int r32, int hi) {
    for (int u = gw; u < BATCH * 4 * 64 * 2 * 4; u += NGW) {
        const int mi = u & 3, dir = (u >> 2) & 1, c = (u >> 3) & 63, h = (u >> 9) & 3, b = u >> 11, chain = (b * 4 + h) * 2 + dir;
        const float* wp0 = WC + (size_t)(chain * 64 + c) * 128 + 8 * hi;
        const bf16_t* vp = VmT + ((size_t)((b * 4 + h) * 128 + 32 * mi + r32)) * SEQ + c * 128 + 8 * hi;
        const bf16_t* kp = KmT + ((size_t)((b * 4 + h) * 128 + r32)) * SEQ + c * 128 + 8 * hi;
        f32x16 acc[4]; float nl[4];
#pragma unroll
        for (int ni = 0; ni < 4; ++ni) { nl[ni] = 0.f;
#pragma unroll
            for (int r = 0; r < 16; ++r) acc[ni][r] = 0.f; }
#pragma unroll 2
        for (int ks = 0; ks < 8; ++ks) {
            const bf16x8 a = *(const GAS bf16x8*)(vp + 16 * ks);
            const f32x4 w0 = *(const GAS f32x4*)(wp0 + 16 * ks), w1 = *(const GAS f32x4*)(wp0 + 16 * ks + 4);
#pragma unroll
            for (int ni = 0; ni < 4; ++ni) {
                const u32x4 kr = *(const GAS u32x4*)(kp + (size_t)(32 * ni) * SEQ + 16 * ks);
                const float p0 = bflo(kr.x) * w0.x, p1 = bfhi(kr.x) * w0.y, p2 = bflo(kr.y) * w0.z, p3 = bfhi(kr.y) * w0.w, p4 = bflo(kr.z) * w1.x, p5 = bfhi(kr.z) * w1.y, p6 = bflo(kr.w) * w1.z, p7 = bfhi(kr.w) * w1.w;
                nl[ni] += ((p0 + p1) + (p2 + p3)) + ((p4 + p5) + (p6 + p7));
                const u32x4 kw = {pk2(p0, p1), pk2(p2, p3), pk2(p4, p5), pk2(p6, p7)};
                acc[ni] = MFMA32(a, __builtin_bit_cast(bf16x8, kw), acc[ni]);
            }
        }
#pragma unroll
        for (int g = 0; g < 4; ++g) {
            GAS bf16_t* cp = (GAS bf16_t*)(CST + (size_t)(chain * 64 + c) * 16384 + (32 * mi + 8 * g + 4 * hi) * 128 + r32);
            asm volatile("" : "+v"(cp));
#pragma unroll
            for (int e = 0; e < 4; ++e)
#pragma unroll
                for (int ni = 0; ni < 4; ++ni) cp[e * 128 + 32 * ni] = (bf16_t)(pk2(acc[ni][4 * g + e], 0.f) & 0xffffu);
        }
#pragma unroll
        for (int ni = 0; ni < 4; ++ni) { const float v = nl[ni] + shx(nl[ni], 32); if (mi == 0 && hi == 0) NST[(size_t)(chain * 64 + c) * 128 + 32 * ni + r32] = v; }
    }
}
__device__ __forceinline__ void mlstm_c2_phase(const bf16_t* QKV, const float* GP, const bf16_t* VmT, const bf16_t* CST, const float* NST, const float* MST, const float* mgain, bf16_t* Y,
                                               LAS float* wl, int gw, int NGW, int lane_, int r32_, int hi_) {
    LAS float* hs = wl; LAS float* aiL = wl + 4096;
    for (int u = gw; u < BATCH * 4 * 64 * 4; u += NGW) {
        const int lane = lane_id(), r32 = lane & 31, hi = lane >> 5; (void)lane_; (void)r32_; (void)hi_;
        const int tb = u & 3, c = (u >> 2) & 63, h = (u >> 8) & 3, b = u >> 10, t = 32 * tb + r32;
        const size_t tok0 = (size_t)b * SEQ + c * 128;
        const GAS f32x4* gpc = (const GAS f32x4*)(GP + ((size_t)(b * 4 + h) * SEQ + c * 128) * 8);
        { const f32x4 e0 = gpc[(2 * lane) * 2], e1 = gpc[(2 * lane + 1) * 2]; aiL[2 * lane] = e0.z; aiL[128 + 2 * lane] = e0.w; aiL[2 * lane + 1] = e1.z; aiL[128 + 2 * lane + 1] = e1.w; }
        LDS_FENCE();
#pragma nounroll
        for (int dir_ = 0; dir_ < 2; ++dir_) {
            int dir = dir_; asm volatile("" : "+s"(dir));
            bf16x8 qf[8];
            { const bf16_t* qp = QKV + (tok0 + t) * QKVP + 768 + h * 128 + 8 * hi;
#pragma unroll
              for (int k0 = 0; k0 < 8; ++k0) qf[k0] = *(const GAS bf16x8*)(qp + 16 * k0); }
            const int chain = (b * 4 + h) * 2 + dir;
            const float mst = MST[chain * 64 + c];
            const GAS float* gpt = (const GAS float*)(gpc + t * 2) + dir;
            const float bct = gpt[0], pm = gpt[6];
            const LAS float* ai = aiL + dir * 128;
            const float mt = fmaxf(bct + pm, bct + mst), inter = __expf(bct + mst - mt);
            f32x16 acc[4];
#pragma unroll
            for (int d0 = 0; d0 < 4; ++d0) {
#pragma unroll
                for (int r = 0; r < 16; ++r) acc[d0][r] = 0.f;
                const bf16_t* cp = CST + (size_t)(chain * 64 + c) * 16384 + (32 * d0 + r32) * 128 + 8 * hi;
#pragma unroll
                for (int k0 = 0; k0 < 8; ++k0) { const bf16x8 cf = *(const GAS bf16x8*)(cp + 16 * k0); acc[d0] = MFMA32(cf, qf[k0], acc[d0]); }
                acc[d0] = acc[d0] * inter;
            }
            float den = 0.f;
#pragma unroll 1
            for (int sb = 0; sb < 4; ++sb) {
                const bool actv = dir == 0 ? sb <= tb : sb >= tb;
                if (!actv) continue;
                f32x16 p;
#pragma unroll
                for (int r = 0; r < 16; ++r) p[r] = 0.f;
                const int pr = (r32 & 0x13) | ((r32 & 4) << 1) | ((r32 & 8) >> 1);
                const bf16_t* kp = QKV + (tok0 + 32 * sb + pr) * QKVP + 1280 + h * 128 + 8 * hi;
#pragma unroll
                for (int k0 = 0; k0 < 8; ++k0) { const bf16x8 kf = *(const GAS bf16x8*)(kp + 16 * k0); p = MFMA32(kf, qf[k0], p); }
#pragma unroll
                for (int r = 0; r < 16; ++r) { const int s = 32 * sb + 16 * (r >> 3) + 8 * hi + (r & 7); const bool ok = dir == 0 ? s <= t : s >= t;
                    const float v = ok ? p[r] * KSCALE * __expf(bct + ai[s] - mt) : 0.f; p[r] = v; den += v; }
#pragma unroll
                for (int j = 0; j < 2; ++j) {
                    const u32x4 w = {pk2(p[8 * j], p[8 * j + 1]), pk2(p[8 * j + 2], p[8 * j + 3]), pk2(p[8 * j + 4], p[8 * j + 5]), pk2(p[8 * j + 6], p[8 * j + 7])};
                    const bf16x8 pb = __builtin_bit_cast(bf16x8, w);
#pragma unroll
                    for (int d0 = 0; d0 < 4; ++d0) {
                        const bf16_t* vp = VmT + ((size_t)((b * 4 + h) * 128 + 32 * d0 + r32)) * SEQ + c * 128 + 32 * sb + 16 * j + 8 * hi;
                        const bf16x8 a = *(const GAS bf16x8*)vp;
                        acc[d0] = MFMA32(a, pb, acc[d0]);
                    }
                }
            }
            den += shx(den, 32);
            float qn = 0.f;
            { const float* np0 = NST + (size_t)(chain * 64 + c) * 128 + 8 * hi;
#pragma unroll
              for (int k0 = 0; k0 < 8; ++k0) { const u32x4 qw = __builtin_bit_cast(u32x4, qf[k0]); const f32x4 n0 = *(const GAS f32x4*)(np0 + 16 * k0), n1 = *(const GAS f32x4*)(np0 + 16 * k0 + 4);
                  qn += bflo(qw.x) * n0.x + bfhi(qw.x) * n0.y + bflo(qw.y) * n0.z + bfhi(qw.y) * n0.w + bflo(qw.z) * n1.x + bfhi(qw.z) * n1.y + bflo(qw.w) * n1.z + bfhi(qw.w) * n1.w; } }
            qn += shx(qn, 32);
            den += inter * qn;
            const float rden = 1.f / fmaxf(fabsf(den), __expf(-mt));
            if (dir == 0) {
#pragma unroll
                for (int d0 = 0; d0 < 4; ++d0)
#pragma unroll
                    for (int r = 0; r < 16; ++r) hs[(32 * d0 + crow(r, hi)) * 32 + r32] = acc[d0][r] * rden;
                LDS_FENCE();
            } else {
                float ss = 0.f;
#pragma unroll
                for (int d0 = 0; d0 < 4; ++d0)
#pragma unroll
                    for (int r = 0; r < 16; ++r) { const float v = acc[d0][r] * rden + hs[(32 * d0 + crow(r, hi)) * 32 + r32]; acc[d0][r] = v; ss += v * v; }
                ss += shx(ss, 32);
                const float rstd = rsqrtf(ss * (1.f / 128.f) + EPS);
                const bf16_t* op = QKV + (tok0 + t) * QKVP + 2304 + h * 128; bf16_t* yp = Y + (tok0 + t) * DM + 512 + h * 128;
#pragma unroll
                for (int d0 = 0; d0 < 4; ++d0)
#pragma unroll
                    for (int g = 0; g < 4; ++g) {
                        const int d = 32 * d0 + 8 * g + 4 * hi; const f32x4 gn = *(const GAS f32x4*)(mgain + h * 128 + d); const u32x2 ow = *(const GAS u32x2*)(op + d);
                        const float s0 = 1.f / (1.f + __expf(-bflo(ow.x))), s1 = 1.f / (1.f + __expf(-bfhi(ow.x))), s2 = 1.f / (1.f + __expf(-bflo(ow.y))), s3 = 1.f / (1.f + __expf(-bfhi(ow.y)));
                        u32x2 w; w.x = pk2(acc[d0][4 * g] * rstd * gn.x * s0, acc[d0][4 * g + 1] * rstd * gn.y * s1); w.y = pk2(acc[d0][4 * g + 2] * rstd * gn.z * s2, acc[d0][4 * g + 3] * rstd * gn.w * s3);
                        *(GAS u32x2*)(yp + d) = w;
                    }
            }
        }
        LDS_FENCE();
    }
}
#define PH_BEGIN { int tid = wave_s * 64 + lane_id(); asm volatile("" : "+v"(tid)); const int lane = tid & 63, wave = wave_s, r32 = lane & 31, hi = lane >> 5; \
    int Bx = blockIdx.x, Gd = gridDim.x; asm volatile("" : "+s"(Bx), "+s"(Gd)); \
    const int gw = Bx * NWAVES + wave, NGW = Gd * NWAVES, gtid = Bx * NTHR + tid, nthreads = Gd * NTHR; \
    LAS float* scrf = (LAS float*)(lds + wave * 16384); LAS bf16_t* scrh = (LAS bf16_t*)(lds + wave * 16384); \
    (void)Bx; (void)Gd; (void)lane; (void)r32; (void)hi; (void)gw; (void)NGW; (void)gtid; (void)nthreads; (void)scrf; (void)scrh;
#define PH_END }
__global__ void __launch_bounds__(NTHR) fwd_megakernel(Args args) {
    extern __shared__ __attribute__((aligned(16))) unsigned char lds_raw[];
    cg::grid_group grid = cg::this_grid();
    ldsp_t lds = (ldsp_t)lds_raw;
    const int wave_s = __builtin_amdgcn_readfirstlane(threadIdx.x >> 6);
    unsigned char* wsl = args.ws;
    if (threadIdx.x < 2) ((LAS unsigned*)(lds + (LDS_BYTES - 16)))[threadIdx.x] = 0u;
    __syncthreads();
    xb_post((unsigned*)wsl, wave_s);
    grid.sync();
#define GSYNC() do { gbar((unsigned*)wsl, (volatile LAS unsigned*)(lds + (LDS_BYTES - 16)), wave_s); asm volatile("" : "+s"(wsl)); } while (0)
#define WSP wsl
#define x_in (args.in[0])
#define mem (args.in[1])
#define t5raw (args.in[2])
#define out (args.out)
#define RSB(k) ((float*)(WSP + WS_RS) + (size_t)(k) * MTOK)
#define GPB ((float*)(WSP + WS_GP))
#define WCB ((float*)(WSP + WS_WC))
#define XB ((bf16_t*)out + (size_t)MTOK * DM)
#define XB2 ((bf16_t*)(WSP + WS_Y))
#define HN ((bf16_t*)(WSP + WS_HN))
#define QKV ((bf16_t*)(WSP + WS_QKV))
#define VT ((bf16_t*)(WSP + WS_VT))
#define Y ((bf16_t*)(WSP + WS_Y))
#define CST ((bf16_t*)(WSP + WS_CST))
#define Gt ((float*)(WSP + WS_G))
#define NST ((float*)(WSP + WS_NST))
#define SC ((float*)(WSP + WS_SC))
#define MST ((float*)(WSP + WS_MST))
#define QC ((bf16_t*)(WSP + WS_QC))
#define KVC(l_) ((bf16_t*)(WSP + WS_KVC + (size_t)(l_) * 4 * MiB))
#define VTC(l_) ((bf16_t*)(WSP + WS_VTC + (size_t)(l_) * 2 * MiB))
#define MEMN ((bf16_t*)(WSP + WS_MEMN))
#define OC ((bf16_t*)(WSP + WS_OC))
#define SIDEB ((float*)(WSP + WS_SIDE))
#define ACT ((bf16_t*)(WSP + WS_ACT))
#define T5T ((float*)(WSP + WS_T5))
#define ROPEC ((float*)(WSP + WS_ROPE))
#define ROPES (ROPEC + 2048)

    PH_BEGIN
#ifdef PROBE_P0
    for (int rep = 0; rep < 2; ++rep) {
#else
    {
#endif
    int goff = 0;
    wt_matrix(args.in[7], 1024, 2832, (bf16_t*)(WSP + WS_WIN0), false, scrf, gw, NGW, lane, goff);
    wt_matrix(args.in[11], 1024, 1024, (bf16_t*)(WSP + WS_WOUT0), false, scrf, gw, NGW, lane, goff);
    wt_matrix(args.in[12], 1024, 3072, (bf16_t*)(WSP + WS_WIN1), false, scrf, gw, NGW, lane, goff);
    wt_matrix(args.in[18], 1024, 1024, (bf16_t*)(WSP + WS_WOUT1), false, scrf, gw, NGW, lane, goff);
    for (int l = 0; l < 2; ++l) {
        wt_matrix(args.in[19] + (size_t)l * 1024 * 512, 1024, 512, (bf16_t*)(WSP + WS_WQ + l * MiB), false, scrf, gw, NGW, lane, goff);
        wt_matrix(args.in[20] + (size_t)l * 1024 * 1024, 1024, 1024, (bf16_t*)(WSP + WS_WKV + 2 * l * MiB), false, scrf, gw, NGW, lane, goff);
        wt_matrix(args.in[22] + (size_t)l * 512 * 1024, 512, 1024, (bf16_t*)(WSP + WS_WO + l * MiB), false, scrf, gw, NGW, lane, goff);
        wt_matrix(args.in[23] + (size_t)l * 1024 * 5632, 1024, 5632, (bf16_t*)(WSP + WS_WUP + 11 * l * MiB), true, scrf, gw, NGW, lane, goff);
        wt_matrix(args.in[26] + (size_t)l * 2816 * 1024, 2816, 1024, (bf16_t*)(WSP + WS_WDN + 6 * l * MiB), false, scrf, gw, NGW, lane, goff);
    }
    for (int i = gtid; i < 4 * 16384; i += nthreads) {
        const int h = i >> 14, rel = (i & 16383) - 8192, n = rel < 0 ? -rel : rel;
        int bk;
        if (n < 8) bk = n; else { const int lg = 8 + (int)(logf((float)n / 8.0f) / logf(16.0f) * 8.0f); bk = lg < 15 ? lg : 15; }
        bk += rel > 0 ? 16 : 0;
        T5T[i] = t5raw[bk * 4 + h] * LOG2E;
    }
    for (int i = gtid; i < 2048; i += nthreads) {
        const int pos = i >> 4, j = i & 15;
        const float inv = exp2f(-(float)j * (13.287712379549449f / 16.0f));
        const double rev = (double)((float)pos * inv) * 0.15915494309189535; const float fr = (float)(rev - floor(rev));
        ROPEC[i] = __builtin_amdgcn_cosf(fr); ROPES[i] = __builtin_amdgcn_sinf(fr);
    }
    }
    rms_rows(x_in, args.in[3], HN, MTOK, gw, NGW, lane);
#ifdef PROBE_RMS
    rms_rows(x_in, args.in[3], HN, MTOK, gw, NGW, lane);
#endif
    rms_rows(mem, args.in[5], MEMN, BATCH * MEMLEN, gw, NGW, lane);
    rms_rows(mem, args.in[5] + DM, MEMN + (size_t)BATCH * MEMLEN * DM, BATCH * MEMLEN, gw, NGW, lane);
    for (int i = gtid; i < 5 * MTOK / 4; i += nthreads) ((GAS f32x4*)RSB(0))[i] = (f32x4){0.f, 0.f, 0.f, 0.f};
    PH_END
    GSYNC();

#pragma nounroll
    for (int l = 0; l < 2; ++l) {
#ifndef NO_GEMM
        if (l == 0) { PH_BEGIN EpiBf16G E{QKV, QKVP, Gt, args.in[8], 2816, nullptr}; run_gemm(lds, HN, (const bf16_t*)(WSP + WS_WIN0), MTOK, 3072, 1024, E, tid, Bx, Gd); PH_END
            PH_BEGIN EpiBf16G E{KVC(0), 1024, nullptr, nullptr, 0, nullptr}; run_gemm(lds, MEMN, (const bf16_t*)(WSP + WS_WKV), BATCH * MEMLEN, 1024, 1024, E, tid, Bx, Gd); PH_END
            PH_BEGIN EpiBf16G E{KVC(1), 1024, nullptr, nullptr, 0, nullptr}; run_gemm(lds, MEMN + (size_t)BATCH * MEMLEN * DM, (const bf16_t*)(WSP + WS_WKV + 2 * MiB), BATCH * MEMLEN, 1024, 1024, E, tid, Bx, Gd); PH_END }
        else        PH_BEGIN EpiBf16G E{QKV, QKVP, nullptr, nullptr, 0, RSB(2)};  run_gemm(lds, HN, (const bf16_t*)(WSP + WS_WIN1), MTOK, 3072, 1024, E, tid, Bx, Gd); PH_END
#endif
        GSYNC();
        PH_BEGIN
        if (l == 0) {
            qknorm_rows<64, true>(QKV, QKVP, 512, 128, MTOK, 0, args.in[9], args.in[9] + 64, 1.f, 1.f, ROPEC, ROPES, gw, NGW, lane);
            transpose_cols(QKV, QKVP, 640, 128, SEQ, BATCH, VT, scrh, gw, NGW, lane);
#ifdef PROBE_TR
            transpose_cols(QKV, QKVP, 640, 128, SEQ, BATCH, VT, scrh, gw, NGW, lane);
#endif
            transpose_cols(QKV, QKVP, 1280, 512, SEQ, BATCH, VT + (size_t)8 * MiB, scrh, gw, NGW, lane);
#ifdef PROBE_TR
            transpose_cols(QKV, QKVP, 1280, 512, SEQ, BATCH, VT + (size_t)8 * MiB, scrh, gw, NGW, lane);
#endif
            transpose_cols(QKV, QKVP, 1792, 512, SEQ, BATCH, VT + (size_t)40 * MiB, scrh, gw, NGW, lane);
#ifdef PROBE_TR
            transpose_cols(QKV, QKVP, 1792, 512, SEQ, BATCH, VT + (size_t)40 * MiB, scrh, gw, NGW, lane);
#endif
            mlstm_gates_phase(Gt, GPB, WCB, SC, gw, NGW, lane);
            for (int lc = 0; lc < 2; ++lc) {
                qknorm_rows<128, false>(KVC(lc), 1024, 0, 512, BATCH * MEMLEN, 0, args.in[21] + lc * 256, args.in[21] + lc * 256 + 128, 1.f, 1.f, nullptr, nullptr, gw, NGW, lane);
                transpose_cols(KVC(lc), 1024, 512, 512, MEMLEN, BATCH, VTC(lc), scrh, gw, NGW, lane);
#ifdef PROBE_TR
                transpose_cols(KVC(lc), 1024, 512, 512, MEMLEN, BATCH, VTC(lc), scrh, gw, NGW, lane);
#endif
            }
        } else {
            qknorm_rows<64, false>(QKV, QKVP, 512, 512, MTOK, 0, args.in[13], args.in[13] + 64, 1.f, 1.f, nullptr, nullptr, gw, NGW, lane);
            qknorm_rows<64, false>(QKV, QKVP, 2048, 512, MTOK, 0, args.in[15], args.in[15] + 64, 1.f, 1.f, nullptr, nullptr, gw, NGW, lane);
            transpose_cols(QKV, QKVP, 1024, 512, SEQ, BATCH, VT, scrh, gw, NGW, lane);
#ifdef PROBE_TR
            transpose_cols(QKV, QKVP, 1024, 512, SEQ, BATCH, VT, scrh, gw, NGW, lane);
#endif
            transpose_cols(QKV, QKVP, 2560, 512, SEQ, BATCH, VT + (size_t)32 * MiB, scrh, gw, NGW, lane);
#ifdef PROBE_TR
            transpose_cols(QKV, QKVP, 2560, 512, SEQ, BATCH, VT + (size_t)32 * MiB, scrh, gw, NGW, lane);
#endif
        }
        PH_END
        GSYNC();
        if (l == 0) {
            const bf16_t* VaT = VT; const bf16_t* KmT = VT + (size_t)8 * MiB; const bf16_t* VmT = VT + (size_t)40 * MiB;
            (void)VaT; (void)KmT; (void)VmT;
#ifndef NO_MA
            PH_BEGIN mlstm_a2_phase(WCB, KmT, VmT, CST, NST, gw, NGW, r32, hi); PH_END
#ifdef PROBE_MA
            PH_BEGIN mlstm_a2_phase(WCB, KmT, VmT, CST, NST, gw, NGW, r32, hi); PH_END
#endif
#endif
            GSYNC();
            PH_BEGIN mlstm_scan_phase(CST, NST, SC, MST, gtid, nthreads); PH_END
            GSYNC();
#ifndef NO_MC
            PH_BEGIN mlstm_c2_phase(QKV, GPB, VmT, CST, NST, MST, args.in[10], Y, (LAS float*)(lds + wave * 20480), gw, NGW, lane, r32, hi); PH_END
#ifdef PROBE_MC
            PH_BEGIN mlstm_c2_phase(QKV, GPB, VmT, CST, NST, MST, args.in[10], Y, (LAS float*)(lds + wave * 20480), gw, NGW, lane, r32, hi); PH_END
#endif
#if defined(PROBE_B) || defined(PROBE_MLSTM)
            GSYNC();
            PH_BEGIN mlstm_a2_phase(WCB, KmT, VmT, CST, NST, gw, NGW, r32, hi); PH_END
            GSYNC();
            PH_BEGIN mlstm_scan_phase(CST, NST, SC, MST, gtid, nthreads); PH_END
            GSYNC();
            PH_BEGIN mlstm_c2_phase(QKV, GPB, VmT, CST, NST, MST, args.in[10], Y, (LAS float*)(lds + wave * 20480), gw, NGW, lane, r32, hi); PH_END
#endif
#endif
#ifndef NO_GQA
            PH_BEGIN gqa_phase(QKV, VaT, Y, args.in[9], ROPEC, ROPES, lds, tid, wave, r32, hi, Bx, Gd); PH_END
#ifdef PROBE_A
            __syncthreads();
            PH_BEGIN gqa_phase(QKV, VaT, Y, args.in[9], ROPEC, ROPES, lds, tid, wave, r32, hi, Bx, Gd); PH_END
#endif
#endif
        } else {
            const bf16_t* VcT = VT; const bf16_t* VdT = VT + (size_t)32 * MiB;
            (void)VcT; (void)VdT;
#ifndef NO_NA
            PH_BEGIN na_phase(QKV, VcT, Y, args.in[14], args.in[13], args.in[13] + 64, lds, tid, wave, r32, hi, Bx, Gd); PH_END
#if defined(PROBE_B) || defined(PROBE_NA)
            __syncthreads();
            PH_BEGIN na_phase(QKV, VcT, Y, args.in[14], args.in[13], args.in[13] + 64, lds, tid, wave, r32, hi, Bx, Gd); PH_END
#endif
#endif
#ifndef NO_DIFF
            const float lam_init = 0.8f - 0.6f * 0.7408182206817179f;
            PH_BEGIN diff_phase(QKV, VdT, Y, T5T, t5raw, args.in[16], args.in[17], args.in[15], lam_init, (float*)CST, lds, tid, wave, lane, r32, hi, Bx, Gd); PH_END
#ifdef PROBE_A
            __syncthreads();
            PH_BEGIN diff_phase(QKV, VdT, Y, T5T, t5raw, args.in[16], args.in[17], args.in[15], lam_init, (float*)CST, lds, tid, wave, lane, r32, hi, Bx, Gd); PH_END
#endif
#endif
        }
        GSYNC();
#ifndef NO_GEMM
        PH_BEGIN EpiResid E{l == 0 ? (const void*)x_in : (const void*)XB, l == 0 ? 0 : 1, XB, 1, DM, HN, args.in[4] + l * DM, RSB(l == 0 ? 0 : 3)}; run_gemm(lds, Y, (const bf16_t*)(WSP + (l == 0 ? WS_WOUT0 : WS_WOUT1)), MTOK, 1024, 1024, E, tid, Bx, Gd); PH_END
#endif
        GSYNC();
#ifndef NO_GEMM
        PH_BEGIN EpiBf16G E{QC, 512, nullptr, nullptr, 0, RSB(l == 0 ? 0 : 3)}; run_gemm(lds, HN, (const bf16_t*)(WSP + WS_WQ + l * MiB), MTOK, 512, 1024, E, tid, Bx, Gd); PH_END
#endif
        GSYNC();
#ifndef NO_CROSS
        PH_BEGIN cross_phase(QC, KVC(l), VTC(l), OC, args.in[21] + l * 256, lds, tid, wave, r32, hi, Bx, Gd); PH_END
#if defined(PROBE_B) || defined(PROBE_CROSS)
        __syncthreads();
        PH_BEGIN cross_phase(QC, KVC(l), VTC(l), OC, args.in[21] + l * 256, lds, tid, wave, r32, hi, Bx, Gd); PH_END
#endif
#endif
        GSYNC();
#ifndef NO_GEMM
        PH_BEGIN EpiResid E{XB, 1, l == 0 ? XB : XB2, 1, DM, HN, args.in[6] + l * DM, RSB(l == 0 ? 1 : 4)}; run_gemm(lds, OC, (const bf16_t*)(WSP + WS_WO + l * MiB), MTOK, 1024, 512, E, tid, Bx, Gd); PH_END
#endif
        GSYNC();
#ifndef NO_GEMM
        PH_BEGIN EpiConvAct E{ACT, SIDEB, args.in[24] + (size_t)l * 3 * 2 * DFF, args.in[25] + (size_t)l * 2 * DFF, RSB(l == 0 ? 1 : 4)};
                 run_gemm(lds, HN, (const bf16_t*)(WSP + WS_WUP + 11 * l * MiB), MTOK, 2 * DFF, 1024, E, tid, Bx, Gd); PH_END
#endif
        GSYNC();
#ifndef NO_GEMM
        PH_BEGIN EpiResid E{l == 0 ? XB : XB2, 1, l == 0 ? (void*)XB : (void*)out, l == 0 ? 1 : 0, DM, l == 0 ? HN : nullptr, args.in[3] + DM, RSB(2)};
                 run_gemm_fix(lds, ACT, (const bf16_t*)(WSP + WS_WDN + 6 * l * MiB), MTOK, 1024, DFF, E, tid, Bx, Gd, ACT, SIDEB, args.in[24] + (size_t)l * 3 * 2 * DFF, args.in[25] + (size_t)l * 2 * DFF); PH_END
#endif
        GSYNC();
    }
}

#undef WSP
#undef HN
#undef XB
#undef XB2
#undef GPB
#undef WCB
#undef RSB
#undef QKV
#undef VT
#undef Y
#undef CST
#undef Gt
#undef NST
#undef SC
#undef MST
#undef QC
#undef KVC
#undef VTC
#undef MEMN
#undef OC
#undef SIDEB
#undef ACT
#undef T5T
#undef ROPEC
#undef ROPES
#undef x_in
#undef mem
#undef t5raw
#undef out
extern "C" void kernel_launch(void* const* d_in, const int* in_sizes, int n_in, void* d_out, int out_size, void* d_ws, size_t ws_size, hipStream_t stream) {
    static int grid_blocks = 0;
    if (grid_blocks == 0) {
        int dev = 0, cus = 0, per_cu = 0;
        (void)hipGetDevice(&dev);
        (void)hipDeviceGetAttribute(&cus, hipDeviceAttributeMultiprocessorCount, dev);
        (void)hipFuncSetAttribute((const void*)fwd_megakernel, hipFuncAttributeMaxDynamicSharedMemorySize, LDS_BYTES);
        (void)hipOccupancyMaxActiveBlocksPerMultiprocessor(&per_cu, (const void*)fwd_megakernel, NTHR, LDS_BYTES);
        if (per_cu < 1) per_cu = 1;
        grid_blocks = cus * per_cu;
        if (n_in != 27 || ws_size < 1000 * MiB) fprintf(stderr, "kernel_launch: unexpected n_in %d / ws_size %zu\n", n_in, ws_size);
    }
    Args a{};
    for (int i = 0; i < 27; ++i) a.in[i] = (const float*)d_in[i];
    a.out = (float*)d_out; a.ws = (unsigned char*)d_ws;
    (void)hipMemsetAsync(d_ws, 0, 16384, stream);
    void* kargs[] = {&a};
    hipError_t e = hipLaunchCooperativeKernel((const void*)fwd_megakernel, dim3(grid_blocks), dim3(NTHR), kargs, LDS_BYTES, stream);
    if (e != hipSuccess) fprintf(stderr, "cooperative launch failed: %s (grid %d)\n", hipGetErrorString(e), grid_blocks);
}
```

```cpp
#include <hip/hip_runtime.h>
#include <hip/hip_cooperative_groups.h>
#include <cstdio>
#include <cstdint>
namespace cg = cooperative_groups;
namespace pg8 {
#define PG8_LAS __attribute__((address_space(3)))
typedef unsigned short bf16_t;
typedef short bf16x8 __attribute__((ext_vector_type(8)));
typedef float f32x4 __attribute__((ext_vector_type(4)));
typedef unsigned u32x4 __attribute__((ext_vector_type(4)));
constexpr int BM = 256, BK = 64, HALF = 128, HTB = HALF * BK * 2  , STAGE_BYTES = 8 * HTB, NXCD = 8, WGM = 8;

__host__ __device__ __forceinline__ int lds_byte(int r, int c) { const int st = (r >> 4) * 2 + (c >> 5), rr = r & 15, cc = c & 31, ob = rr * 64 + cc * 2; return st * 1024 + (ob ^ (((ob >> 9) & 1) << 5)); }
__host__ __device__ __forceinline__ void stage_rc(int b, int& R, int& C) { const int st = b / 1024, sb = b % 1024, swz = sb ^ (((sb >> 9) & 1) << 5); R = (st >> 1) * 16 + swz / 64; C = (st & 1) * 32 + (swz % 64) / 2; }
__host__ __device__ __forceinline__ int perm32(int rho) { const int n = rho >> 4, i = rho & 15; return 8 * (i >> 2) + 4 * n + (i & 3); }

struct Unit { int pm, pn; };
struct Gemm { const bf16_t* A; const bf16_t* Bt; int M, N, K; };

struct StaticOrder {
    int nM, nN, nwg, G, c;
    __host__ __device__ void init(int M, int N, int G_, int c_) { nM = M / BM; nN = N / BM; nwg = nM * nN; G = G_; c = c_; }
    __host__ __device__ bool next(int i, Unit& u) const {
        const long L = (long)i * G + c; if (L >= nwg) return false;
        int wgid = (int)L; { const int q = nwg / NXCD, r = nwg % NXCD, xcd = wgid % NXCD, off = wgid / NXCD; wgid = (xcd < r ? xcd * (q + 1) : r * (q + 1) + (xcd - r) * q) + off; }
        const int nig = WGM * nN, gid = wgid / nig, fm = gid * WGM, gsz = (nM - fm) < WGM ? (nM - fm) : WGM;
        u.pm = fm + ((wgid % nig) % gsz); u.pn = (wgid % nig) / gsz; return true;
    }
    __device__ __forceinline__ void a_ready(const Unit&) const {}
    __device__ __forceinline__ void done(const Unit&) const {}
};

__device__ __forceinline__ unsigned cvt_pk_bf16(float lo, float hi) { unsigned r; asm volatile("v_cvt_pk_bf16_f32 %0, %1, %2" : "=v"(r) : "v"(lo), "v"(hi)); return r; }
typedef float f32x2 __attribute__((ext_vector_type(2)));
template <class Epi, class Sched, bool ALIGN_EPI = false, bool SP2 = false>
__device__ __forceinline__ void gemm_phase(PG8_LAS unsigned char* lds, const Gemm g, const Sched& S, const Epi& E, int tid_in) {
    int tid_l = tid_in; asm volatile("" : "+v"(tid_l)); const int tid = tid_l, wid = __builtin_amdgcn_readfirstlane(tid >> 6), lane = tid & 63, wr = wid >> 2, wc = wid & 3, fr = lane & 15, fq = lane >> 4;
    const int K = g.K, nt = K / BK;
    unsigned voffA[2], voffB[2];
#pragma unroll
    for (int i = 0; i < 2; ++i) { int R, C; stage_rc(tid * 16 + i * 8192, R, C); const int Rb = Epi::PERM ? ((R & ~31) + perm32(R & 31)) : R;
        voffA[i] = (unsigned)(R * K + C) * 2u; voffB[i] = (unsigned)(Rb * K + C) * 2u; }
    const size_t kstep = (size_t)(BK * 2);
    const size_t hstep = (size_t)HALF * K * 2;
    const size_t tstep = 2 * hstep;
    const unsigned ldsw = (unsigned)wid * 1024u;
    const int aoff = lds_byte(wr * 64 + fr, fq * 8), boff = lds_byte(wc * 32 + fr, fq * 8);
#define PG8_SA(b, h) (((b) * 2 + (h)) * HTB)
#define PG8_SB(b, h) ((4 + (b) * 2 + (h)) * HTB)
#define PG8_STAGE(bufoff, gbase, voff) do { _Pragma("unroll") for (int _i = 0; _i < 2; ++_i) \
        __builtin_amdgcn_global_load_lds((const unsigned*)((const char*)(gbase) + (voff)[_i]), (PG8_LAS unsigned*)(lds + (bufoff) + ldsw + _i * 8192), 16, 0, 0); } while (0)
#define PG8_LDA(dst, b, h) do { _Pragma("unroll") for (int m = 0; m < 4; ++m) _Pragma("unroll") for (int k = 0; k < 2; ++k) dst[m][k] = *(const PG8_LAS bf16x8*)(lds + PG8_SA(b, h) + aoff + m * 2048 + k * 1024); } while (0)
#define PG8_LDB(dst, b, h) do { _Pragma("unroll") for (int n = 0; n < 2; ++n) _Pragma("unroll") for (int k = 0; k < 2; ++k) dst[n][k] = *(const PG8_LAS bf16x8*)(lds + PG8_SB(b, h) + boff + n * 2048 + k * 1024); } while (0)
#define PG8_MMA(ai, bj, At, Bt) do { __builtin_amdgcn_s_setprio(1); _Pragma("unroll") for (int m = 0; m < 4; ++m) _Pragma("unroll") for (int n = 0; n < 2; ++n) _Pragma("unroll") for (int k = 0; k < 2; ++k) \
        acc[ai][bj][m][n] = __builtin_amdgcn_mfma_f32_16x16x32_bf16(Bt[n][k], At[m][k], acc[ai][bj][m][n], 0, 0, 0); __builtin_amdgcn_s_setprio(0); } while (0)
#define PG8_WAIT_V(n) asm volatile("s_waitcnt vmcnt(" #n ")" ::: "memory")
#define PG8_WAIT_L(n) asm volatile("s_waitcnt lgkmcnt(" #n ")" ::: "memory")
#define PG8_BAR __builtin_amdgcn_s_barrier()
#define PG8_SCHED __builtin_amdgcn_sched_barrier(0)
    Unit cur, nxt; int ui = 0;
    if (!S.next(0, cur)) return;
    f32x4 acc[2][2][4][2];
#pragma unroll
    for (int a = 0; a < 2; ++a)
#pragma unroll
        for (int b = 0; b < 2; ++b)
#pragma unroll
            for (int m = 0; m < 4; ++m)
#pragma unroll
                for (int n = 0; n < 2; ++n) acc[a][b][m][n] = (f32x4){0.f, 0.f, 0.f, 0.f};
    bf16x8 At[4][2], B0[2][2], B1[2][2];
    const char* cA = (const char*)g.A + (size_t)cur.pm * tstep; const char* cB = (const char*)g.Bt + (size_t)cur.pn * tstep;
    S.a_ready(cur);
    if constexpr (SP2) {
        PG8_STAGE(PG8_SB(0, 0), cB, voffB); PG8_STAGE(PG8_SB(0, 1), cB + hstep, voffB); PG8_STAGE(PG8_SA(0, 0), cA, voffA); PG8_STAGE(PG8_SA(0, 1), cA + hstep, voffA);
        if (wr == 1) PG8_BAR;
        PG8_WAIT_V(2); PG8_BAR;
        PG8_STAGE(PG8_SB(1, 0), cB + kstep, voffB); PG8_STAGE(PG8_SA(1, 0), cA + kstep, voffA); PG8_STAGE(PG8_SB(1, 1), cB + hstep + kstep, voffB);
        PG8_WAIT_V(6); PG8_BAR;
    } else {
        PG8_STAGE(PG8_SB(0, 0), cB, voffB); PG8_STAGE(PG8_SA(0, 0), cA, voffA); PG8_STAGE(PG8_SB(0, 1), cB + hstep, voffB); PG8_STAGE(PG8_SA(0, 1), cA + hstep, voffA);
        if (wr == 1) PG8_BAR;
        PG8_WAIT_V(4); PG8_BAR;
        PG8_STAGE(PG8_SB(1, 0), cB + kstep, voffB); PG8_STAGE(PG8_SA(1, 0), cA + kstep, voffA); PG8_STAGE(PG8_SB(1, 1), cB + hstep + kstep, voffB);
        PG8_WAIT_V(6); PG8_BAR;
    }
    for (;;) {
        const bool has_next = S.next(ui + 1, nxt);
        const char* nA = has_next ? (const char*)g.A + (size_t)nxt.pm * tstep : cA; const char* nB = has_next ? (const char*)g.Bt + (size_t)nxt.pn * tstep : cB;
        for (int t = 0; t < nt; t += 2) {
            const bool last = (t == nt - 2);
            const char* a1 = cA + (size_t)(t + 1) * kstep;
            const char* a2 = last ? nA : cA + (size_t)(t + 2) * kstep; const char* b2 = last ? nB : cB + (size_t)(t + 2) * kstep;
            const char* a3 = a2 + kstep; const char* b3 = b2 + kstep;
            if (last && has_next) S.a_ready(nxt);
            if constexpr (SP2) {
            PG8_LDB(B0, 0, 0); PG8_LDB(B1, 0, 1); PG8_SCHED; PG8_LDA(At, 0, 0); PG8_STAGE(PG8_SA(1, 1), a1 + hstep, voffA);
            PG8_WAIT_V(8); PG8_WAIT_L(0); PG8_BAR; PG8_MMA(0, 0, At, B0); PG8_MMA(0, 1, At, B1); PG8_BAR; PG8_SCHED;
            PG8_LDA(At, 0, 1); PG8_STAGE(PG8_SB(0, 0), b2, voffB); PG8_STAGE(PG8_SB(0, 1), b2 + hstep, voffB); PG8_STAGE(PG8_SA(0, 0), a2, voffA);
            PG8_WAIT_V(8); PG8_WAIT_L(0); PG8_BAR; PG8_MMA(1, 0, At, B0); PG8_MMA(1, 1, At, B1); PG8_BAR; PG8_SCHED;
            PG8_LDB(B0, 1, 0); PG8_LDB(B1, 1, 1); PG8_SCHED; PG8_LDA(At, 1, 0); PG8_STAGE(PG8_SA(0, 1), a2 + hstep, voffA);
            PG8_WAIT_V(8); PG8_WAIT_L(0); PG8_BAR; PG8_MMA(0, 0, At, B0); PG8_MMA(0, 1, At, B1); PG8_BAR; PG8_SCHED;
            PG8_LDA(At, 1, 1); PG8_STAGE(PG8_SB(1, 0), b3, voffB); PG8_STAGE(PG8_SB(1, 1), b3 + hstep, voffB); PG8_STAGE(PG8_SA(1, 0), a3, voffA);
            PG8_WAIT_V(8); PG8_WAIT_L(0); PG8_BAR; PG8_MMA(1, 0, At, B0); PG8_MMA(1, 1, At, B1); PG8_BAR; PG8_SCHED;
            } else {
            PG8_LDB(B0, 0, 0); PG8_SCHED; PG8_LDA(At, 0, 0); PG8_STAGE(PG8_SA(1, 1), a1 + hstep, voffA);
            PG8_WAIT_L(8); PG8_BAR; PG8_WAIT_L(0); PG8_MMA(0, 0, At, B0); PG8_BAR; PG8_SCHED;
            PG8_LDB(B1, 0, 1); PG8_STAGE(PG8_SB(0, 0), b2, voffB);
            PG8_BAR; PG8_WAIT_L(0); PG8_MMA(0, 1, At, B1); PG8_BAR;
            PG8_LDA(At, 0, 1); PG8_STAGE(PG8_SA(0, 0), a2, voffA);
            PG8_BAR; PG8_WAIT_L(0); PG8_MMA(1, 0, At, B0); PG8_BAR; PG8_SCHED;
            PG8_STAGE(PG8_SB(0, 1), b2 + hstep, voffB);
            PG8_WAIT_V(6); PG8_BAR; PG8_MMA(1, 1, At, B1); PG8_BAR;
            PG8_LDB(B0, 1, 0); PG8_SCHED; PG8_LDA(At, 1, 0); PG8_STAGE(PG8_SA(0, 1), a2 + hstep, voffA);
            PG8_WAIT_L(8); PG8_BAR; PG8_WAIT_L(0); PG8_MMA(0, 0, At, B0); PG8_BAR; PG8_SCHED;
            PG8_LDB(B1, 1, 1); PG8_STAGE(PG8_SB(1, 0), b3, voffB);
            PG8_BAR; PG8_WAIT_L(0); PG8_MMA(0, 1, At, B1); PG8_BAR;
            PG8_LDA(At, 1, 1); PG8_STAGE(PG8_SA(1, 0), a3, voffA);
            PG8_BAR; PG8_WAIT_L(0); PG8_MMA(1, 0, At, B0); PG8_BAR; PG8_SCHED;
            PG8_STAGE(PG8_SB(1, 1), b3 + hstep, voffB);
            PG8_WAIT_V(6); PG8_BAR; PG8_MMA(1, 1, At, B1); PG8_BAR;
            }
        }
        if constexpr (ALIGN_EPI) { if (wr == 0) PG8_BAR; }
        if constexpr (!Epi::AFTER_DRAIN) { E(acc, cur, wr, wc, fr, fq); S.done(cur); }
        if (!has_next) break;
#pragma unroll
        for (int a = 0; a < 2; ++a)
#pragma unroll
            for (int b = 0; b < 2; ++b)
#pragma unroll
                for (int m = 0; m < 4; ++m)
#pragma unroll
                    for (int n = 0; n < 2; ++n) acc[a][b][m][n] = (f32x4){0.f, 0.f, 0.f, 0.f};
        cur = nxt; cA = nA; cB = nB; ++ui;
        if constexpr (ALIGN_EPI) { if (wr == 1) PG8_BAR; }
    }
    PG8_WAIT_V(0);
    if constexpr (!ALIGN_EPI) { if (wr == 0) PG8_BAR; }
    PG8_BAR;
    if constexpr (Epi::AFTER_DRAIN) { E.fused(acc, cur, wr, wc, fr, fq, lds, wid, lane); S.done(cur); }
#undef PG8_SA
#undef PG8_SB
#undef PG8_STAGE
#undef PG8_LDA
#undef PG8_LDB
#undef PG8_MMA
#undef PG8_WAIT_V
#undef PG8_WAIT_L
#undef PG8_BAR
#undef PG8_SCHED
}
}
#define LAS __attribute__((address_space(3)))
typedef unsigned short bf16_t;
typedef short bf16x8 __attribute__((ext_vector_type(8)));
typedef short s16x4 __attribute__((ext_vector_type(4)));
typedef float f32x16 __attribute__((ext_vector_type(16)));
typedef float f32x4 __attribute__((ext_vector_type(4)));
typedef float f32x2 __attribute__((ext_vector_type(2)));
typedef unsigned u32x4 __attribute__((ext_vector_type(4)));
typedef unsigned u32x2 __attribute__((ext_vector_type(2)));
typedef LAS unsigned char* ldsp_t;

constexpr int BATCH = 8, SEQ = 8192, DM = 1024, MTOK = BATCH * SEQ, MEMLEN = 256, DFF = 2816;
constexpr float EPS = 1e-6f, LOG2E = 1.4426950408889634f;
constexpr size_t MiB = 1ull << 20;
constexpr int NWAVES = 8, NTHR = 512;
constexpr int LDS_BYTES = 163840;
constexpr int QKVP = 3072;
constexpr size_t WS_WIN0 = 1 * MiB, WS_WOUT0 = 7 * MiB, WS_WIN1 = 9 * MiB, WS_WOUT1 = 15 * MiB, WS_WQ = 17 * MiB, WS_WKV = 19 * MiB, WS_WO = 23 * MiB,
                 WS_WUP = 25 * MiB, WS_WDN = 47 * MiB, WS_T5 = 59 * MiB, WS_ROPE = 59 * MiB + 512 * 1024;
constexpr size_t WS_HN = 64 * MiB;
constexpr size_t WS_QKV = 192 * MiB;
constexpr size_t WS_VT = 576 * MiB;
constexpr size_t WS_Y = 720 * MiB;
constexpr size_t WS_CST = 848 * MiB;
constexpr size_t WS_G = 976 * MiB, WS_NST = 980 * MiB, WS_SC = 982 * MiB, WS_MST = 983 * MiB;
constexpr size_t WS_QC = 192 * MiB, WS_OC = 272 * MiB, WS_KVC = 994 * MiB, WS_VTC = 1002 * MiB;
constexpr size_t WS_RS = 984 * MiB, WS_MEMN = 986 * MiB;
constexpr size_t WS_ACT = 192 * MiB, WS_SIDE = 544 * MiB;

struct Args { const float* in[27]; float* out; unsigned char* ws; };

#define GAS __attribute__((address_space(1)))
#define LDS_FENCE() asm volatile("s_waitcnt lgkmcnt(0)" ::: "memory")
__device__ __forceinline__ unsigned pk2(float lo, float hi) { typedef __bf16 b2 __attribute__((ext_vector_type(2))); f32x2 v = {lo, hi}; b2 b = __builtin_convertvector(v, b2); return __builtin_bit_cast(unsigned, b); }
__device__ __forceinline__ float bflo(unsigned w) { return __uint_as_float(w << 16); }
__device__ __forceinline__ float bfhi(unsigned w) { return __uint_as_float(w & 0xffff0000u); }
__device__ __forceinline__ float bf1(bf16_t v) { return __uint_as_float(((unsigned)v) << 16); }
__device__ __forceinline__ int lane_id() { int l; asm volatile("v_mbcnt_lo_u32_b32 %0, -1, 0\n\tv_mbcnt_hi_u32_b32 %0, -1, %0" : "=v"(l)); return l; }
__device__ __forceinline__ float bperm(float v, int src) { return __builtin_bit_cast(float, __builtin_amdgcn_ds_bpermute(src << 2, __builtin_bit_cast(int, v))); }
__device__ __forceinline__ float shx(float v, int o) { return bperm(v, lane_id() ^ o); }
__device__ __forceinline__ float shup(float v, int o) { const int l = lane_id(); return bperm(v, l >= o ? l - o : l); }
__device__ __forceinline__ float shdn(float v, int o) { const int l = lane_id(); return bperm(v, l + o < 64 ? l + o : l); }
__device__ __forceinline__ float shl_(float v, int k) { return bperm(v, k); }
__device__ __forceinline__ float wave_sum(float v) {
#pragma unroll
    for (int o = 1; o < 64; o <<= 1) v += shx(v, o);
    return v;
}
__device__ __forceinline__ float ex2(float x) { return __builtin_amdgcn_exp2f(x); }
__device__ __forceinline__ float logsig(float x) { return fminf(x, 0.f) - __logf(1.f + __expf(-fabsf(x))); }
__device__ __forceinline__ int crow(int r, int hi) { return (r & 3) + 8 * (r >> 2) + 4 * hi; }
__device__ __forceinline__ int clampi(int v, int lo, int hi) { return v < lo ? lo : (v > hi ? hi : v); }

struct EpiBf16G {
    static constexpr bool PERM = true, AFTER_DRAIN = false;
    bf16_t* O; int ldc; float* G; const float* gbias; int gcol0; const float* RS;
    __device__ __forceinline__ void operator()(const pg8::f32x4 (&acc)[2][2][4][2], const pg8::Unit& u, int wr, int wc, int fr, int fq) const {
        const int row0 = u.pm * 256 + wr * 64 + fr, col0 = u.pn * 256 + wc * 32 + 8 * fq;
#pragma unroll
        for (int ai = 0; ai < 2; ++ai)
#pragma unroll
            for (int m = 0; m < 4; ++m) {
                const size_t row = (size_t)(row0 + ai * 128 + m * 16);
                const float rstd = RS ? rsqrtf(RS[row] * (1.f / DM) + EPS) : 1.f;
#pragma unroll
                for (int bj = 0; bj < 2; ++bj) {
                    const int col = col0 + bj * 128;
                    const pg8::f32x4 v0 = acc[ai][bj][m][0] * rstd, v1 = acc[ai][bj][m][1] * rstd;
                    if (G != nullptr && col >= gcol0) {
                        if (col < gcol0 + 16) {
                            float* gp = G + row * 16 + (col - gcol0); const float* bp = gbias + (col - gcol0);
                            gp[0] = v0[0] + bp[0]; gp[1] = v0[1] + bp[1]; gp[2] = v0[2] + bp[2]; gp[3] = v0[3] + bp[3];
                            gp[4] = v1[0] + bp[4]; gp[5] = v1[1] + bp[5]; gp[6] = v1[2] + bp[6]; gp[7] = v1[3] + bp[7];
                        }
                    } else {
                        u32x4 w; w.x = pk2(v0[0], v0[1]); w.y = pk2(v0[2], v0[3]); w.z = pk2(v1[0], v1[1]); w.w = pk2(v1[2], v1[3]);
                        *(GAS u32x4*)(O + row * ldc + col) = w;
                    }
                }
            }
    }
};
struct EpiResid {
    static constexpr bool PERM = false, AFTER_DRAIN = false;
    const void* R; int r_bf; void* Out; int o_bf; int ldc; bf16_t* XG; const float* gain; float* RS;
    __device__ __forceinline__ void operator()(const pg8::f32x4 (&acc)[2][2][4][2], const pg8::Unit& u, int wr, int wc, int fr, int fq) const {
        const int row0 = u.pm * 256 + wr * 64 + fr, col0 = u.pn * 256 + wc * 32 + 4 * fq;
        pg8::f32x4 gv[2][2];
        if (XG) {
#pragma unroll
            for (int bj = 0; bj < 2; ++bj)
#pragma unroll
                for (int n = 0; n < 2; ++n) gv[bj][n] = *(const GAS pg8::f32x4*)(gain + col0 + bj * 128 + n * 16);
        }
#pragma unroll
        for (int ai = 0; ai < 2; ++ai)
#pragma unroll
            for (int m = 0; m < 4; ++m) {
                const int row = row0 + ai * 128 + m * 16;
                const size_t off = (size_t)row * ldc + col0;
                float ss = 0.f;
#pragma unroll
                for (int bj = 0; bj < 2; ++bj)
#pragma unroll
                    for (int n = 0; n < 2; ++n) {
                        const size_t o2 = off + bj * 128 + n * 16;
                        pg8::f32x4 r;
                        if (r_bf) { const u32x2 rw = *(const GAS u32x2*)((const bf16_t*)R + o2); r = (pg8::f32x4){bflo(rw.x), bfhi(rw.x), bflo(rw.y), bfhi(rw.y)}; }
                        else r = *(const GAS pg8::f32x4*)((const float*)R + o2);
                        const pg8::f32x4 v = r + acc[ai][bj][m][n];
                        if (o_bf) { u32x2 w; w.x = pk2(v[0], v[1]); w.y = pk2(v[2], v[3]); *(GAS u32x2*)((bf16_t*)Out + o2) = w; }
                        else *(GAS pg8::f32x4*)((float*)Out + o2) = v;
                        if (XG) {
                            ss += (v[0] * v[0] + v[1] * v[1]) + (v[2] * v[2] + v[3] * v[3]);
                            const pg8::f32x4 g = gv[bj][n]; u32x2 w; w.x = pk2(v[0] * g[0], v[1] * g[1]); w.y = pk2(v[2] * g[2], v[3] * g[3]);
                            *(GAS u32x2*)(XG + o2) = w;
                        }
                    }
                if (XG) {
                    ss += shx(ss, 16); ss += shx(ss, 32);
                    if (fq == 0) __hip_atomic_fetch_add(RS + row, ss, __ATOMIC_RELAXED, __HIP_MEMORY_SCOPE_AGENT);
                }
            }
    }
};
#ifndef RESID_ALIGN
#define RESID_ALIGN true
#endif
template <class Epi> struct EpiAlign { static constexpr bool value = true; };
template <> struct EpiAlign<EpiResid> { static constexpr bool value = RESID_ALIGN; };
template <class Epi> __device__ __forceinline__ void run_gemm(ldsp_t lds, const bf16_t* A, const bf16_t* Bt, int M, int N, int K, const Epi& E, int tid, int Bx, int Gd) {
    pg8::Gemm g{A, Bt, M, N, K}; pg8::StaticOrder S; S.init(M, N, Gd, Bx);
    pg8::gemm_phase<Epi, pg8::StaticOrder, EpiAlign<Epi>::value, true>(lds, g, S, E, tid);
}
template <int CTRL> __device__ __forceinline__ float dppf(float x) { return __builtin_bit_cast(float, __builtin_amdgcn_update_dpp(0, __builtin_bit_cast(int, x), CTRL, 0xf, 0xf, true)); }
struct EpiConvAct {
    static constexpr bool PERM = true, AFTER_DRAIN = false;
    bf16_t* ACT; float* SIDE; const float* cw; const float* cb; const float* RS;
    __device__ __forceinline__ void operator()(const pg8::f32x4 (&acc)[2][2][4][2], const pg8::Unit& u, int wr_, int wc_, int fr_, int fq_) const {
        int wr = wr_, wc = wc_, fr = fr_, fq = fq_; asm volatile("" : "+s"(wr), "+s"(wc), "+v"(fr), "+v"(fq));
        const int ch0 = u.pn * 128 + wc * 32 + 8 * fq;
#pragma unroll
        for (int ai = 0; ai < 2; ++ai) {
            const int rowb = u.pm * 256 + ai * 128 + wr * 64, slab = rowb >> 6;
            float rs[4], rsp[4], rsn[4];
#pragma unroll
            for (int m = 0; m < 4; ++m) rs[m] = rsqrtf(RS[rowb + 16 * m + fr] * (1.f / DM) + EPS);
            { float mir[4];
#pragma unroll
              for (int m = 0; m < 4; ++m) mir[m] = dppf<0x140>(rs[m]);
#pragma unroll
              for (int m = 0; m < 4; ++m) { const float a = dppf<0x111>(rs[m]), b = dppf<0x101>(rs[m]); rsp[m] = fr > 0 ? a : mir[m > 0 ? m - 1 : 0]; rsn[m] = fr < 15 ? b : mir[m < 3 ? m + 1 : 3]; } }
#pragma unroll
            for (int mm = 0; mm < 2; ++mm) {
                const int m = mm ? 3 : 0; const int k = mm ? (fr == 14 ? 2 : fr == 15 ? 3 : -1) : (fr == 0 ? 0 : fr == 1 ? 1 : -1);
                if (k >= 0) {
                    float* sp = SIDE + ((size_t)(slab * 4 + k) * 2) * DFF + ch0;
                    *(GAS pg8::f32x4*)sp = acc[ai][0][m][0] * rs[m]; *(GAS pg8::f32x4*)(sp + 4) = acc[ai][0][m][1] * rs[m];
                    *(GAS pg8::f32x4*)(sp + DFF) = acc[ai][1][m][0] * rs[m]; *(GAS pg8::f32x4*)(sp + DFF + 4) = acc[ai][1][m][1] * rs[m];
                }
            }
#pragma unroll
            for (int eh = 0; eh < 2; ++eh) {
                const int chh = ch0 + 4 * eh;
                const pg8::f32x4 W0g = *(const GAS pg8::f32x4*)(cw + chh), W1g = *(const GAS pg8::f32x4*)(cw + 2 * DFF + chh), W2g = *(const GAS pg8::f32x4*)(cw + 4 * DFF + chh), Bg = *(const GAS pg8::f32x4*)(cb + chh);
                const pg8::f32x4 W0v = *(const GAS pg8::f32x4*)(cw + DFF + chh), W1v = *(const GAS pg8::f32x4*)(cw + 3 * DFF + chh), W2v = *(const GAS pg8::f32x4*)(cw + 5 * DFF + chh), Bv = *(const GAS pg8::f32x4*)(cb + DFF + chh);
#pragma unroll
                for (int m = 0; m < 4; ++m) {
                    float r4[4];
#pragma unroll
                    for (int ei = 0; ei < 4; ++ei) {
                        const float xg = acc[ai][0][m][eh][ei], xv = acc[ai][1][m][eh][ei];
                        const float mgp = dppf<0x140>(acc[ai][0][m > 0 ? m - 1 : 0][eh][ei]), mgn = dppf<0x140>(acc[ai][0][m < 3 ? m + 1 : 3][eh][ei]);
                        const float mvp = dppf<0x140>(acc[ai][1][m > 0 ? m - 1 : 0][eh][ei]), mvn = dppf<0x140>(acc[ai][1][m < 3 ? m + 1 : 3][eh][ei]);
                        const float sg = dppf<0x111>(xg), lg = dppf<0x101>(xg), sv = dppf<0x111>(xv), lv = dppf<0x101>(xv);
                        const float pg_ = fr > 0 ? sg : mgp, ng_ = fr < 15 ? lg : mgn, pv_ = fr > 0 ? sv : mvp, nv_ = fr < 15 ? lv : mvn;
                        const float gte = Bg[ei] + W0g[ei] * (pg_ * rsp[m]) + W1g[ei] * (xg * rs[m]) + W2g[ei] * (ng_ * rsn[m]);
                        const float val = Bv[ei] + W0v[ei] * (pv_ * rsp[m]) + W1v[ei] * (xv * rs[m]) + W2v[ei] * (nv_ * rsn[m]);
                        r4[ei] = gte * __builtin_amdgcn_rcpf(1.f + ex2(-gte * LOG2E)) * val;
                    }
                    const int s_ = 16 * m + fr;
                    if (s_ != 0 && s_ != 63) { u32x2 o; o.x = pk2(r4[0], r4[1]); o.y = pk2(r4[2], r4[3]); *(GAS u32x2*)(ACT + (size_t)(rowb + s_) * DFF + chh) = o; }
                }
                asm volatile("" ::: "memory");
            }
        }
    }
};
__device__ __forceinline__ void ffn_fixup(int pm, bf16_t* ACT, const float* SIDE, const float* cw, const float* cb, int tid) {
    for (int idx = tid; idx < 8 * (DFF / 8); idx += NTHR) {
        const int ri = idx / (DFF / 8), ch = (idx % (DFF / 8)) * 8, slab = pm * 4 + (ri >> 1), last = ri & 1, row = slab * 64 + (last ? 63 : 0), t = row % SEQ;
        const float* sc = SIDE + ((size_t)(slab * 4 + (last ? 3 : 0)) * 2) * DFF + ch;
        const float* sp = last ? SIDE + ((size_t)(slab * 4 + 2) * 2) * DFF + ch : SIDE + ((size_t)((slab - 1) * 4 + 3) * 2) * DFF + ch;
        const float* sn = last ? SIDE + ((size_t)((slab + 1) * 4 + 0) * 2) * DFF + ch : SIDE + ((size_t)(slab * 4 + 1) * 2) * DFF + ch;
        const bool hp = last || t > 0, hn = !last || t < SEQ - 1;
        float r[8];
#pragma unroll
        for (int hlf = 0; hlf < 2; ++hlf) {
            const f32x4 z = {0.f, 0.f, 0.f, 0.f};
            const f32x4 cg = *(const GAS f32x4*)(sc + 4 * hlf), cv = *(const GAS f32x4*)(sc + DFF + 4 * hlf);
            const f32x4 pg_ = hp ? *(const GAS f32x4*)(sp + 4 * hlf) : z, pv_ = hp ? *(const GAS f32x4*)(sp + DFF + 4 * hlf) : z;
            const f32x4 ng_ = hn ? *(const GAS f32x4*)(sn + 4 * hlf) : z, nv_ = hn ? *(const GAS f32x4*)(sn + DFF + 4 * hlf) : z;
#pragma unroll
            for (int i = 0; i < 4; ++i) {
                const int c = ch + 4 * hlf + i;
                const float gte = cb[c] + cw[c] * pg_[i] + cw[2 * DFF + c] * cg[i] + cw[4 * DFF + c] * ng_[i];
                const float val = cb[DFF + c] + cw[DFF + c] * pv_[i] + cw[3 * DFF + c] * cv[i] + cw[5 * DFF + c] * nv_[i];
                r[4 * hlf + i] = gte / (1.f + __expf(-gte)) * val;
            }
        }
        u32x4 o; o.x = pk2(r[0], r[1]); o.y = pk2(r[2], r[3]); o.z = pk2(r[4], r[5]); o.w = pk2(r[6], r[7]);
        *(GAS u32x4*)(ACT + (size_t)row * DFF + ch) = o;
    }
}
template <class Epi> __device__ __forceinline__ void run_gemm_fix(ldsp_t lds, const bf16_t* A, const bf16_t* Bt, int M, int N, int K, const Epi& E, int tid, int Bx, int Gd,
                                                                  bf16_t* ACT, const float* SIDE, const float* cw, const float* cb) {
    pg8::Gemm g{A, Bt, M, N, K}; pg8::StaticOrder S; S.init(M, N, Gd, Bx);
    { pg8::Unit u; int last_pm = -1; for (int i = 0; S.next(i, u); ++i) { if (u.pm != last_pm) ffn_fixup(u.pm, ACT, SIDE, cw, cb, tid); last_pm = u.pm; } }
    asm volatile("s_waitcnt vmcnt(0)" ::: "memory"); __syncthreads();
    pg8::gemm_phase<Epi, pg8::StaticOrder, EpiAlign<Epi>::value, true>(lds, g, S, E, tid);
}
#define XB_TMO      128
#define XB_XCNT(j)  (256  + 64 * (j))
#define XB_XSUB(j)  (1280 + 64 * (j))
#define XB_XGEN(j)  (2304 + 64 * (j))
#define XB_TOP      3328
#define XB_TOPGEN   3392
#define XB_SPIN_CAP (1u << 20)
__device__ __forceinline__ unsigned xb_ld(unsigned* p)              { return __hip_atomic_load(p, __ATOMIC_RELAXED, __HIP_MEMORY_SCOPE_AGENT); }
__device__ __forceinline__ unsigned xb_add(unsigned* p, unsigned v) { return __hip_atomic_fetch_add(p, v, __ATOMIC_RELAXED, __HIP_MEMORY_SCOPE_AGENT); }
__device__ __forceinline__ unsigned xb_xcc_id() { return (unsigned)__builtin_amdgcn_s_getreg((3 << 11) | 20) & 0xFu; }
#define XB_SPIN(cond, bar) do { unsigned _sp = 0; while (cond) { __builtin_amdgcn_s_sleep(1); \
    if ((++_sp & 255u) == 0u) { if (xb_ld(&(bar)[XB_TMO])) break; if (_sp > XB_SPIN_CAP) { atomicAdd(&(bar)[XB_TMO], 1u); break; } } } } while (0)
__device__ __forceinline__ void xb_post(unsigned* bar, int wave_s) {
    if (wave_s == 0 && lane_id() == 0) (void)xb_add(&bar[XB_XCNT(xb_xcc_id())], 1u);
}
__device__ __forceinline__ void xb_complete(unsigned* bar, unsigned x, unsigned& nloc, unsigned& nx) {
    const unsigned G = gridDim.x;
    unsigned sum, cnt, mine, sp = 0u;
    for (;;) {
        sum = 0u; cnt = 0u; mine = 0u;
#pragma unroll
        for (unsigned j = 0; j < 16; ++j) { const unsigned c = xb_ld(&bar[XB_XCNT(j)]); sum += c; cnt += (c > 0u) ? 1u : 0u; mine = (j == x) ? c : mine; }
        if (sum == G) break;
        __builtin_amdgcn_s_sleep(1);
        if ((++sp & 255u) == 0u) { if (xb_ld(&bar[XB_TMO])) break; if (sp > XB_SPIN_CAP) { atomicAdd(&bar[XB_TMO], 1u); break; } }
    }
    nloc = mine > 0u ? mine : 1u; nx = cnt > 0u ? cnt : 1u;
}
__device__ __forceinline__ void gbar(unsigned* bar, volatile LAS unsigned* st, int wave_s) {
    asm volatile("s_waitcnt vmcnt(0) lgkmcnt(0)" ::: "memory");
    __syncthreads();
    if (wave_s == 0 && lane_id() == 0) {
        const unsigned x = xb_xcc_id();
        unsigned nloc = st[0], nx = st[1];
        if (nloc == 0u) { xb_complete(bar, x, nloc, nx); st[0] = nloc; st[1] = nx; }
        const unsigned old = xb_add(&bar[XB_XSUB(x)], 1u);
        const unsigned gen = old / nloc;
        if (old + 1u == (gen + 1u) * nloc) {
            __builtin_amdgcn_fence(__ATOMIC_RELEASE, "agent");
            asm volatile("s_waitcnt vmcnt(0)" ::: "memory");
            const unsigned og = xb_add(&bar[XB_TOP], 1u);
            const unsigned tg = og / nx;
            if (og + 1u == (tg + 1u) * nx) xb_add(&bar[XB_TOPGEN], 1u);
            else XB_SPIN(xb_ld(&bar[XB_TOPGEN]) == tg, bar);
            __builtin_amdgcn_fence(__ATOMIC_ACQUIRE, "agent");
            xb_add(&bar[XB_XGEN(x)], 1u);
            asm volatile("s_waitcnt vmcnt(0)" ::: "memory");
        } else {
            XB_SPIN(xb_ld(&bar[XB_XGEN(x)]) == gen, bar);
            __builtin_amdgcn_fence(__ATOMIC_ACQUIRE, "agent");
            asm volatile("s_waitcnt vmcnt(0)" ::: "memory");
        }
    }
    __syncthreads();
}

__device__ __forceinline__ int rowmap_up(int n) { const int ch = n < DFF ? n : n - DFF; return ((ch >> 7) << 8) + (n < DFF ? 0 : 128) + (ch & 127); }
__device__ __forceinline__ void wt_matrix(const float* W, int K, int N, bf16_t* WT, bool upmap, LAS float* scrf, int gw, int NGW, int lane, int& goff) {
    LAS bf16_t* scr = (LAS bf16_t*)scrf;
    const int nblk = (N + 63) / 64, nitems = (K / 64) * nblk;
    const int first = ((gw - goff) % NGW + NGW) % NGW; goff = (goff + nitems) % NGW;
    for (int item = first; item < nitems; item += NGW) {
        const int kb = item / nblk, nb = item % nblk, k0 = 64 * kb, n0 = 64 * nb;
        const int n4 = (lane & 15) * 4, kq = lane >> 4;
        f32x4 v[16];
#pragma unroll
        for (int i = 0; i < 16; ++i) { v[i] = (f32x4){0.f, 0.f, 0.f, 0.f}; if (n0 + n4 < N) v[i] = *(const GAS f32x4*)(W + (size_t)(k0 + 4 * i + kq) * N + n0 + n4); }
#pragma unroll
        for (int i = 0; i < 16; ++i) { LAS unsigned* d = (LAS unsigned*)(scr + (4 * i + kq) * 66 + n4); d[0] = pk2(v[i].x, v[i].y); d[1] = pk2(v[i].z, v[i].w); }
        LDS_FENCE();
        const int c = lane & 7;
#pragma unroll
        for (int j = 0; j < 8; ++j) {
            const int nl = (lane >> 3) + 8 * j, n = n0 + nl;
            const LAS bf16_t* s = scr + (8 * c) * 66 + nl;
            u32x4 o; o.x = (unsigned)s[0] | ((unsigned)s[66] << 16); o.y = (unsigned)s[132] | ((unsigned)s[198] << 16); o.z = (unsigned)s[264] | ((unsigned)s[330] << 16); o.w = (unsigned)s[396] | ((unsigned)s[462] << 16);
            if (n < N) { const int rr = upmap ? rowmap_up(n) : n; *(GAS u32x4*)(WT + (size_t)rr * K + k0 + 8 * c) = o; }
        }
        LDS_FENCE();
    }
}

__device__ __forceinline__ void rms_rows(const float* X, const float* gain, bf16_t* O, int nrows, int gw, int NGW, int lane) {
    for (int m = gw; m < nrows; m += NGW) {
        const GAS f32x4* xr = (const GAS f32x4*)(X + (size_t)m * DM) + lane;
        f32x4 v[4]; float s = 0.f;
#pragma unroll
        for (int j = 0; j < 4; ++j) { v[j] = xr[64 * j]; s += (v[j].x * v[j].x + v[j].y * v[j].y) + (v[j].z * v[j].z + v[j].w * v[j].w); }
        const float rstd = rsqrtf(wave_sum(s) * (1.f / DM) + EPS);
        GAS u32x2* o8 = (GAS u32x2*)(O + (size_t)m * DM) + lane;
#pragma unroll
        for (int j = 0; j < 4; ++j) { const f32x4 g = ((const f32x4*)gain)[lane + 64 * j]; u32x2 w; w.x = pk2(v[j].x * rstd * g.x, v[j].y * rstd * g.y); w.y = pk2(v[j].z * rstd * g.z, v[j].w * rstd * g.w); o8[64 * j] = w; }
    }
}

template <int GD, bool ROPE>
__device__ __forceinline__ void qknorm_rows(bf16_t* X, int pitch, int c0, int ncols, int nrows, int nq_cols, const float* gq, const float* gk, float sq, float sk,
                                            const float* ropeC, const float* ropeS, int gw, int NGW, int lane) {
    constexpr int LPG = GD / 8;
    const int nchunks = (ncols + 511) / 512;
    const int total = nrows * nchunks;
    for (int it0 = gw; it0 < total; it0 += 4 * NGW) {
      u32x4 raws[4];
#pragma unroll
      for (int j = 0; j < 4; ++j) {
          const int it = it0 + j * NGW; raws[j] = (u32x4){0u, 0u, 0u, 0u};
          if (it < total) { const int row = it / nchunks, ch = it % nchunks, c = ch * 512 + lane * 8; if (c < ncols) raws[j] = *(const GAS u32x4*)(X + (size_t)row * pitch + c0 + c); }
      }
#pragma unroll
      for (int j = 0; j < 4; ++j) {
        const int it = it0 + j * NGW; if (it >= total) break;
        const int row = it / nchunks, ch = it % nchunks;
        const int c = ch * 512 + lane * 8; const bool act = c < ncols;
        bf16_t* p = X + (size_t)row * pitch + c0 + c;
        const u32x4 raw = raws[j];
        float v[8]; v[0] = bflo(raw.x); v[1] = bfhi(raw.x); v[2] = bflo(raw.y); v[3] = bfhi(raw.y); v[4] = bflo(raw.z); v[5] = bfhi(raw.z); v[6] = bflo(raw.w); v[7] = bfhi(raw.w);
        float ss = 0.f;
#pragma unroll
        for (int i = 0; i < 8; ++i) ss += v[i] * v[i];
#pragma unroll
        for (int o = 1; o < LPG; o <<= 1) ss += shx(ss, o);
        const float rstd = rsqrtf(ss * (1.f / GD) + EPS);
        const bool isq = c < nq_cols; const float* g = (isq ? gq : gk) + (c % GD); const float sc = isq ? sq : sk;
        const f32x4 g0 = *(const f32x4*)g, g1 = *(const f32x4*)(g + 4);
        v[0] *= rstd * g0.x; v[1] *= rstd * g0.y; v[2] *= rstd * g0.z; v[3] *= rstd * g0.w; v[4] *= rstd * g1.x; v[5] *= rstd * g1.y; v[6] *= rstd * g1.z; v[7] *= rstd * g1.w;
        if (ROPE) {
            const int d = c & 63, half = d >> 5, dd = d & 31, t = row % SEQ, pos = half ? (t & 63) : (t >> 6), j0 = dd & 15; const bool second = dd >= 16;
#pragma unroll
            for (int i = 0; i < 8; ++i) {
                const float xp = shx(v[i], 2); const float cs = ropeC[pos * 16 + j0 + i], sn = ropeS[pos * 16 + j0 + i];
                v[i] = second ? (xp * sn + v[i] * cs) : (v[i] * cs - xp * sn);
            }
        }
        u32x4 o; o.x = pk2(v[0] * sc, v[1] * sc); o.y = pk2(v[2] * sc, v[3] * sc); o.z = pk2(v[4] * sc, v[5] * sc); o.w = pk2(v[6] * sc, v[7] * sc);
        if (act) *(GAS u32x4*)p = o;
      }
    }
}

__device__ __forceinline__ void transpose_cols(const bf16_t* X, int pitch, int c0, int C, int Sx, int nb, bf16_t* T, LAS bf16_t* scr, int gw, int NGW, int lane) {
    const int tt = Sx / 64, ct = C / 64, nitems = nb * tt * ct;
    for (int it = gw; it < nitems; it += NGW) {
        const int cti = it % ct, r = it / ct, tti = r % tt, b = r / tt;
        const bf16_t* src = X + (size_t)(b * Sx + tti * 64) * pitch + c0 + cti * 64;
#pragma unroll
        for (int i = 0; i < 8; ++i) {
            const int tok = 8 * i + (lane >> 3), chn = lane & 7;
            const u32x4 v = *(const GAS u32x4*)(src + (size_t)tok * pitch + chn * 8);
            LAS unsigned* d = (LAS unsigned*)(scr + tok * 66 + chn * 8);
            d[0] = v.x; d[1] = v.y; d[2] = v.z; d[3] = v.w;
        }
        LDS_FENCE();
#pragma unroll
        for (int i = 0; i < 8; ++i) {
            const int col = 8 * i + (lane >> 3), chn = lane & 7;
            const LAS bf16_t* s = scr + (chn * 8) * 66 + col;
            u32x4 o; o.x = (unsigned)s[0] | ((unsigned)s[66] << 16); o.y = (unsigned)s[132] | ((unsigned)s[198] << 16); o.z = (unsigned)s[264] | ((unsigned)s[330] << 16); o.w = (unsigned)s[396] | ((unsigned)s[462] << 16);
            *(GAS u32x4*)(T + (size_t)(b * C + cti * 64 + col) * Sx + tti * 64 + chn * 8) = o;
        }
        LDS_FENCE();
    }
}

__device__ __forceinline__ float bfsel(const u32x4& v, int i) { const unsigned w = i < 2 ? v.x : i < 4 ? v.y : i < 6 ? v.z : v.w; return (i & 1) ? bfhi(w) : bflo(w); }
__device__ __forceinline__ void conv_gate(const bf16_t* U, bf16_t* ACT, int nrows, const float* cw, const float* cb, int gtid, int nthreads) {
    constexpr int nchunk = DFF / 8, RB = 16;
    const int nitems = (nrows / RB) * nchunk;
    for (int idx = gtid; idx < nitems; idx += nthreads) {
        const int rb = idx / nchunk, chk = idx % nchunk, ch = chk * 8, row0 = rb * RB, t0 = row0 % SEQ;
        const int ucol = ((ch >> 7) << 8) + (ch & 127);
        float wg[3][8], wv[3][8], bg[8], bv[8];
#pragma unroll
        for (int j = 0; j < 3; ++j) {
            const f32x4 a0 = *(const GAS f32x4*)(cw + j * 2 * DFF + ch), a1 = *(const GAS f32x4*)(cw + j * 2 * DFF + ch + 4);
            const f32x4 c0 = *(const GAS f32x4*)(cw + j * 2 * DFF + DFF + ch), c1 = *(const GAS f32x4*)(cw + j * 2 * DFF + DFF + ch + 4);
#pragma unroll
            for (int i = 0; i < 4; ++i) { wg[j][i] = a0[i]; wg[j][4 + i] = a1[i]; wv[j][i] = c0[i]; wv[j][4 + i] = c1[i]; }
        }
        { const f32x4 a0 = *(const GAS f32x4*)(cb + ch), a1 = *(const GAS f32x4*)(cb + ch + 4), c0 = *(const GAS f32x4*)(cb + DFF + ch), c1 = *(const GAS f32x4*)(cb + DFF + ch + 4);
#pragma unroll
          for (int i = 0; i < 4; ++i) { bg[i] = a0[i]; bg[4 + i] = a1[i]; bv[i] = c0[i]; bv[4 + i] = c1[i]; } }
        const bf16_t* up = U + (size_t)row0 * (2 * DFF) + ucol;
        const u32x4 z = {0u, 0u, 0u, 0u};
        u32x4 gp = z, vp = z;
        if (t0 > 0) { gp = *(const GAS u32x4*)(up - 2 * DFF); vp = *(const GAS u32x4*)(up - 2 * DFF + 128); }
        u32x4 gc = *(const GAS u32x4*)up, vc = *(const GAS u32x4*)(up + 128);
#pragma unroll 4
        for (int rr = 0; rr < RB; ++rr) {
            u32x4 gn = z, vn = z;
            if (rr < RB - 1 || t0 + RB < SEQ) { gn = *(const GAS u32x4*)(up + (size_t)(rr + 1) * (2 * DFF)); vn = *(const GAS u32x4*)(up + (size_t)(rr + 1) * (2 * DFF) + 128); }
            float r[8];
#pragma unroll
            for (int i = 0; i < 8; ++i) {
                const float gte = bg[i] + bfsel(gp, i) * wg[0][i] + bfsel(gc, i) * wg[1][i] + bfsel(gn, i) * wg[2][i];
                const float val = bv[i] + bfsel(vp, i) * wv[0][i] + bfsel(vc, i) * wv[1][i] + bfsel(vn, i) * wv[2][i];
                r[i] = gte / (1.f + __expf(-gte)) * val;
            }
            u32x4 o; o.x = pk2(r[0], r[1]); o.y = pk2(r[2], r[3]); o.z = pk2(r[4], r[5]); o.w = pk2(r[6], r[7]);
            *(GAS u32x4*)(ACT + (size_t)(row0 + rr) * DFF + ch) = o;
            gp = gc; vp = vc; gc = gn; vc = vn;
        }
    }
}

#define MFMA32(a, b, c) __builtin_amdgcn_mfma_f32_32x32x16_bf16((a), (b), (c), 0, 0, 0)
constexpr int VSTR = 144, ATT_VOFF = 17408;
template <int DQK> __device__ __forceinline__ void tile_qk(f32x16& p0, f32x16& p1, const bf16x8* qf, const LAS unsigned char* Ks, int r32, int hi, float cinit) {
    constexpr int KSTR = (DQK + 8) * 2;
#pragma unroll
    for (int r = 0; r < 16; ++r) { p0[r] = cinit; p1[r] = cinit; }
    const int pr = (r32 & 0x13) | ((r32 & 4) << 1) | ((r32 & 8) >> 1);
    const LAS unsigned char* kb = Ks + pr * KSTR + hi * 16;
#pragma unroll
    for (int d0 = 0; d0 < DQK / 16; ++d0) {
        const bf16x8 a0 = *(const LAS bf16x8*)(kb + d0 * 32), a1 = *(const LAS bf16x8*)(kb + 32 * KSTR + d0 * 32);
        p0 = MFMA32(a0, qf[d0], p0); p1 = MFMA32(a1, qf[d0], p1);
    }
}
template <int DV> __device__ __forceinline__ void tile_softmax_pv(f32x16& p0, f32x16& p1, float& m, float& l, f32x16* o, const LAS unsigned char* Vts, int r32, int hi) {
    float mx = fmaxf(p0[0], p1[0]);
#pragma unroll
    for (int r = 1; r < 16; ++r) mx = fmaxf(mx, fmaxf(p0[r], p1[r]));
    mx = fmaxf(mx, shx(mx, 32));
    const float mn = fmaxf(m, mx), alpha = ex2(m - mn); m = mn;
    float s = 0.f;
#pragma unroll
    for (int r = 0; r < 16; ++r) { p0[r] = ex2(p0[r] - mn); p1[r] = ex2(p1[r] - mn); s += p0[r] + p1[r]; }
    l = l * alpha + s;
    if (__any(alpha != 1.0f)) {
#pragma unroll
        for (int d0 = 0; d0 < DV / 32; ++d0) o[d0] = o[d0] * alpha;
    }
    u32x4 w[4];
    w[0] = (u32x4){pk2(p0[0], p0[1]), pk2(p0[2], p0[3]), pk2(p0[4], p0[5]), pk2(p0[6], p0[7])};
    w[1] = (u32x4){pk2(p0[8], p0[9]), pk2(p0[10], p0[11]), pk2(p0[12], p0[13]), pk2(p0[14], p0[15])};
    w[2] = (u32x4){pk2(p1[0], p1[1]), pk2(p1[2], p1[3]), pk2(p1[4], p1[5]), pk2(p1[6], p1[7])};
    w[3] = (u32x4){pk2(p1[8], p1[9]), pk2(p1[10], p1[11]), pk2(p1[12], p1[13]), pk2(p1[14], p1[15])};
    const LAS unsigned char* vb = Vts + r32 * VSTR + hi * 16;
#pragma unroll
    for (int j = 0; j < 4; ++j) {
        const bf16x8 pb = __builtin_bit_cast(bf16x8, w[j]);
#pragma unroll
        for (int d0 = 0; d0 < DV / 32; ++d0) {
            const bf16x8 a = *(const LAS bf16x8*)(vb + d0 * 32 * VSTR + j * 32);
            o[d0] = MFMA32(a, pb, o[d0]);
        }
    }
}
template <int DV> __device__ __forceinline__ void tile_exp_pv(f32x16& p0, f32x16& p1, f32x16& oe, f32x16* o, const LAS unsigned char* Vts, int r32, int hi) {
#pragma unroll
    for (int r = 0; r < 16; ++r) { p0[r] = ex2(p0[r]); p1[r] = ex2(p1[r]); }
    u32x4 w[4];
    w[0] = (u32x4){pk2(p0[0], p0[1]), pk2(p0[2], p0[3]), pk2(p0[4], p0[5]), pk2(p0[6], p0[7])};
    w[1] = (u32x4){pk2(p0[8], p0[9]), pk2(p0[10], p0[11]), pk2(p0[12], p0[13]), pk2(p0[14], p0[15])};
    w[2] = (u32x4){pk2(p1[0], p1[1]), pk2(p1[2], p1[3]), pk2(p1[4], p1[5]), pk2(p1[6], p1[7])};
    w[3] = (u32x4){pk2(p1[8], p1[9]), pk2(p1[10], p1[11]), pk2(p1[12], p1[13]), pk2(p1[14], p1[15])};
    const u32x4 onesw = {0x3f803f80u, 0x3f803f80u, 0x3f803f80u, 0x3f803f80u};
    const bf16x8 ones = __builtin_bit_cast(bf16x8, onesw);
    const LAS unsigned char* vb = Vts + r32 * VSTR + hi * 16;
#pragma unroll
    for (int j = 0; j < 4; ++j) {
        const bf16x8 pb = __builtin_bit_cast(bf16x8, w[j]);
        oe = MFMA32(ones, pb, oe);
#pragma unroll
        for (int d0 = 0; d0 < DV / 32; ++d0) {
            const bf16x8 a = *(const LAS bf16x8*)(vb + d0 * 32 * VSTR + j * 32);
            o[d0] = MFMA32(a, pb, o[d0]);
        }
    }
}
template <int D> __device__ __forceinline__ float score_bound(const float* gq, const float* gk, int lane) {
    float a = fabsf(gq[lane & (D - 1)]), b = fabsf(gk[lane & (D - 1)]);
    if (D == 128) { a = fmaxf(a, fabsf(gq[64 + lane])); b = fmaxf(b, fabsf(gk[64 + lane])); }
#pragma unroll
    for (int o = 1; o < 64; o <<= 1) { a = fmaxf(a, shx(a, o)); b = fmaxf(b, shx(b, o)); }
    return (D == 64 ? 8.0f : 11.3137085f) * a * b * LOG2E * 1.02f;
}
template <int DQK, int DV> struct KVRegs { u32x4 k[DQK / 64]; u32x4 v[DV / 64]; };
template <int DQK, int DV> __device__ __forceinline__ void kv_load(KVRegs<DQK, DV>& R, const bf16_t* Kt, int kpitch, const bf16_t* Vt, int vtpitch, int tid) {
#pragma unroll
    for (int i = 0; i < DQK / 64; ++i) { const int ci = tid + 512 * i, row = ci / (DQK / 8), cc = ci % (DQK / 8); R.k[i] = *(const GAS u32x4*)(Kt + (size_t)row * kpitch + cc * 8); }
#pragma unroll
    for (int i = 0; i < DV / 64; ++i) { const int ci = tid + 512 * i, d = ci >> 3, cc = ci & 7; R.v[i] = *(const GAS u32x4*)(Vt + (size_t)d * vtpitch + cc * 8); }
}
template <int DQK, int DV> __device__ __forceinline__ void kv_store(const KVRegs<DQK, DV>& R, LAS unsigned char* Ks, LAS unsigned char* Vts, int tid) {
    constexpr int KSTR = (DQK + 8) * 2;
#pragma unroll
    for (int i = 0; i < DQK / 64; ++i) { const int ci = tid + 512 * i, row = ci / (DQK / 8), cc = ci % (DQK / 8); *(LAS u32x4*)(Ks + row * KSTR + cc * 16) = R.k[i]; }
#pragma unroll
    for (int i = 0; i < DV / 64; ++i) { const int ci = tid + 512 * i, d = ci >> 3, cc = ci & 7; *(LAS u32x4*)(Vts + d * VSTR + cc * 16) = R.v[i]; }
}
constexpr int ATT_BUF = 35840;
template <int DQK, int BIAS>
__device__ __forceinline__ void qk_biased(f32x16& p0, f32x16& p1, const bf16x8* qf, const LAS unsigned char* Ks, int t, int q0w, const float* tb, float cneg, float cpos, float sref, int r32, int hi) {
    float cinit = -sref; bool near = false;
    if (BIAS == 1) { const int lo = t * 64 - (q0w + 31), hh = t * 64 + 63 - q0w; if (hh <= -91) cinit = cneg; else if (lo >= 91) cinit = cpos; else near = true; }
    tile_qk<DQK>(p0, p1, qf, Ks, r32, hi, cinit);
    if (BIAS == 1 && near) {
        const GAS float* tq = (const GAS float*)(tb + (t * 64 + 8 * hi - (q0w + r32)));
#pragma unroll
        for (int r = 0; r < 16; ++r) { const int kk = 16 * (r >> 3) + (r & 7); p0[r] += tq[kk]; p1[r] += tq[kk + 32]; }
    }
}
template <int DQK, bool ROPE> __device__ __forceinline__ void qf_norm(bf16x8* qf, const float* qgain, float qscale, int hi, const float* ropeC, const float* ropeS, int prow, int pcol) {
    float v[DQK / 16][8]; float ss = 0.f;
#pragma unroll
    for (int d0 = 0; d0 < DQK / 16; ++d0) { const u32x4 w = __builtin_bit_cast(u32x4, qf[d0]);
        v[d0][0] = bflo(w.x); v[d0][1] = bfhi(w.x); v[d0][2] = bflo(w.y); v[d0][3] = bfhi(w.y); v[d0][4] = bflo(w.z); v[d0][5] = bfhi(w.z); v[d0][6] = bflo(w.w); v[d0][7] = bfhi(w.w);
#pragma unroll
        for (int i = 0; i < 8; ++i) ss += v[d0][i] * v[d0][i]; }
    ss += shx(ss, 32);
    const float rs = rsqrtf(ss * (1.f / DQK) + EPS);
#pragma unroll
    for (int d0 = 0; d0 < DQK / 16; ++d0) { const f32x4 g0 = *(const f32x4*)(qgain + d0 * 16 + hi * 8), g1 = *(const f32x4*)(qgain + d0 * 16 + hi * 8 + 4);
        v[d0][0] *= rs * g0.x; v[d0][1] *= rs * g0.y; v[d0][2] *= rs * g0.z; v[d0][3] *= rs * g0.w; v[d0][4] *= rs * g1.x; v[d0][5] *= rs * g1.y; v[d0][6] *= rs * g1.z; v[d0][7] *= rs * g1.w; }
    if constexpr (ROPE && DQK == 64) {
#pragma unroll
        for (int hf = 0; hf < 2; ++hf) {
            const float* cp = ropeC + (hf ? pcol : prow) * 16 + 8 * hi; const float* sp = ropeS + (hf ? pcol : prow) * 16 + 8 * hi;
            const f32x4 c0 = *(const f32x4*)cp, c1 = *(const f32x4*)(cp + 4), s0 = *(const f32x4*)sp, s1 = *(const f32x4*)(sp + 4);
#pragma unroll
            for (int i = 0; i < 8; ++i) { const float cs = i < 4 ? c0[i & 3] : c1[i & 3], sn = i < 4 ? s0[i & 3] : s1[i & 3]; const float t1 = v[2 * hf][i], t2 = v[2 * hf + 1][i];
                v[2 * hf][i] = t1 * cs - t2 * sn; v[2 * hf + 1][i] = t1 * sn + t2 * cs; }
        }
    }
#pragma unroll
    for (int d0 = 0; d0 < DQK / 16; ++d0) { u32x4 r; r.x = pk2(v[d0][0] * qscale, v[d0][1] * qscale); r.y = pk2(v[d0][2] * qscale, v[d0][3] * qscale); r.z = pk2(v[d0][4] * qscale, v[d0][5] * qscale); r.w = pk2(v[d0][6] * qscale, v[d0][7] * qscale);
        qf[d0] = __builtin_bit_cast(bf16x8, r); }
}
template <int DQK, int DV, int BIAS, bool PIPE, bool FIXED>
__device__ __forceinline__ void attn_pass(const bf16_t* Qw, int qpitch, const bf16_t* Kb, int kpitch, const bf16_t* Vtb, int vtpitch, int ntiles,
                                          int q0w, const float* tb, float cneg, float cpos, ldsp_t lds, float& m, float& l, f32x16* o, int tid, int r32, int hi,
                                          const float* qgain = nullptr, float qscale = 1.f, const float* ropeC = nullptr, const float* ropeS = nullptr, int qprow = 0, int qpcol = 0) {
    bf16x8 qf[DQK / 16];
#pragma unroll
    for (int d0 = 0; d0 < DQK / 16; ++d0) qf[d0] = *(const GAS bf16x8*)(Qw + (size_t)r32 * qpitch + d0 * 16 + hi * 8);
    if (qgain) { if (ropeC) qf_norm<DQK, true>(qf, qgain, qscale, hi, ropeC, ropeS, qprow, qpcol); else qf_norm<DQK, false>(qf, qgain, qscale, hi, nullptr, nullptr, 0, 0); }
    const float sref = FIXED ? m : 0.f;
    if (FIXED) { cneg -= sref; cpos -= sref; }
    m = -1e30f; l = 0.f;
#pragma unroll
    for (int d0 = 0; d0 < DV / 32; ++d0)
#pragma unroll
        for (int r = 0; r < 16; ++r) o[d0][r] = 0.f;
    f32x16 oe;
#pragma unroll
    for (int r = 0; r < 16; ++r) oe[r] = 0.f;
    KVRegs<DQK, DV> R; kv_load<DQK, DV>(R, Kb, kpitch, Vtb, vtpitch, tid);
    __syncthreads();
    kv_store<DQK, DV>(R, lds, lds + ATT_VOFF, tid);
    if (ntiles > 1) kv_load<DQK, DV>(R, Kb + (size_t)64 * kpitch, kpitch, Vtb + 64, vtpitch, tid);
    __syncthreads();
    int cur = 0;
    if constexpr (PIPE) {
    f32x16 pa0, pa1, pb0, pb1;
    qk_biased<DQK, BIAS>(pa0, pa1, qf, lds, 0, q0w, tb, cneg, cpos, sref, r32, hi);
#define ATT_STEP(P0, P1, N0, N1, T) do { \
        const int t_ = (T); const int nxt = cur == 2 * ATT_BUF ? 0 : cur + ATT_BUF; \
        if (t_ + 1 < ntiles) kv_store<DQK, DV>(R, lds + nxt, lds + nxt + ATT_VOFF, tid); \
        __syncthreads(); \
        if (t_ + 2 < ntiles) kv_load<DQK, DV>(R, Kb + (size_t)(t_ + 2) * 64 * kpitch, kpitch, Vtb + (t_ + 2) * 64, vtpitch, tid); \
        if (t_ + 1 < ntiles) qk_biased<DQK, BIAS>(N0, N1, qf, lds + nxt, t_ + 1, q0w, tb, cneg, cpos, sref, r32, hi); \
        if constexpr (FIXED) tile_exp_pv<DV>(P0, P1, oe, o, lds + cur + ATT_VOFF, r32, hi); else tile_softmax_pv<DV>(P0, P1, m, l, o, lds + cur + ATT_VOFF, r32, hi); \
        cur = nxt; } while (0)
#pragma nounroll
    for (int t = 0; t < ntiles; t += 2) {
        ATT_STEP(pa0, pa1, pb0, pb1, t);
        ATT_STEP(pb0, pb1, pa0, pa1, t + 1);
    }
#undef ATT_STEP
    } else {
#pragma nounroll
    for (int t = 0; t < ntiles; ++t) {
        const int nxt = cur == 2 * ATT_BUF ? 0 : cur + ATT_BUF;
        if (t + 1 < ntiles) kv_store<DQK, DV>(R, lds + nxt, lds + nxt + ATT_VOFF, tid);
        __syncthreads();
        if (t + 2 < ntiles) kv_load<DQK, DV>(R, Kb + (size_t)(t + 2) * 64 * kpitch, kpitch, Vtb + (t + 2) * 64, vtpitch, tid);
        f32x16 p0, p1;
        qk_biased<DQK, BIAS>(p0, p1, qf, lds + cur, t, q0w, tb, cneg, cpos, sref, r32, hi);
        if constexpr (FIXED) tile_exp_pv<DV>(p0, p1, oe, o, lds + cur + ATT_VOFF, r32, hi); else tile_softmax_pv<DV>(p0, p1, m, l, o, lds + cur + ATT_VOFF, r32, hi);
        cur = nxt;
    }
    }
    if constexpr (FIXED) l = 0.5f * oe[0];
}
template <int DV> __device__ __forceinline__ void store_o(const f32x16* o, float inv, bf16_t* Ow, int opitch, int r32, int hi) {
#pragma unroll
    for (int d0 = 0; d0 < DV / 32; ++d0)
#pragma unroll
        for (int g = 0; g < 4; ++g) {
            u32x2 w; w.x = pk2(o[d0][4 * g] * inv, o[d0][4 * g + 1] * inv); w.y = pk2(o[d0][4 * g + 2] * inv, o[d0][4 * g + 3] * inv);
            *(GAS u32x2*)(Ow + (size_t)r32 * opitch + 32 * d0 + 8 * g + 4 * hi) = w;
        }
}
__device__ __forceinline__ int vcu_of(int bx, int G) { return (G % 8 == 0) ? (bx % 8) * (G / 8) + bx / 8 : bx; }

__device__ __forceinline__ void gqa_phase(const bf16_t* QKV, const bf16_t* VaT, bf16_t* Y, const float* gqk, const float* ropeC, const float* ropeS, ldsp_t lds, int tid, int wave, int r32, int hi, int Bx, int Gd) {
    const int G = Gd, vcu = vcu_of(Bx, G);
    const float sref = score_bound<64>(gqk, gqk + 64, tid & 63);
    for (int u = vcu; u < BATCH * 8 * 32; u += G) {
        const int qt = u & 31, hq = (u >> 5) & 3, kvh = (u >> 7) & 1, b = u >> 8, hqf = kvh * 4 + hq;
        const size_t row0 = (size_t)b * SEQ + qt * 256 + wave * 32;
        float m = sref, l; f32x16 o[2];
        if (sref < 40.f) attn_pass<64, 64, 0, true, true>(QKV + row0 * QKVP + hqf * 64, QKVP, QKV + (size_t)b * SEQ * QKVP + 512 + kvh * 64, QKVP, VaT + (size_t)((b * 2 + kvh) * 64) * SEQ, SEQ, SEQ / 64,
                             0, nullptr, 0.f, 0.f, lds, m, l, o, tid, r32, hi, gqk, 0.125f * LOG2E, ropeC, ropeS, (qt * 256 + wave * 32 + r32) >> 6, (wave * 32 + r32) & 63);
        else attn_pass<64, 64, 0, false, false>(QKV + row0 * QKVP + hqf * 64, QKVP, QKV + (size_t)b * SEQ * QKVP + 512 + kvh * 64, QKVP, VaT + (size_t)((b * 2 + kvh) * 64) * SEQ, SEQ, SEQ / 64,
                             0, nullptr, 0.f, 0.f, lds, m, l, o, tid, r32, hi, gqk, 0.125f * LOG2E, ropeC, ropeS, (qt * 256 + wave * 32 + r32) >> 6, (wave * 32 + r32) & 63);
        l += shx(l, 32);
        store_o<64>(o, 1.f / l, Y + row0 * DM + hqf * 64, DM, r32, hi);
    }
}
__device__ __forceinline__ void cross_phase(const bf16_t* QC, const bf16_t* KVC, const bf16_t* VTC, bf16_t* OC, const float* gqk, ldsp_t lds, int tid, int wave, int r32, int hi, int Bx, int Gd) {
    const int G = Gd, vcu = vcu_of(Bx, G);
    const float sref = score_bound<128>(gqk, gqk + 128, tid & 63);
    for (int u = vcu; u < BATCH * 4 * 32; u += G) {
        const int qt = u & 31, h = (u >> 5) & 3, b = u >> 7;
        const size_t row0 = (size_t)b * SEQ + qt * 256 + wave * 32;
        float m = sref, l; f32x16 o[4];
        if (sref < 40.f) attn_pass<128, 128, 0, false, true>(QC + row0 * 512 + h * 128, 512, KVC + (size_t)b * MEMLEN * 1024 + h * 128, 1024, VTC + (size_t)((b * 4 + h) * 128) * MEMLEN, MEMLEN, MEMLEN / 64,
                               0, nullptr, 0.f, 0.f, lds, m, l, o, tid, r32, hi, gqk, 0.08838834764831845f * LOG2E);
        else attn_pass<128, 128, 0, false, false>(QC + row0 * 512 + h * 128, 512, KVC + (size_t)b * MEMLEN * 1024 + h * 128, 1024, VTC + (size_t)((b * 4 + h) * 128) * MEMLEN, MEMLEN, MEMLEN / 64,
                               0, nullptr, 0.f, 0.f, lds, m, l, o, tid, r32, hi, gqk, 0.08838834764831845f * LOG2E);
        l += shx(l, 32);
        store_o<128>(o, 1.f / l, OC + row0 * 512 + h * 128, 512, r32, hi);
    }
}
__device__ __forceinline__ void diff_phase(const bf16_t* QKV, const bf16_t* VdT, bf16_t* Y, const float* t5tab, const float* t5raw, const float* lamv, const float* dgain, const float* gqk, float lam_init,
                                           float* stash, ldsp_t lds, int tid, int wave, int lane, int r32, int hi, int Bx, int Gd) {
    const int G = Gd, vcu = vcu_of(Bx, G);
    f32x4* st = (f32x4*)(stash + ((size_t)(Bx * NWAVES + wave) * 64 + lane) * 64);
    float bmax = fmaxf(fabsf(t5raw[lane]), fabsf(t5raw[64 + lane]));
#pragma unroll
    for (int o = 1; o < 64; o <<= 1) bmax = fmaxf(bmax, shx(bmax, o));
    const float sref = score_bound<64>(gqk, gqk + 64, lane) + bmax * LOG2E;
    const float lam = __expf(wave_sum(lamv[lane] * lamv[64 + lane])) - __expf(wave_sum(lamv[128 + lane] * lamv[192 + lane])) + lam_init;
    for (int u = vcu; u < BATCH * 4 * 32; u += G) {
        const int qt = u & 31, h = (u >> 5) & 3, b = u >> 7;
        const int q0w = qt * 256 + wave * 32; const size_t row0 = (size_t)b * SEQ + q0w;
        const float cneg = t5raw[15 * 4 + h] * LOG2E, cpos = t5raw[31 * 4 + h] * LOG2E; const float* tb = t5tab + h * 16384 + 8192;
        const bf16_t* Kb = QKV + (size_t)b * SEQ * QKVP + 2048 + h * 128; const bf16_t* Vt = VdT + (size_t)((b * 4 + h) * 128) * SEQ;
        float m, l; f32x16 o1[4];
        { f32x16 o2[4];
          m = sref;
          if (sref < 40.f) attn_pass<64, 128, 1, false, true>(QKV + row0 * QKVP + 1536 + h * 128 + 64, QKVP, Kb + 64, QKVP, Vt, SEQ, SEQ / 64, q0w, tb, cneg, cpos, lds, m, l, o2, tid, r32, hi, gqk, 0.125f * LOG2E);
          else attn_pass<64, 128, 1, false, false>(QKV + row0 * QKVP + 1536 + h * 128 + 64, QKVP, Kb + 64, QKVP, Vt, SEQ, SEQ / 64, q0w, tb, cneg, cpos, lds, m, l, o2, tid, r32, hi, gqk, 0.125f * LOG2E);
          l += shx(l, 32);
          const float inv = lam / l;
#pragma unroll
          for (int d0 = 0; d0 < 4; ++d0)
#pragma unroll
              for (int g = 0; g < 4; ++g) st[d0 * 4 + g] = (f32x4){o2[d0][4 * g] * inv, o2[d0][4 * g + 1] * inv, o2[d0][4 * g + 2] * inv, o2[d0][4 * g + 3] * inv}; }
        asm volatile("" ::: "memory");
        m = sref;
        if (sref < 40.f) attn_pass<64, 128, 1, false, true>(QKV + row0 * QKVP + 1536 + h * 128, QKVP, Kb, QKVP, Vt, SEQ, SEQ / 64, q0w, tb, cneg, cpos, lds, m, l, o1, tid, r32, hi, gqk, 0.125f * LOG2E);
        else attn_pass<64, 128, 1, false, false>(QKV + row0 * QKVP + 1536 + h * 128, QKVP, Kb, QKVP, Vt, SEQ, SEQ / 64, q0w, tb, cneg, cpos, lds, m, l, o1, tid, r32, hi, gqk, 0.125f * LOG2E);
        l += shx(l, 32);
        float ss = 0.f;
        { const float inv = 1.f / l;
#pragma unroll
          for (int d0 = 0; d0 < 4; ++d0)
#pragma unroll
              for (int g = 0; g < 4; ++g) { const f32x4 sv = st[d0 * 4 + g];
#pragma unroll
                  for (int e = 0; e < 4; ++e) { const float v = o1[d0][4 * g + e] * inv - sv[e]; o1[d0][4 * g + e] = v; ss += v * v; } } }
        asm volatile("" ::: "memory");
        ss += shx(ss, 32);
        const float rstd = rsqrtf(ss * (1.f / 128.f) + EPS) * (1.f - lam_init);
        bf16_t* Ow = Y + row0 * DM + 512 + h * 128;
#pragma unroll
        for (int d0 = 0; d0 < 4; ++d0)
#pragma unroll
            for (int g = 0; g < 4; ++g) {
                const int d = 32 * d0 + 8 * g + 4 * hi; const f32x4 gn = *(const f32x4*)(dgain + h * 128 + d);
                u32x2 w; w.x = pk2(o1[d0][4 * g] * rstd * gn.x, o1[d0][4 * g + 1] * rstd * gn.y); w.y = pk2(o1[d0][4 * g + 2] * rstd * gn.z, o1[d0][4 * g + 3] * rstd * gn.w);
                *(u32x2*)(Ow + (size_t)r32 * DM + d) = w;
            }
    }
}
__device__ __forceinline__ void na_phase(const bf16_t* QKV, const bf16_t* VcT, bf16_t* Y, const float* rpb, const float* gq, const float* gk, ldsp_t lds, int tid, int wave, int r32, int hi, int Bx, int Gd) {
    const int G = Gd, vcu = vcu_of(Bx, G);
    LAS unsigned char* Ks = lds; LAS unsigned char* Vts = lds + ATT_VOFF; LAS float* rpl = (LAS float*)(lds + 3 * ATT_BUF);
    float bmax = 0.f;
    for (int i = (tid & 63); i < 8 * 465; i += 64) bmax = fmaxf(bmax, fabsf(rpb[i]));
#pragma unroll
    for (int o_ = 1; o_ < 64; o_ <<= 1) bmax = fmaxf(bmax, shx(bmax, o_));
    const float sref = score_bound<64>(gq, gk, tid & 63) + bmax * LOG2E;
    const bool fast = sref < 40.f;
    for (int u = vcu; u < BATCH * 8 * 32; u += G) {
        const int rg = u & 31, h = (u >> 5) & 7, b = u >> 8;
        const int R0 = 4 * rg, Rw = R0 + (wave >> 1), qc = 32 * (wave & 1) + r32;
        const int r0w = clampi(Rw - 4, 0, 120), ulo = clampi(R0 - 4, 0, 120), uhi = clampi(R0 - 1, 0, 120) + 7, nt = uhi - ulo + 1;
        const int c0 = clampi(qc - 8, 0, 48);
        __syncthreads();
        if (tid < 465) rpl[tid] = rpb[h * 465 + tid] * LOG2E;
        const size_t row0 = (size_t)b * SEQ + Rw * 64 + 32 * (wave & 1);
        const bf16_t* Qw = QKV + row0 * QKVP + h * 64;
        const bf16_t* Kb = QKV + ((size_t)b * SEQ + ulo * 64) * QKVP + 512 + h * 64;
        const bf16_t* Vtb = VcT + (size_t)((b * 8 + h) * 64) * SEQ + ulo * 64;
        bf16x8 qf[4];
#pragma unroll
        for (int d0 = 0; d0 < 4; ++d0) qf[d0] = *(const GAS bf16x8*)(Qw + (size_t)r32 * QKVP + d0 * 16 + hi * 8);
        qf_norm<64, false>(qf, gq, 0.125f * LOG2E, hi, nullptr, nullptr, 0, 0);
        float m = -1e30f, l = 0.f; f32x16 o[2], oe;
#pragma unroll
        for (int r = 0; r < 16; ++r) oe[r] = 0.f;
#pragma unroll
        for (int d0 = 0; d0 < 2; ++d0)
#pragma unroll
            for (int r = 0; r < 16; ++r) o[d0][r] = 0.f;
        KVRegs<64, 64> R; kv_load<64, 64>(R, Kb, QKVP, Vtb, SEQ, tid);
        for (int t = 0; t < nt; ++t) {
            __syncthreads();
            kv_store<64, 64>(R, Ks, Vts, tid);
            __syncthreads();
            if (t + 1 < nt) kv_load<64, 64>(R, Kb + (size_t)(t + 1) * 64 * QKVP, QKVP, Vtb + (t + 1) * 64, SEQ, tid);
            const int kr = ulo + t;
            if (kr >= r0w && kr < r0w + 8) {
                f32x16 p0, p1; tile_qk<64>(p0, p1, qf, Ks, r32, hi, fast ? -sref : 0.f);
                const LAS float* rp = rpl + (kr - Rw + 7) * 31 + 15 - qc;
#pragma unroll
                for (int r = 0; r < 16; ++r) {
                    const int kc = 16 * (r >> 3) + (r & 7) + 8 * hi, kc2 = kc + 32;
                    p0[r] = (kc >= c0 && kc < c0 + 16) ? p0[r] + rp[kc] : -1e30f;
                    p1[r] = (kc2 >= c0 && kc2 < c0 + 16) ? p1[r] + rp[kc2] : -1e30f;
                }
                if (fast) tile_exp_pv<64>(p0, p1, oe, o, Vts, r32, hi); else tile_softmax_pv<64>(p0, p1, m, l, o, Vts, r32, hi);
            }
        }
        l += shx(l, 32); if (fast) l = oe[0];
        store_o<64>(o, 1.f / l, Y + row0 * DM + h * 64, DM, r32, hi);
    }
}

constexpr float KSCALE = 0.08838834764831845f;
__device__ __forceinline__ void mlstm_a_phase(const float* Gt, const bf16_t* KmT, const bf16_t* VmT, bf16_t* CST, float* NST, float* SC, ldsp_t lds, int tid, int wave, int r32, int hi, int Bx, int Gd) {
    LAS float* fl = (LAS float*)lds; LAS float* ab = fl + 128; LAS float* wv = fl + 256;
    for (int u = Bx; u < BATCH * 4 * 64 * 2; u += Gd) {
        const int dir = u & 1, c = (u >> 1) & 63, h = (u >> 7) & 3, b = u >> 9, chain = (b * 4 + h) * 2 + dir;
        const size_t tok0 = (size_t)b * SEQ + c * 128;
        __syncthreads();
        float gi = 0.f;
        if (tid < 128) { const float* gp = Gt + (tok0 + tid) * 16 + dir * 8 + h; gi = gp[0]; fl[tid] = logsig(gp[4]); }
        __syncthreads();
        if (tid < 128) {
            float cum = 0.f, tot = 0.f;
            for (int s = 0; s < 128; ++s) { const float f = fl[s]; tot += f; if (dir == 0 ? s <= tid : s >= tid) cum += f; }
            ab[tid] = tot - cum + gi;
            if (tid == 0) SC[(chain * 64 + c) * 2] = tot;
        }
        __syncthreads();
        if (tid < 128) {
            float mx = -1e30f;
            for (int s = 0; s < 128; ++s) mx = fmaxf(mx, ab[s]);
            wv[tid] = __expf(ab[tid] - mx) * KSCALE;
            if (tid == 0) SC[(chain * 64 + c) * 2 + 1] = mx;
        }
        __syncthreads();
        const int mi = wave >> 1, nh = wave & 1;
        const bf16_t* vp = VmT + ((size_t)((b * 4 + h) * 128 + 32 * mi + r32)) * SEQ + c * 128 + 8 * hi;
        const bf16_t* kp = KmT + ((size_t)((b * 4 + h) * 128 + 64 * nh + r32)) * SEQ + c * 128 + 8 * hi;
        f32x16 acc[2];
#pragma unroll
        for (int ni = 0; ni < 2; ++ni)
#pragma unroll
            for (int r = 0; r < 16; ++r) acc[ni][r] = 0.f;
#pragma unroll
        for (int ks = 0; ks < 8; ++ks) {
            const bf16x8 a = *(const GAS bf16x8*)(vp + 16 * ks);
            const LAS float* wp = wv + 16 * ks + 8 * hi;
#pragma unroll
            for (int ni = 0; ni < 2; ++ni) {
                const u32x4 kr = *(const GAS u32x4*)(kp + (size_t)(32 * ni) * SEQ + 16 * ks);
                u32x4 kw; kw.x = pk2(bflo(kr.x) * wp[0], bfhi(kr.x) * wp[1]); kw.y = pk2(bflo(kr.y) * wp[2], bfhi(kr.y) * wp[3]);
                kw.z = pk2(bflo(kr.z) * wp[4], bfhi(kr.z) * wp[5]); kw.w = pk2(bflo(kr.w) * wp[6], bfhi(kr.w) * wp[7]);
                acc[ni] = MFMA32(a, __builtin_bit_cast(bf16x8, kw), acc[ni]);
            }
        }
        bf16_t* cp = CST + (size_t)(chain * 64 + c) * 16384;
#pragma unroll
        for (int ni = 0; ni < 2; ++ni)
#pragma unroll
            for (int r = 0; r < 16; ++r) { const int dv = 32 * mi + crow(r, hi), dk = 64 * nh + 32 * ni + r32; cp[dv * 128 + dk] = (bf16_t)(pk2(acc[ni][r], 0.f) & 0xffffu); }
        if (tid < 128) {
            const bf16_t* kq = KmT + ((size_t)((b * 4 + h) * 128 + tid)) * SEQ + c * 128; float s = 0.f;
#pragma unroll 4
            for (int j = 0; j < 16; ++j) { const u32x4 kr = *(const GAS u32x4*)(kq + 8 * j); const LAS float* wp = wv + 8 * j;
                s += bflo(kr.x) * wp[0] + bfhi(kr.x) * wp[1] + bflo(kr.y) * wp[2] + bfhi(kr.y) * wp[3] + bflo(kr.z) * wp[4] + bfhi(kr.z) * wp[5] + bflo(kr.w) * wp[6] + bfhi(kr.w) * wp[7]; }
            NST[(size_t)(chain * 64 + c) * 128 + tid] = s;
        }
    }
}
__device__ __forceinline__ void mlstm_scan_phase(bf16_t* CST, float* NST, const float* SC, float* MST, int gtid, int nthreads) {
    for (int idx = gtid; idx < 64 * 2048; idx += nthreads) {
        const int chain = idx >> 11, e = idx & 2047, dir = chain & 1; const bool hasn = e < 16;
        float C[8], N[8]; float m = 0.f;
#pragma unroll
        for (int i = 0; i < 8; ++i) { C[i] = 0.f; N[i] = 0.f; }
        for (int step = 0; step < 64; ++step) {
            const int c = dir ? 63 - step : step; const int base = chain * 64 + c;
            const float g = SC[base * 2], ml = SC[base * 2 + 1];
            const float mn = fmaxf(g + m, ml), dec = __expf(g + m - mn), sc = __expf(ml - mn);
            GAS u32x4* p = (GAS u32x4*)(CST + (size_t)base * 16384 + e * 8);
            const u32x4 kl = *p;
            u32x4 st; st.x = pk2(C[0], C[1]); st.y = pk2(C[2], C[3]); st.z = pk2(C[4], C[5]); st.w = pk2(C[6], C[7]);
            *p = st;
            if (e == 0) MST[base] = m;
            C[0] = dec * C[0] + sc * bflo(kl.x); C[1] = dec * C[1] + sc * bfhi(kl.x); C[2] = dec * C[2] + sc * bflo(kl.y); C[3] = dec * C[3] + sc * bfhi(kl.y);
            C[4] = dec * C[4] + sc * bflo(kl.z); C[5] = dec * C[5] + sc * bfhi(kl.z); C[6] = dec * C[6] + sc * bflo(kl.w); C[7] = dec * C[7] + sc * bfhi(kl.w);
            if (hasn) {
                GAS f32x4* q = (GAS f32x4*)(NST + (size_t)base * 128 + e * 8);
                const f32x4 n0 = q[0], n1 = q[1];
                q[0] = (f32x4){N[0], N[1], N[2], N[3]}; q[1] = (f32x4){N[4], N[5], N[6], N[7]};
                N[0] = dec * N[0] + sc * n0.x; N[1] = dec * N[1] + sc * n0.y; N[2] = dec * N[2] + sc * n0.z; N[3] = dec * N[3] + sc * n0.w;
                N[4] = dec * N[4] + sc * n1.x; N[5] = dec * N[5] + sc * n1.y; N[6] = dec * N[6] + sc * n1.z; N[7] = dec * N[7] + sc * n1.w;
            }
            m = mn;
        }
    }
}
__device__ __forceinline__ void mlstm_c_phase(const bf16_t* QKV, const float* Gt, const bf16_t* VmT, const bf16_t* CST, const float* NST, const float* MST, const float* mgain, bf16_t* Y,
                                              ldsp_t lds, int tid, int wave, int r32, int hi, int Bx, int Gd) {
    LAS float* bc = (LAS float*)lds; LAS float* rbv = bc + 128; LAS float* aif = bc + 256; LAS float* aib = bc + 384; LAS float* nst = bc + 512; LAS float* hb = bc + 1024;
    const int dir = wave >> 2, tb = wave & 3, t = 32 * tb + r32;
    for (int u = Bx; u < BATCH * 4 * 64; u += Gd) {
        const int c = u & 63, h = (u >> 6) & 3, b = u >> 8;
        const size_t tok0 = (size_t)b * SEQ + c * 128;
        __syncthreads();
        float i_f = 0.f, i_b = 0.f;
        if (tid < 128) { const float* gp = Gt + (tok0 + tid) * 16 + h; i_f = gp[0]; hb[tid] = logsig(gp[4]); i_b = gp[8]; hb[128 + tid] = logsig(gp[12]); }
        else if (tid < 384) { const int d2 = (tid - 128) >> 7, dk = (tid - 128) & 127; nst[d2 * 128 + dk] = NST[(size_t)(((b * 4 + h) * 2 + d2) * 64 + c) * 128 + dk]; }
        __syncthreads();
        if (tid < 128) {
            float cf = 0.f, cb = 0.f;
            for (int s = 0; s < 128; ++s) { if (s <= tid) cf += hb[s]; if (s >= tid) cb += hb[128 + s]; }
            bc[tid] = cf; rbv[tid] = cb; aif[tid] = i_f - cf; aib[tid] = i_b - cb;
        }
        __syncthreads();
        const int chain = (b * 4 + h) * 2 + dir;
        const float mst = MST[chain * 64 + c];
        const float bct = dir ? rbv[t] : bc[t];
        const LAS float* ai = dir ? aib : aif;
        bf16x8 qf[8];
        { const bf16_t* qp = QKV + (tok0 + t) * QKVP + 768 + h * 128 + 8 * hi;
#pragma unroll
          for (int k0 = 0; k0 < 8; ++k0) qf[k0] = *(const GAS bf16x8*)(qp + 16 * k0); }
        float mmax = -1e30f;
        for (int s = hi; s < 128; s += 2) { const bool ok = dir == 0 ? s <= t : s >= t; const float v = bct + ai[s]; if (ok) mmax = fmaxf(mmax, v); }
        mmax = fmaxf(mmax, shx(mmax, 32));
        const float mt = fmaxf(mmax, bct + mst);
        const float inter = __expf(bct + mst - mt);
        f32x16 acc[4];
#pragma unroll
        for (int d0 = 0; d0 < 4; ++d0) {
#pragma unroll
            for (int r = 0; r < 16; ++r) acc[d0][r] = 0.f;
            const bf16_t* cp = CST + (size_t)(chain * 64 + c) * 16384 + (32 * d0 + r32) * 128 + 8 * hi;
#pragma unroll
            for (int k0 = 0; k0 < 8; ++k0) { const bf16x8 cf = *(const GAS bf16x8*)(cp + 16 * k0); acc[d0] = MFMA32(cf, qf[k0], acc[d0]); }
            acc[d0] = acc[d0] * inter;
        }
        float den = 0.f;
#pragma unroll 1
        for (int sb = 0; sb < 4; ++sb) {
            const bool actv = dir == 0 ? sb <= tb : sb >= tb;
            if (!actv) continue;
            f32x16 p;
#pragma unroll
            for (int r = 0; r < 16; ++r) p[r] = 0.f;
            const bf16_t* kp = QKV + (tok0 + 32 * sb + r32) * QKVP + 1280 + h * 128 + 8 * hi;
#pragma unroll
            for (int k0 = 0; k0 < 8; ++k0) { const bf16x8 kf = *(const GAS bf16x8*)(kp + 16 * k0); p = MFMA32(kf, qf[k0], p); }
#pragma unroll
            for (int r = 0; r < 16; ++r) { const int s = 32 * sb + crow(r, hi); const bool ok = dir == 0 ? s <= t : s >= t;
                const float v = ok ? p[r] * KSCALE * __expf(bct + ai[s] - mt) : 0.f; p[r] = v; den += v; }
#pragma unroll
            for (int j = 0; j < 2; ++j) {
                const u32x4 w = {pk2(p[8 * j], p[8 * j + 1]), pk2(p[8 * j + 2], p[8 * j + 3]), pk2(p[8 * j + 4], p[8 * j + 5]), pk2(p[8 * j + 6], p[8 * j + 7])};
                const bf16x8 pb = __builtin_bit_cast(bf16x8, w);
#pragma unroll
                for (int d0 = 0; d0 < 4; ++d0) {
                    const bf16_t* vp = VmT + ((size_t)((b * 4 + h) * 128 + 32 * d0 + r32)) * SEQ + c * 128 + 32 * sb + 16 * j + 4 * hi;
                    const s16x4 lo = *(const GAS s16x4*)vp, h4 = *(const GAS s16x4*)(vp + 8);
                    const bf16x8 a = {lo[0], lo[1], lo[2], lo[3], h4[0], h4[1], h4[2], h4[3]};
                    acc[d0] = MFMA32(a, pb, acc[d0]);
                }
            }
        }
        den += shx(den, 32);
        float qn = 0.f;
#pragma unroll
        for (int k0 = 0; k0 < 8; ++k0) { const u32x4 qw = __builtin_bit_cast(u32x4, qf[k0]); const LAS float* np = nst + dir * 128 + 16 * k0 + 8 * hi;
            qn += bflo(qw.x) * np[0] + bfhi(qw.x) * np[1] + bflo(qw.y) * np[2] + bfhi(qw.y) * np[3] + bflo(qw.z) * np[4] + bfhi(qw.z) * np[5] + bflo(qw.w) * np[6] + bfhi(qw.w) * np[7]; }
        qn += shx(qn, 32);
        den += inter * qn;
        const float rden = 1.f / fmaxf(fabsf(den), __expf(-mt));
        __syncthreads();
        if (dir == 1) {
#pragma unroll
            for (int d0 = 0; d0 < 4; ++d0)
#pragma unroll
                for (int r = 0; r < 16; ++r) hb[(32 * d0 + crow(r, hi)) * 129 + t] = acc[d0][r] * rden;
        }
        __syncthreads();
        if (dir == 0) {
            float ss = 0.f;
#pragma unroll
            for (int d0 = 0; d0 < 4; ++d0)
#pragma unroll
                for (int r = 0; r < 16; ++r) { const float v = acc[d0][r] * rden + hb[(32 * d0 + crow(r, hi)) * 129 + t]; acc[d0][r] = v; ss += v * v; }
            ss += shx(ss, 32);
            const float rstd = rsqrtf(ss * (1.f / 128.f) + EPS);
            const bf16_t* op = QKV + (tok0 + t) * QKVP + 2304 + h * 128; bf16_t* yp = Y + (tok0 + t) * DM + 512 + h * 128;
#pragma unroll
            for (int d0 = 0; d0 < 4; ++d0)
#pragma unroll
                for (int g = 0; g < 4; ++g) {
                    const int d = 32 * d0 + 8 * g + 4 * hi; const f32x4 gn = *(const f32x4*)(mgain + h * 128 + d); const u32x2 ow = *(const u32x2*)(op + d);
                    const float s0 = 1.f / (1.f + __expf(-bflo(ow.x))), s1 = 1.f / (1.f + __expf(-bfhi(ow.x))), s2 = 1.f / (1.f + __expf(-bflo(ow.y))), s3 = 1.f / (1.f + __expf(-bfhi(ow.y)));
                    u32x2 w; w.x = pk2(acc[d0][4 * g] * rstd * gn.x * s0, acc[d0][4 * g + 1] * rstd * gn.y * s1); w.y = pk2(acc[d0][4 * g + 2] * rstd * gn.z * s2, acc[d0][4 * g + 3] * rstd * gn.w * s3);
                    *(u32x2*)(yp + d) = w;
                }
        }
    }
}
constexpr size_t WS_GP = 1008 * MiB, WS_WC = 1016 * MiB;
__device__ __forceinline__ void mlstm_gates_phase(const float* Gt, float* GP, float* WC, float* SC, int gw, int NGW, int lane) {
    for (int u = gw; u < BATCH * 4 * 64; u += NGW) {
        const int c = u & 63, h = (u >> 6) & 3, b = u >> 8;
        const size_t tok0 = (size_t)b * SEQ + c * 128;
        const int t0 = 2 * lane;
        const float* g0 = Gt + (tok0 + t0) * 16 + h; const float* g1 = g0 + 16;
        const float if0 = g0[0], ff0 = logsig(g0[4]), ib0 = g0[8], fb0 = logsig(g0[12]);
        const float if1 = g1[0], ff1 = logsig(g1[4]), ib1 = g1[8], fb1 = logsig(g1[12]);
        const float sf = ff0 + ff1, sb = fb0 + fb1;
        float xf = sf, xb = sb;
#pragma unroll
        for (int o = 1; o < 64; o <<= 1) { const float yf = shup(xf, o), yb = shup(xb, o); if (lane >= o) { xf += yf; xb += yb; } }
        const float totf = shl_(xf, 63), totb = shl_(xb, 63);
        const float bc0 = (xf - sf) + ff0, bc1 = bc0 + ff1;
        const float cb0 = (xb - sb) + fb0, cb1 = cb0 + fb1;
        const float rb0 = totb - cb0 + fb0, rb1 = totb - cb1 + fb1;
        const float aif0 = if0 - bc0, aif1 = if1 - bc1, aib0 = ib0 - rb0, aib1 = ib1 - rb1;
        float px = fmaxf(aif0, aif1);
#pragma unroll
        for (int o = 1; o < 64; o <<= 1) { const float y = shup(px, o); if (lane >= o) px = fmaxf(px, y); }
        float pe = shup(px, 1); if (lane == 0) pe = -3.0e38f;
        const float pmf0 = fmaxf(pe, aif0), pmf1 = fmaxf(pmf0, aif1);
        float sx = fmaxf(aib0, aib1);
#pragma unroll
        for (int o = 1; o < 64; o <<= 1) { const float y = shdn(sx, o); if (lane + o < 64) sx = fmaxf(sx, y); }
        float se = shdn(sx, 1); if (lane == 63) se = -3.0e38f;
        const float pmb1 = fmaxf(se, aib1), pmb0 = fmaxf(pmb1, aib0);
        const float mxf = shl_(px, 63), mxb = shl_(sx, 0);
        const float wf0 = __expf(aif0 - mxf) * KSCALE, wf1 = __expf(aif1 - mxf) * KSCALE, wb0 = __expf(aib0 - mxb) * KSCALE, wb1 = __expf(aib1 - mxb) * KSCALE;
        GAS f32x4* gp = (GAS f32x4*)(GP + ((size_t)(b * 4 + h) * SEQ + c * 128 + t0) * 8);
        gp[0] = (f32x4){bc0, rb0, aif0, aib0}; gp[1] = (f32x4){wf0, wb0, pmf0, pmb0}; gp[2] = (f32x4){bc1, rb1, aif1, aib1}; gp[3] = (f32x4){wf1, wb1, pmf1, pmb1};
        const int chf = (b * 4 + h) * 2;
        *(GAS f32x2*)(WC + (size_t)(chf * 64 + c) * 128 + t0) = (f32x2){wf0, wf1};
        *(GAS f32x2*)(WC + (size_t)((chf + 1) * 64 + c) * 128 + t0) = (f32x2){wb0, wb1};
        if (lane == 0) { SC[(chf * 64 + c) * 2] = totf; SC[(chf * 64 + c) * 2 + 1] = totf + mxf; SC[((chf + 1) * 64 + c) * 2] = totb; SC[((chf + 1) * 64 + c) * 2 + 1] = totb + mxb; }
    }
}
__device__ __forceinline__ void mlstm_a2_phase(const float* WC, const bf16_t* KmT, const bf16_t* VmT, bf16_t* CST, float* NST, int gw, int NGW, int r32, int hi) {
    for (int u = gw; u < BATCH * 4 * 64 * 2 * 4; u += NGW) {
        const int mi = u & 3, dir = (u >> 2) & 1, c = (u >> 3) & 63, h = (u >> 9) & 3, b = u >> 11, chain = (b * 4 + h) * 2 + dir;
        const float* wp0 = WC + (size_t)(chain * 64 + c) * 128 + 8 * hi;
        const bf16_t* vp = VmT + ((size_t)((b * 4 + h) * 128 + 32 * mi + r32)) * SEQ + c * 128 + 8 * hi;
        const bf16_t* kp = KmT + ((size_t)((b * 4 + h) * 128 + r32)) * SEQ + c * 128 + 8 * hi;
        f32x16 acc[4]; float nl[4];
#pragma unroll
        for (int ni = 0; ni < 4; ++ni) { nl[ni] = 0.f;
#pragma unroll
            for (int r = 0; r < 16; ++r) acc[ni][r] = 0.f; }
#pragma unroll 2
        for (int ks = 0; ks < 8; ++ks) {
            const bf16x8 a = *(const GAS bf16x8*)(vp + 16 * ks);
            const f32x4 w0 = *(const GAS f32x4*)(wp0 + 16 * ks), w1 = *(const GAS f32x4*)(wp0 + 16 * ks + 4);
#pragma unroll
            for (int ni = 0; ni < 4; ++ni) {
                const u32x4 kr = *(const GAS u32x4*)(kp + (size_t)(32 * ni) * SEQ + 16 * ks);
                const float p0 = bflo(kr.x) * w0.x, p1 = bfhi(kr.x) * w0.y, p2 = bflo(kr.y) * w0.z, p3 = bfhi(kr.y) * w0.w, p4 = bflo(kr.z) * w1.x, p5 = bfhi(kr.z) * w1.y, p6 = bflo(kr.w) * w1.z, p7 = bfhi(kr.w) * w1.w;
                nl[ni] += ((p0 + p1) + (p2 + p3)) + ((p4 + p5) + (p6 + p7));
                const u32x4 kw = {pk2(p0, p1), pk2(p2, p3), pk2(p4, p5), pk2(p6, p7)};
                acc[ni] = MFMA32(a, __builtin_bit_cast(bf16x8, kw), acc[ni]);
            }
        }
#pragma unroll
        for (int g = 0; g < 4; ++g) {
            GAS bf16_t* cp = (GAS bf16_t*)(CST + (size_t)(chain * 64 + c) * 16384 + (32 * mi + 8 * g + 4 * hi) * 128 + r32);
            asm volatile("" : "+v"(cp));
#pragma unroll
            for (int e = 0; e < 4; ++e)
#pragma unroll
                for (int ni = 0; ni < 4; ++ni) cp[e * 128 + 32 * ni] = (bf16_t)(pk2(acc[ni][4 * g + e], 0.f) & 0xffffu);
        }
#pragma unroll
        for (int ni = 0; ni < 4; ++ni) { const float v = nl[ni] + shx(nl[ni], 32); if (mi == 0 && hi == 0) NST[(size_t)(chain * 64 + c) * 128 + 32 * ni + r32] = v; }
    }
}
__device__ __forceinline__ void mlstm_c2_phase(const bf16_t* QKV, const float* GP, const bf16_t* VmT, const bf16_t* CST, const float* NST, const float* MST, const float* mgain, bf16_t* Y,
                                               LAS float* wl, int gw, int NGW, int lane_, int r32_, int hi_) {
    LAS float* hs = wl; LAS float* aiL = wl + 4096;
    for (int u = gw; u < BATCH * 4 * 64 * 4; u += NGW) {
        const int lane = lane_id(), r32 = lane & 31, hi = lane >> 5; (void)lane_; (void)r32_; (void)hi_;
        const int tb = u & 3, c = (u >> 2) & 63, h = (u >> 8) & 3, b = u >> 10, t = 32 * tb + r32;
        const size_t tok0 = (size_t)b * SEQ + c * 128;
        const GAS f32x4* gpc = (const GAS f32x4*)(GP + ((size_t)(b * 4 + h) * SEQ + c * 128) * 8);
        { const f32x4 e0 = gpc[(2 * lane) * 2], e1 = gpc[(2 * lane + 1) * 2]; aiL[2 * lane] = e0.z; aiL[128 + 2 * lane] = e0.w; aiL[2 * lane + 1] = e1.z; aiL[128 + 2 * lane + 1] = e1.w; }
        LDS_FENCE();
#pragma nounroll
        for (int dir_ = 0; dir_ < 2; ++dir_) {
            int dir = dir_; asm volatile("" : "+s"(dir));
            bf16x8 qf[8];
            { const bf16_t* qp = QKV + (tok0 + t) * QKVP + 768 + h * 128 + 8 * hi;
#pragma unroll
              for (int k0 = 0; k0 < 8; ++k0) qf[k0] = *(const GAS bf16x8*)(qp + 16 * k0); }
            const int chain = (b * 4 + h) * 2 + dir;
            const float mst = MST[chain * 64 + c];
            const GAS float* gpt = (const GAS float*)(gpc + t * 2) + dir;
            const float bct = gpt[0], pm = gpt[6];
            const LAS float* ai = aiL + dir * 128;
            const float mt = fmaxf(bct + pm, bct + mst), inter = __expf(bct + mst - mt);
            f32x16 acc[4];
#pragma unroll
            for (int d0 = 0; d0 < 4; ++d0) {
#pragma unroll
                for (int r = 0; r < 16; ++r) acc[d0][r] = 0.f;
                const bf16_t* cp = CST + (size_t)(chain * 64 + c) * 16384 + (32 * d0 + r32) * 128 + 8 * hi;
#pragma unroll
                for (int k0 = 0; k0 < 8; ++k0) { const bf16x8 cf = *(const GAS bf16x8*)(cp + 16 * k0); acc[d0] = MFMA32(cf, qf[k0], acc[d0]); }
                acc[d0] = acc[d0] * inter;
            }
            float den = 0.f;
#pragma unroll 1
            for (int sb = 0; sb < 4; ++sb) {
                const bool actv = dir == 0 ? sb <= tb : sb >= tb;
                if (!actv) continue;
                f32x16 p;
#pragma unroll
                for (int r = 0; r < 16; ++r) p[r] = 0.f;
                const int pr = (r32 & 0x13) | ((r32 & 4) << 1) | ((r32 & 8) >> 1);
                const bf16_t* kp = QKV + (tok0 + 32 * sb + pr) * QKVP + 1280 + h * 128 + 8 * hi;
#pragma unroll
                for (int k0 = 0; k0 < 8; ++k0) { const bf16x8 kf = *(const GAS bf16x8*)(kp + 16 * k0); p = MFMA32(kf, qf[k0], p); }
#pragma unroll
                for (int r = 0; r < 16; ++r) { const int s = 32 * sb + 16 * (r >> 3) + 8 * hi + (r & 7); const bool ok = dir == 0 ? s <= t : s >= t;
                    const float v = ok ? p[r] * KSCALE * __expf(bct + ai[s] - mt) : 0.f; p[r] = v; den += v; }
#pragma unroll
                for (int j = 0; j < 2; ++j) {
                    const u32x4 w = {pk2(p[8 * j], p[8 * j + 1]), pk2(p[8 * j + 2], p[8 * j + 3]), pk2(p[8 * j + 4], p[8 * j + 5]), pk2(p[8 * j + 6], p[8 * j + 7])};
                    const bf16x8 pb = __builtin_bit_cast(bf16x8, w);
#pragma unroll
                    for (int d0 = 0; d0 < 4; ++d0) {
                        const bf16_t* vp = VmT + ((size_t)((b * 4 + h) * 128 + 32 * d0 + r32)) * SEQ + c * 128 + 32 * sb + 16 * j + 8 * hi;
                        const bf16x8 a = *(const GAS bf16x8*)vp;
                        acc[d0] = MFMA32(a, pb, acc[d0]);
                    }
                }
            }
            den += shx(den, 32);
            float qn = 0.f;
            { const float* np0 = NST + (size_t)(chain * 64 + c) * 128 + 8 * hi;
#pragma unroll
              for (int k0 = 0; k0 < 8; ++k0) { const u32x4 qw = __builtin_bit_cast(u32x4, qf[k0]); const f32x4 n0 = *(const GAS f32x4*)(np0 + 16 * k0), n1 = *(const GAS f32x4*)(np0 + 16 * k0 + 4);
                  qn += bflo(qw.x) * n0.x + bfhi(qw.x) * n0.y + bflo(qw.y) * n0.z + bfhi(qw.y) * n0.w + bflo(qw.z) * n1.x + bfhi(qw.z) * n1.y + bflo(qw.w) * n1.z + bfhi(qw.w) * n1.w; } }
            qn += shx(qn, 32);
            den += inter * qn;
            const float rden = 1.f / fmaxf(fabsf(den), __expf(-mt));
            if (dir == 0) {
#pragma unroll
                for (int d0 = 0; d0 < 4; ++d0)
#pragma unroll
                    for (int r = 0; r < 16; ++r) hs[(32 * d0 + crow(r, hi)) * 32 + r32] = acc[d0][r] * rden;
                LDS_FENCE();
            } else {
                float ss = 0.f;
#pragma unroll
                for (int d0 = 0; d0 < 4; ++d0)
#pragma unroll
                    for (int r = 0; r < 16; ++r) { const float v = acc[d0][r] * rden + hs[(32 * d0 + crow(r, hi)) * 32 + r32]; acc[d0][r] = v; ss += v * v; }
                ss += shx(ss, 32);
                const float rstd = rsqrtf(ss * (1.f / 128.f) + EPS);
                const bf16_t* op = QKV + (tok0 + t) * QKVP + 2304 + h * 128; bf16_t* yp = Y + (tok0 + t) * DM + 512 + h * 128;
#pragma unroll
                for (int d0 = 0; d0 < 4; ++d0)
#pragma unroll
                    for (int g = 0; g < 4; ++g) {
                        const int d = 32 * d0 + 8 * g + 4 * hi; const f32x4 gn = *(const GAS f32x4*)(mgain + h * 128 + d); const u32x2 ow = *(const GAS u32x2*)(op + d);
                        const float s0 = 1.f / (1.f + __expf(-bflo(ow.x))), s1 = 1.f / (1.f + __expf(-bfhi(ow.x))), s2 = 1.f / (1.f + __expf(-bflo(ow.y))), s3 = 1.f / (1.f + __expf(-bfhi(ow.y)));
                        u32x2 w; w.x = pk2(acc[d0][4 * g] * rstd * gn.x * s0, acc[d0][4 * g + 1] * rstd * gn.y * s1); w.y = pk2(acc[d0][4 * g + 2] * rstd * gn.z * s2, acc[d0][4 * g + 3] * rstd * gn.w * s3);
                        *(GAS u32x2*)(yp + d) = w;
                    }
            }
        }
        LDS_FENCE();
    }
}
#define PH_BEGIN { int tid = wave_s * 64 + lane_id(); asm volatile("" : "+v"(tid)); const int lane = tid & 63, wave = wave_s, r32 = lane & 31, hi = lane >> 5; \
    int Bx = blockIdx.x, Gd = gridDim.x; asm volatile("" : "+s"(Bx), "+s"(Gd)); \
    const int gw = Bx * NWAVES + wave, NGW = Gd * NWAVES, gtid = Bx * NTHR + tid, nthreads = Gd * NTHR; \
    LAS float* scrf = (LAS float*)(lds + wave * 16384); LAS bf16_t* scrh = (LAS bf16_t*)(lds + wave * 16384); \
    (void)Bx; (void)Gd; (void)lane; (void)r32; (void)hi; (void)gw; (void)NGW; (void)gtid; (void)nthreads; (void)scrf; (void)scrh;
#define PH_END }
__global__ void __launch_bounds__(NTHR) fwd_megakernel(Args args) {
    extern __shared__ __attribute__((aligned(16))) unsigned char lds_raw[];
    cg::grid_group grid = cg::this_grid();
    ldsp_t lds = (ldsp_t)lds_raw;
    const int wave_s = __builtin_amdgcn_readfirstlane(threadIdx.x >> 6);
    unsigned char* wsl = args.ws;
    if (threadIdx.x < 2) ((LAS unsigned*)(lds + (LDS_BYTES - 16)))[threadIdx.x] = 0u;
    __syncthreads();
    xb_post((unsigned*)wsl, wave_s);
    grid.sync();
#define GSYNC() do { gbar((unsigned*)wsl, (volatile LAS unsigned*)(lds + (LDS_BYTES - 16)), wave_s); asm volatile("" : "+s"(wsl)); } while (0)
#define WSP wsl
#define x_in (args.in[0])
#define mem (args.in[1])
#define t5raw (args.in[2])
#define out (args.out)
#define RSB(k) ((float*)(WSP + WS_RS) + (size_t)(k) * MTOK)
#define GPB ((float*)(WSP + WS_GP))
#define WCB ((float*)(WSP + WS_WC))
#define XB ((bf16_t*)out + (size_t)MTOK * DM)
#define XB2 ((bf16_t*)(WSP + WS_Y))
#define HN ((bf16_t*)(WSP + WS_HN))
#define QKV ((bf16_t*)(WSP + WS_QKV))
#define VT ((bf16_t*)(WSP + WS_VT))
#define Y ((bf16_t*)(WSP + WS_Y))
#define CST ((bf16_t*)(WSP + WS_CST))
#define Gt ((float*)(WSP + WS_G))
#define NST ((float*)(WSP + WS_NST))
#define SC ((float*)(WSP + WS_SC))
#define MST ((float*)(WSP + WS_MST))
#define QC ((bf16_t*)(WSP + WS_QC))
#define KVC(l_) ((bf16_t*)(WSP + WS_KVC + (size_t)(l_) * 4 * MiB))
#define VTC(l_) ((bf16_t*)(WSP + WS_VTC + (size_t)(l_) * 2 * MiB))
#define MEMN ((bf16_t*)(WSP + WS_MEMN))
#define OC ((bf16_t*)(WSP + WS_OC))
#define SIDEB ((float*)(WSP + WS_SIDE))
#define ACT ((bf16_t*)(WSP + WS_ACT))
#define T5T ((float*)(WSP + WS_T5))
#define ROPEC ((float*)(WSP + WS_ROPE))
#define ROPES (ROPEC + 2048)

    PH_BEGIN
#ifdef PROBE_P0
    for (int rep = 0; rep < 2; ++rep) {
#else
    {
#endif
    int goff = 0;
    wt_matrix(args.in[7], 1024, 2832, (bf16_t*)(WSP + WS_WIN0), false, scrf, gw, NGW, lane, goff);
    wt_matrix(args.in[11], 1024, 1024, (bf16_t*)(WSP + WS_WOUT0), false, scrf, gw, NGW, lane, goff);
    wt_matrix(args.in[12], 1024, 3072, (bf16_t*)(WSP + WS_WIN1), false, scrf, gw, NGW, lane, goff);
    wt_matrix(args.in[18], 1024, 1024, (bf16_t*)(WSP + WS_WOUT1), false, scrf, gw, NGW, lane, goff);
    for (int l = 0; l < 2; ++l) {
        wt_matrix(args.in[19] + (size_t)l * 1024 * 512, 1024, 512, (bf16_t*)(WSP + WS_WQ + l * MiB), false, scrf, gw, NGW, lane, goff);
        wt_matrix(args.in[20] + (size_t)l * 1024 * 1024, 1024, 1024, (bf16_t*)(WSP + WS_WKV + 2 * l * MiB), false, scrf, gw, NGW, lane, goff);
        wt_matrix(args.in[22] + (size_t)l * 512 * 1024, 512, 1024, (bf16_t*)(WSP + WS_WO + l * MiB), false, scrf, gw, NGW, lane, goff);
        wt_matrix(args.in[23] + (size_t)l * 1024 * 5632, 1024, 5632, (bf16_t*)(WSP + WS_WUP + 11 * l * MiB), true, scrf, gw, NGW, lane, goff);
        wt_matrix(args.in[26] + (size_t)l * 2816 * 1024, 2816, 1024, (bf16_t*)(WSP + WS_WDN + 6 * l * MiB), false, scrf, gw, NGW, lane, goff);
    }
    for (int i = gtid; i < 4 * 16384; i += nthreads) {
        const int h = i >> 14, rel = (i & 16383) - 8192, n = rel < 0 ? -rel : rel;
        int bk;
        if (n < 8) bk = n; else { const int lg = 8 + (int)(logf((float)n / 8.0f) / logf(16.0f) * 8.0f); bk = lg < 15 ? lg : 15; }
        bk += rel > 0 ? 16 : 0;
        T5T[i] = t5raw[bk * 4 + h] * LOG2E;
    }
    for (int i = gtid; i < 2048; i += nthreads) {
        const int pos = i >> 4, j = i & 15;
        const float inv = exp2f(-(float)j * (13.287712379549449f / 16.0f));
        const double rev = (double)((float)pos * inv) * 0.15915494309189535; const float fr = (float)(rev - floor(rev));
        ROPEC[i] = __builtin_amdgcn_cosf(fr); ROPES[i] = __builtin_amdgcn_sinf(fr);
    }
    }
    rms_rows(x_in, args.in[3], HN, MTOK, gw, NGW, lane);
#ifdef PROBE_RMS
    rms_rows(x_in, args.in[3], HN, MTOK, gw, NGW, lane);
#endif
    rms_rows(mem, args.in[5], MEMN, BATCH * MEMLEN, gw, NGW, lane);
    rms_rows(mem, args.in[5] + DM, MEMN + (size_t)BATCH * MEMLEN * DM, BATCH * MEMLEN, gw, NGW, lane);
    for (int i = gtid; i < 5 * MTOK / 4; i += nthreads) ((GAS f32x4*)RSB(0))[i] = (f32x4){0.f, 0.f, 0.f, 0.f};
    PH_END
    GSYNC();

#pragma nounroll
    for (int l = 0; l < 2; ++l) {
#ifndef NO_GEMM
        if (l == 0) { PH_BEGIN EpiBf16G E{QKV, QKVP, Gt, args.in[8], 2816, nullptr}; run_gemm(lds, HN, (const bf16_t*)(WSP + WS_WIN0), MTOK, 3072, 1024, E, tid, Bx, Gd); PH_END
            PH_BEGIN EpiBf16G E{KVC(0), 1024, nullptr, nullptr, 0, nullptr}; run_gemm(lds, MEMN, (const bf16_t*)(WSP + WS_WKV), BATCH * MEMLEN, 1024, 1024, E, tid, Bx, Gd); PH_END
            PH_BEGIN EpiBf16G E{KVC(1), 1024, nullptr, nullptr, 0, nullptr}; run_gemm(lds, MEMN + (size_t)BATCH * MEMLEN * DM, (const bf16_t*)(WSP + WS_WKV + 2 * MiB), BATCH * MEMLEN, 1024, 1024, E, tid, Bx, Gd); PH_END }
        else        PH_BEGIN EpiBf16G E{QKV, QKVP, nullptr, nullptr, 0, RSB(2)};  run_gemm(lds, HN, (const bf16_t*)(WSP + WS_WIN1), MTOK, 3072, 1024, E, tid, Bx, Gd); PH_END
#endif
        GSYNC();
        PH_BEGIN
        if (l == 0) {
            qknorm_rows<64, true>(QKV, QKVP, 512, 128, MTOK, 0, args.in[9], args.in[9] + 64, 1.f, 1.f, ROPEC, ROPES, gw, NGW, lane);
            transpose_cols(QKV, QKVP, 640, 128, SEQ, BATCH, VT, scrh, gw, NGW, lane);
#ifdef PROBE_TR
            transpose_cols(QKV, QKVP, 640, 128, SEQ, BATCH, VT, scrh, gw, NGW, lane);
#endif
            transpose_cols(QKV, QKVP, 1280, 512, SEQ, BATCH, VT + (size_t)8 * MiB, scrh, gw, NGW, lane);
#ifdef PROBE_TR
            transpose_cols(QKV, QKVP, 1280, 512, SEQ, BATCH, VT + (size_t)8 * MiB, scrh, gw, NGW, lane);
#endif
            transpose_cols(QKV, QKVP, 1792, 512, SEQ, BATCH, VT + (size_t)40 * MiB, scrh, gw, NGW, lane);
#ifdef PROBE_TR
            transpose_cols(QKV, QKVP, 1792, 512, SEQ, BATCH, VT + (size_t)40 * MiB, scrh, gw, NGW, lane);
#endif
            mlstm_gates_phase(Gt, GPB, WCB, SC, gw, NGW, lane);
            for (int lc = 0; lc < 2; ++lc) {
                qknorm_rows<128, false>(KVC(lc), 1024, 0, 512, BATCH * MEMLEN, 0, args.in[21] + lc * 256, args.in[21] + lc * 256 + 128, 1.f, 1.f, nullptr, nullptr, gw, NGW, lane);
                transpose_cols(KVC(lc), 1024, 512, 512, MEMLEN, BATCH, VTC(lc), scrh, gw, NGW, lane);
#ifdef PROBE_TR
                transpose_cols(KVC(lc), 1024, 512, 512, MEMLEN, BATCH, VTC(lc), scrh, gw, NGW, lane);
#endif
            }
        } else {
            qknorm_rows<64, false>(QKV, QKVP, 512, 512, MTOK, 0, args.in[13], args.in[13] + 64, 1.f, 1.f, nullptr, nullptr, gw, NGW, lane);
            qknorm_rows<64, false>(QKV, QKVP, 2048, 512, MTOK, 0, args.in[15], args.in[15] + 64, 1.f, 1.f, nullptr, nullptr, gw, NGW, lane);
            transpose_cols(QKV, QKVP, 1024, 512, SEQ, BATCH, VT, scrh, gw, NGW, lane);
#ifdef PROBE_TR
            transpose_cols(QKV, QKVP, 1024, 512, SEQ, BATCH, VT, scrh, gw, NGW, lane);
#endif
            transpose_cols(QKV, QKVP, 2560, 512, SEQ, BATCH, VT + (size_t)32 * MiB, scrh, gw, NGW, lane);
#ifdef PROBE_TR
            transpose_cols(QKV, QKVP, 2560, 512, SEQ, BATCH, VT + (size_t)32 * MiB, scrh, gw, NGW, lane);
#endif
        }
        PH_END
        GSYNC();
        if (l == 0) {
            const bf16_t* VaT = VT; const bf16_t* KmT = VT + (size_t)8 * MiB; const bf16_t* VmT = VT + (size_t)40 * MiB;
            (void)VaT; (void)KmT; (void)VmT;
#ifndef NO_MA
            PH_BEGIN mlstm_a2_phase(WCB, KmT, VmT, CST, NST, gw, NGW, r32, hi); PH_END
#ifdef PROBE_MA
            PH_BEGIN mlstm_a2_phase(WCB, KmT, VmT, CST, NST, gw, NGW, r32, hi); PH_END
#endif
#endif
            GSYNC();
            PH_BEGIN mlstm_scan_phase(CST, NST, SC, MST, gtid, nthreads); PH_END
            GSYNC();
#ifndef NO_MC
            PH_BEGIN mlstm_c2_phase(QKV, GPB, VmT, CST, NST, MST, args.in[10], Y, (LAS float*)(lds + wave * 20480), gw, NGW, lane, r32, hi); PH_END
#ifdef PROBE_MC
            PH_BEGIN mlstm_c2_phase(QKV, GPB, VmT, CST, NST, MST, args.in[10], Y, (LAS float*)(lds + wave * 20480), gw, NGW, lane, r32, hi); PH_END
#endif
#if defined(PROBE_B) || defined(PROBE_MLSTM)
            GSYNC();
            PH_BEGIN mlstm_a2_phase(WCB, KmT, VmT, CST, NST, gw, NGW, r32, hi); PH_END
            GSYNC();
            PH_BEGIN mlstm_scan_phase(CST, NST, SC, MST, gtid, nthreads); PH_END
            GSYNC();
            PH_BEGIN mlstm_c2_phase(QKV, GPB, VmT, CST, NST, MST, args.in[10], Y, (LAS float*)(lds + wave * 20480), gw, NGW, lane, r32, hi); PH_END
#endif
#endif
#ifndef NO_GQA
            PH_BEGIN gqa_phase(QKV, VaT, Y, args.in[9], ROPEC, ROPES, lds, tid, wave, r32, hi, Bx, Gd); PH_END
#ifdef PROBE_A
            __syncthreads();
            PH_BEGIN gqa_phase(QKV, VaT, Y, args.in[9], ROPEC, ROPES, lds, tid, wave, r32, hi, Bx, Gd); PH_END
#endif
#endif
        } else {
            const bf16_t* VcT = VT; const bf16_t* VdT = VT + (size_t)32 * MiB;
            (void)VcT; (void)VdT;
#ifndef NO_NA
            PH_BEGIN na_phase(QKV, VcT, Y, args.in[14], args.in[13], args.in[13] + 64, lds, tid, wave, r32, hi, Bx, Gd); PH_END
#if defined(PROBE_B) || defined(PROBE_NA)
            __syncthreads();
            PH_BEGIN na_phase(QKV, VcT, Y, args.in[14], args.in[13], args.in[13] + 64, lds, tid, wave, r32, hi, Bx, Gd); PH_END
#endif
#endif
#ifndef NO_DIFF
            const float lam_init = 0.8f - 0.6f * 0.7408182206817179f;
            PH_BEGIN diff_phase(QKV, VdT, Y, T5T, t5raw, args.in[16], args.in[17], args.in[15], lam_init, (float*)CST, lds, tid, wave, lane, r32, hi, Bx, Gd); PH_END
#ifdef PROBE_A
            __syncthreads();
            PH_BEGIN diff_phase(QKV, VdT, Y, T5T, t5raw, args.in[16], args.in[17], args.in[15], lam_init, (float*)CST, lds, tid, wave, lane, r32, hi, Bx, Gd); PH_END
#endif
#endif
        }
        GSYNC();
#ifndef NO_GEMM
        PH_BEGIN EpiResid E{l == 0 ? (const void*)x_in : (const void*)XB, l == 0 ? 0 : 1, XB, 1, DM, HN, args.in[4] + l * DM, RSB(l == 0 ? 0 : 3)}; run_gemm(lds, Y, (const bf16_t*)(WSP + (l == 0 ? WS_WOUT0 : WS_WOUT1)), MTOK, 1024, 1024, E, tid, Bx, Gd); PH_END
#endif
        GSYNC();
#ifndef NO_GEMM
        PH_BEGIN EpiBf16G E{QC, 512, nullptr, nullptr, 0, RSB(l == 0 ? 0 : 3)}; run_gemm(lds, HN, (const bf16_t*)(WSP + WS_WQ + l * MiB), MTOK, 512, 1024, E, tid, Bx, Gd); PH_END
#endif
        GSYNC();
#ifndef NO_CROSS
        PH_BEGIN cross_phase(QC, KVC(l), VTC(l), OC, args.in[21] + l * 256, lds, tid, wave, r32, hi, Bx, Gd); PH_END
#if defined(PROBE_B) || defined(PROBE_CROSS)
        __syncthreads();
        PH_BEGIN cross_phase(QC, KVC(l), VTC(l), OC, args.in[21] + l * 256, lds, tid, wave, r32, hi, Bx, Gd); PH_END
#endif
#endif
        GSYNC();
#ifndef NO_GEMM
        PH_BEGIN EpiResid E{XB, 1, l == 0 ? XB : XB2, 1, DM, HN, args.in[6] + l * DM, RSB(l == 0 ? 1 : 4)}; run_gemm(lds, OC, (const bf16_t*)(WSP + WS_WO + l * MiB), MTOK, 1024, 512, E, tid, Bx, Gd); PH_END
#endif
        GSYNC();
#ifndef NO_GEMM
        PH_BEGIN EpiConvAct E{ACT, SIDEB, args.in[24] + (size_t)l * 3 * 2 * DFF, args.in[25] + (size_t)l * 2 * DFF, RSB(l == 0 ? 1 : 4)};
                 run_gemm(lds, HN, (const bf16_t*)(WSP + WS_WUP + 11 * l * MiB), MTOK, 2 * DFF, 1024, E, tid, Bx, Gd); PH_END
#endif
        GSYNC();
#ifndef NO_GEMM
        PH_BEGIN EpiResid E{l == 0 ? XB : XB2, 1, l == 0 ? (void*)XB : (void*)out, l == 0 ? 1 : 0, DM, l == 0 ? HN : nullptr, args.in[3] + DM, RSB(2)};
                 run_gemm_fix(lds, ACT, (const bf16_t*)(WSP + WS_WDN + 6 * l * MiB), MTOK, 1024, DFF, E, tid, Bx, Gd, ACT, SIDEB, args.in[24] + (size_t)l * 3 * 2 * DFF, args.in[25] + (size_t)l * 2 * DFF); PH_END
#endif
        GSYNC();
    }
}

#undef WSP
#undef HN
#undef XB
#undef XB2
#undef GPB
#undef WCB
#undef RSB
#undef QKV
#undef VT
#undef Y
#undef CST
#undef Gt
#undef NST
#undef SC
#undef MST
#undef QC
#undef KVC
#undef VTC
#undef MEMN
#undef OC
#undef SIDEB
#undef ACT
#undef T5T
#undef ROPEC
#undef ROPES
#undef x_in
#undef mem
#undef t5raw
#undef out
extern "C" void kernel_launch(void* const* d_in, const int* in_sizes, int n_in, void* d_out, int out_size, void* d_ws, size_t ws_size, hipStream_t stream) {
    static int grid_blocks = 0;
    if (grid_blocks == 0) {
        int dev = 0, cus = 0, per_cu = 0;
        (void)hipGetDevice(&dev);
        (void)hipDeviceGetAttribute(&cus, hipDeviceAttributeMultiprocessorCount, dev);
        (void)hipFuncSetAttribute((const void*)fwd_megakernel, hipFuncAttributeMaxDynamicSharedMemorySize, LDS_BYTES);
        (void)hipOccupancyMaxActiveBlocksPerMultiprocessor(&per_cu, (const void*)fwd_megakernel, NTHR, LDS_BYTES);
        if (per_cu < 1) per_cu = 1;
        grid_blocks = cus * per_cu;
        if (n_in != 27 || ws_size < 1000 * MiB) fprintf(stderr, "kernel_launch: unexpected n_in %d / ws_size %zu\n", n_in, ws_size);
    }
    Args a{};
    for (int i = 0; i < 27; ++i) a.in[i] = (const float*)d_in[i];
    a.out = (float*)d_out; a.ws = (unsigned char*)d_ws;
    (void)hipMemsetAsync(d_ws, 0, 16384, stream);
    void* kargs[] = {&a};
    hipError_t e = hipLaunchCooperativeKernel((const void*)fwd_megakernel, dim3(grid_blocks), dim3(NTHR), kargs, LDS_BYTES, stream);
    if (e != hipSuccess) fprintf(stderr, "cooperative launch failed: %s (grid %d)\n", hipGetErrorString(e), grid_blocks);
}
```

```cpp
#include <hip/hip_runtime.h>
#include <hip/hip_cooperative_groups.h>
#include <cstdio>
#include <cstdint>
namespace cg = cooperative_groups;
namespace pg8 {
#define PG8_LAS __attribute__((address_space(3)))
typedef unsigned short bf16_t;
typedef short bf16x8 __attribute__((ext_vector_type(8)));
typedef float f32x4 __attribute__((ext_vector_type(4)));
typedef unsigned u32x4 __attribute__((ext_vector_type(4)));
constexpr int BM = 256, BK = 64, HALF = 128, HTB = HALF * BK * 2  , STAGE_BYTES = 8 * HTB, NXCD = 8, WGM = 8;

__host__ __device__ __forceinline__ int lds_byte(int r, int c) { const int st = (r >> 4) * 2 + (c >> 5), rr = r & 15, cc = c & 31, ob = rr * 64 + cc * 2; return st * 1024 + (ob ^ (((ob >> 9) & 1) << 5)); }
__host__ __device__ __forceinline__ void stage_rc(int b, int& R, int& C) { const int st = b / 1024, sb = b % 1024, swz = sb ^ (((sb >> 9) & 1) << 5); R = (st >> 1) * 16 + swz / 64; C = (st & 1) * 32 + (swz % 64) / 2; }
__host__ __device__ __forceinline__ int perm32(int rho) { const int n = rho >> 4, i = rho & 15; return 8 * (i >> 2) + 4 * n + (i & 3); }

struct Unit { int pm, pn; };
struct Gemm { const bf16_t* A; const bf16_t* Bt; int M, N, K; };

struct StaticOrder {
    int nM, nN, nwg, G, c;
    __host__ __device__ void init(int M, int N, int G_, int c_) { nM = M / BM; nN = N / BM; nwg = nM * nN; G = G_; c = c_; }
    __host__ __device__ bool next(int i, Unit& u) const {
        const long L = (long)i * G + c; if (L >= nwg) return false;
        int wgid = (int)L; { const int q = nwg / NXCD, r = nwg % NXCD, xcd = wgid % NXCD, off = wgid / NXCD; wgid = (xcd < r ? xcd * (q + 1) : r * (q + 1) + (xcd - r) * q) + off; }
        const int nig = WGM * nN, gid = wgid / nig, fm = gid * WGM, gsz = (nM - fm) < WGM ? (nM - fm) : WGM;
        u.pm = fm + ((wgid % nig) % gsz); u.pn = (wgid % nig) / gsz; return true;
    }
    __device__ __forceinline__ void a_ready(const Unit&) const {}
    __device__ __forceinline__ void done(const Unit&) const {}
};

__device__ __forceinline__ unsigned cvt_pk_bf16(float lo, float hi) { unsigned r; asm volatile("v_cvt_pk_bf16_f32 %0, %1, %2" : "=v"(r) : "v"(lo), "v"(hi)); return r; }
typedef float f32x2 __attribute__((ext_vector_type(2)));
template <class Epi, class Sched, bool ALIGN_EPI = false, bool SP2 = false>
__device__ __forceinline__ void gemm_phase(PG8_LAS unsigned char* lds, const Gemm g, const Sched& S, const Epi& E, int tid_in) {
    int tid_l = tid_in; asm volatile("" : "+v"(tid_l)); const int tid = tid_l, wid = __builtin_amdgcn_readfirstlane(tid >> 6), lane = tid & 63, wr = wid >> 2, wc = wid & 3, fr = lane & 15, fq = lane >> 4;
    const int K = g.K, nt = K / BK;
    unsigned voffA[2], voffB[2];
#pragma unroll
    for (int i = 0; i < 2; ++i) { int R, C; stage_rc(tid * 16 + i * 8192, R, C); const int Rb = Epi::PERM ? ((R & ~31) + perm32(R & 31)) : R;
        voffA[i] = (unsigned)(R * K + C) * 2u; voffB[i] = (unsigned)(Rb * K + C) * 2u; }
    const size_t kstep = (size_t)(BK * 2);
    const size_t hstep = (size_t)HALF * K * 2;
    const size_t tstep = 2 * hstep;
    const unsigned ldsw = (unsigned)wid * 1024u;
    const int aoff = lds_byte(wr * 64 + fr, fq * 8), boff = lds_byte(wc * 32 + fr, fq * 8);
#define PG8_SA(b, h) (((b) * 2 + (h)) * HTB)
#define PG8_SB(b, h) ((4 + (b) * 2 + (h)) * HTB)
#define PG8_STAGE(bufoff, gbase, voff) do { _Pragma("unroll") for (int _i = 0; _i < 2; ++_i) \
        __builtin_amdgcn_global_load_lds((const unsigned*)((const char*)(gbase) + (voff)[_i]), (PG8_LAS unsigned*)(lds + (bufoff) + ldsw + _i * 8192), 16, 0, 0); } while (0)
#define PG8_LDA(dst, b, h) do { _Pragma("unroll") for (int m = 0; m < 4; ++m) _Pragma("unroll") for (int k = 0; k < 2; ++k) dst[m][k] = *(const PG8_LAS bf16x8*)(lds + PG8_SA(b, h) + aoff + m * 2048 + k * 1024); } while (0)
#define PG8_LDB(dst, b, h) do { _Pragma("unroll") for (int n = 0; n < 2; ++n) _Pragma("unroll") for (int k = 0; k < 2; ++k) dst[n][k] = *(const PG8_LAS bf16x8*)(lds + PG8_SB(b, h) + boff + n * 2048 + k * 1024); } while (0)
#define PG8_MMA(ai, bj, At, Bt) do { __builtin_amdgcn_s_setprio(1); _Pragma("unroll") for (int m = 0; m < 4; ++m) _Pragma("unroll") for (int n = 0; n < 2; ++n) _Pragma("unroll") for (int k = 0; k < 2; ++k) \
        acc[ai][bj][m][n] = __builtin_amdgcn_mfma_f32_16x16x32_bf16(Bt[n][k], At[m][k], acc[ai][bj][m][n], 0, 0, 0); __builtin_amdgcn_s_setprio(0); } while (0)
#define PG8_WAIT_V(n) asm volatile("s_waitcnt vmcnt(" #n ")" ::: "memory")
#define PG8_WAIT_L(n) asm volatile("s_waitcnt lgkmcnt(" #n ")" ::: "memory")
#define PG8_BAR __builtin_amdgcn_s_barrier()
#define PG8_SCHED __builtin_amdgcn_sched_barrier(0)
    Unit cur, nxt; int ui = 0;
    if (!S.next(0, cur)) return;
    f32x4 acc[2][2][4][2];
#pragma unroll
    for (int a = 0; a < 2; ++a)
#pragma unroll
        for (int b = 0; b < 2; ++b)
#pragma unroll
            for (int m = 0; m < 4; ++m)
#pragma unroll
                for (int n = 0; n < 2; ++n) acc[a][b][m][n] = (f32x4){0.f, 0.f, 0.f, 0.f};
    bf16x8 At[4][2], B0[2][2], B1[2][2];
    const char* cA = (const char*)g.A + (size_t)cur.pm * tstep; const char* cB = (const char*)g.Bt + (size_t)cur.pn * tstep;
    S.a_ready(cur);
    if constexpr (SP2) {
        PG8_STAGE(PG8_SB(0, 0), cB, voffB); PG8_STAGE(PG8_SB(0, 1), cB + hstep, voffB); PG8_STAGE(PG8_SA(0, 0), cA, voffA); PG8_STAGE(PG8_SA(0, 1), cA + hstep, voffA);
        if (wr == 1) PG8_BAR;
        PG8_WAIT_V(2); PG8_BAR;
        PG8_STAGE(PG8_SB(1, 0), cB + kstep, voffB); PG8_STAGE(PG8_SA(1, 0), cA + kstep, voffA); PG8_STAGE(PG8_SB(1, 1), cB + hstep + kstep, voffB);
        PG8_WAIT_V(6); PG8_BAR;
    } else {
        PG8_STAGE(PG8_SB(0, 0), cB, voffB); PG8_STAGE(PG8_SA(0, 0), cA, voffA); PG8_STAGE(PG8_SB(0, 1), cB + hstep, voffB); PG8_STAGE(PG8_SA(0, 1), cA + hstep, voffA);
        if (wr == 1) PG8_BAR;
        PG8_WAIT_V(4); PG8_BAR;
        PG8_STAGE(PG8_SB(1, 0), cB + kstep, voffB); PG8_STAGE(PG8_SA(1, 0), cA + kstep, voffA); PG8_STAGE(PG8_SB(1, 1), cB + hstep + kstep, voffB);
        PG8_WAIT_V(6); PG8_BAR;
    }
    for (;;) {
        const bool has_next = S.next(ui + 1, nxt);
        const char* nA = has_next ? (const char*)g.A + (size_t)nxt.pm * tstep : cA; const char* nB = has_next ? (const char*)g.Bt + (size_t)nxt.pn * tstep : cB;
        for (int t = 0; t < nt; t += 2) {
            const bool last = (t == nt - 2);
            const char* a1 = cA + (size_t)(t + 1) * kstep;
            const char* a2 = last ? nA : cA + (size_t)(t + 2) * kstep; const char* b2 = last ? nB : cB + (size_t)(t + 2) * kstep;
            const char* a3 = a2 + kstep; const char* b3 = b2 + kstep;
            if (last && has_next) S.a_ready(nxt);
            if constexpr (SP2) {
            PG8_LDB(B0, 0, 0); PG8_LDB(B1, 0, 1); PG8_SCHED; PG8_LDA(At, 0, 0); PG8_STAGE(PG8_SA(1, 1), a1 + hstep, voffA);
            PG8_WAIT_V(8); PG8_WAIT_L(0); PG8_BAR; PG8_MMA(0, 0, At, B0); PG8_MMA(0, 1, At, B1); PG8_BAR; PG8_SCHED;
            PG8_LDA(At, 0, 1); PG8_STAGE(PG8_SB(0, 0), b2, voffB); PG8_STAGE(PG8_SB(0, 1), b2 + hstep, voffB); PG8_STAGE(PG8_SA(0, 0), a2, voffA);
            PG8_WAIT_V(8); PG8_WAIT_L(0); PG8_BAR; PG8_MMA(1, 0, At, B0); PG8_MMA(1, 1, At, B1); PG8_BAR; PG8_SCHED;
            PG8_LDB(B0, 1, 0); PG8_LDB(B1, 1, 1); PG8_SCHED; PG8_LDA(At, 1, 0); PG8_STAGE(PG8_SA(0, 1), a2 + hstep, voffA);
            PG8_WAIT_V(8); PG8_WAIT_L(0); PG8_BAR; PG8_MMA(0, 0, At, B0); PG8_MMA(0, 1, At, B1); PG8_BAR; PG8_SCHED;
            PG8_LDA(At, 1, 1); PG8_STAGE(PG8_SB(1, 0), b3, voffB); PG8_STAGE(PG8_SB(1, 1), b3 + hstep, voffB); PG8_STAGE(PG8_SA(1, 0), a3, voffA);
            PG8_WAIT_V(8); PG8_WAIT_L(0); PG8_BAR; PG8_MMA(1, 0, At, B0); PG8_MMA(1, 1, At, B1); PG8_BAR; PG8_SCHED;
            } else {
            PG8_LDB(B0, 0, 0); PG8_SCHED; PG8_LDA(At, 0, 0); PG8_STAGE(PG8_SA(1, 1), a1 + hstep, voffA);
            PG8_WAIT_L(8); PG8_BAR; PG8_WAIT_L(0); PG8_MMA(0, 0, At, B0); PG8_BAR; PG8_SCHED;
            PG8_LDB(B1, 0, 1); PG8_STAGE(PG8_SB(0, 0), b2, voffB);
            PG8_BAR; PG8_WAIT_L(0); PG8_MMA(0, 1, At, B1); PG8_BAR;
            PG8_LDA(At, 0, 1); PG8_STAGE(PG8_SA(0, 0), a2, voffA);
            PG8_BAR; PG8_WAIT_L(0); PG8_MMA(1, 0, At, B0); PG8_BAR; PG8_SCHED;
            PG8_STAGE(PG8_SB(0, 1), b2 + hstep, voffB);
            PG8_WAIT_V(6); PG8_BAR; PG8_MMA(1, 1, At, B1); PG8_BAR;
            PG8_LDB(B0, 1, 0); PG8_SCHED; PG8_LDA(At, 1, 0); PG8_STAGE(PG8_SA(0, 1), a2 + hstep, voffA);
            PG8_WAIT_L(8); PG8_BAR; PG8_WAIT_L(0); PG8_MMA(0, 0, At, B0); PG8_BAR; PG8_SCHED;
            PG8_LDB(B1, 1, 1); PG8_STAGE(PG8_SB(1, 0), b3, voffB);
            PG8_BAR; PG8_WAIT_L(0); PG8_MMA(0, 1, At, B1); PG8_BAR;
            PG8_LDA(At, 1, 1); PG8_STAGE(PG8_SA(1, 0), a3, voffA);
            PG8_BAR; PG8_WAIT_L(0); PG8_MMA(1, 0, At, B0); PG8_BAR; PG8_SCHED;
            PG8_STAGE(PG8_SB(1, 1), b3 + hstep, voffB);
            PG8_WAIT_V(6); PG8_BAR; PG8_MMA(1, 1, At, B1); PG8_BAR;
            }
        }
        if constexpr (ALIGN_EPI) { if (wr == 0) PG8_BAR; }
        if constexpr (!Epi::AFTER_DRAIN) { E(acc, cur, wr, wc, fr, fq); S.done(cur); }
        if (!has_next) break;
#pragma unroll
        for (int a = 0; a < 2; ++a)
#pragma unroll
            for (int b = 0; b < 2; ++b)
#pragma unroll
                for (int m = 0; m < 4; ++m)
#pragma unroll
                    for (int n = 0; n < 2; ++n) acc[a][b][m][n] = (f32x4){0.f, 0.f, 0.f, 0.f};
        cur = nxt; cA = nA; cB = nB; ++ui;
        if constexpr (ALIGN_EPI) { if (wr == 1) PG8_BAR; }
    }
    PG8_WAIT_V(0);
    if constexpr (!ALIGN_EPI) { if (wr == 0) PG8_BAR; }
    PG8_BAR;
    if constexpr (Epi::AFTER_DRAIN) { E.fused(acc, cur, wr, wc, fr, fq, lds, wid, lane); S.done(cur); }
#undef PG8_SA
#undef PG8_SB
#undef PG8_STAGE
#undef PG8_LDA
#undef PG8_LDB
#undef PG8_MMA
#undef PG8_WAIT_V
#undef PG8_WAIT_L
#undef PG8_BAR
#undef PG8_SCHED
}
}
#define LAS __attribute__((address_space(3)))
typedef unsigned short bf16_t;
typedef short bf16x8 __attribute__((ext_vector_type(8)));
typedef short s16x4 __attribute__((ext_vector_type(4)));
typedef float f32x16 __attribute__((ext_vector_type(16)));
typedef float f32x4 __attribute__((ext_vector_type(4)));
typedef float f32x2 __attribute__((ext_vector_type(2)));
typedef unsigned u32x4 __attribute__((ext_vector_type(4)));
typedef unsigned u32x2 __attribute__((ext_vector_type(2)));
typedef LAS unsigned char* ldsp_t;

constexpr int BATCH = 8, SEQ = 8192, DM = 1024, MTOK = BATCH * SEQ, MEMLEN = 256, DFF = 2816;
constexpr float EPS = 1e-6f, LOG2E = 1.4426950408889634f;
constexpr size_t MiB = 1ull << 20;
constexpr int NWAVES = 8, NTHR = 512;
constexpr int LDS_BYTES = 163840;
constexpr int QKVP = 3072;
constexpr size_t WS_WIN0 = 1 * MiB, WS_WOUT0 = 7 * MiB, WS_WIN1 = 9 * MiB, WS_WOUT1 = 15 * MiB, WS_WQ = 17 * MiB, WS_WKV = 19 * MiB, WS_WO = 23 * MiB,
                 WS_WUP = 25 * MiB, WS_WDN = 47 * MiB, WS_T5 = 59 * MiB, WS_ROPE = 59 * MiB + 512 * 1024;
constexpr size_t WS_HN = 64 * MiB;
constexpr size_t WS_QKV = 192 * MiB;
constexpr size_t WS_VT = 576 * MiB;
constexpr size_t WS_Y = 720 * MiB;
constexpr size_t WS_CST = 848 * MiB;
constexpr size_t WS_G = 976 * MiB, WS_NST = 980 * MiB, WS_SC = 982 * MiB, WS_MST = 983 * MiB;
constexpr size_t WS_QC = 192 * MiB, WS_OC = 272 * MiB, WS_KVC = 994 * MiB, WS_VTC = 1002 * MiB;
constexpr size_t WS_RS = 984 * MiB, WS_MEMN = 986 * MiB;
constexpr size_t WS_ACT = 192 * MiB, WS_SIDE = 544 * MiB;

struct Args { const float* in[27]; float* out; unsigned char* ws; };

#define GAS __attribute__((address_space(1)))
#define LDS_FENCE() asm volatile("s_waitcnt lgkmcnt(0)" ::: "memory")
__device__ __forceinline__ unsigned pk2(float lo, float hi) { typedef __bf16 b2 __attribute__((ext_vector_type(2))); f32x2 v = {lo, hi}; b2 b = __builtin_convertvector(v, b2); return __builtin_bit_cast(unsigned, b); }
__device__ __forceinline__ float bflo(unsigned w) { return __uint_as_float(w << 16); }
__device__ __forceinline__ float bfhi(unsigned w) { return __uint_as_float(w & 0xffff0000u); }
__device__ __forceinline__ float bf1(bf16_t v) { return __uint_as_float(((unsigned)v) << 16); }
__device__ __forceinline__ int lane_id() { int l; asm volatile("v_mbcnt_lo_u32_b32 %0, -1, 0\n\tv_mbcnt_hi_u32_b32 %0, -1, %0" : "=v"(l)); return l; }
__device__ __forceinline__ float bperm(float v, int src) { return __builtin_bit_cast(float, __builtin_amdgcn_ds_bpermute(src << 2, __builtin_bit_cast(int, v))); }
__device__ __forceinline__ float shx(float v, int o) { return bperm(v, lane_id() ^ o); }
__device__ __forceinline__ float shup(float v, int o) { const int l = lane_id(); return bperm(v, l >= o ? l - o : l); }
__device__ __forceinline__ float shdn(float v, int o) { const int l = lane_id(); return bperm(v, l + o < 64 ? l + o : l); }
__device__ __forceinline__ float shl_(float v, int k) { return bperm(v, k); }
__device__ __forceinline__ float wave_sum(float v) {
#pragma unroll
    for (int o = 1; o < 64; o <<= 1) v += shx(v, o);
    return v;
}
__device__ __forceinline__ float ex2(float x) { return __builtin_amdgcn_exp2f(x); }
__device__ __forceinline__ float logsig(float x) { return fminf(x, 0.f) - __logf(1.f + __expf(-fabsf(x))); }
__device__ __forceinline__ int crow(int r, int hi) { return (r & 3) + 8 * (r >> 2) + 4 * hi; }
__device__ __forceinline__ int clampi(int v, int lo, int hi) { return v < lo ? lo : (v > hi ? hi : v); }

struct EpiBf16G {
    static constexpr bool PERM = true, AFTER_DRAIN = false;
    bf16_t* O; int ldc; float* G; const float* gbias; int gcol0; const float* RS;
    __device__ __forceinline__ void operator()(const pg8::f32x4 (&acc)[2][2][4][2], const pg8::Unit& u, int wr, int wc, int fr, int fq) const {
        const int row0 = u.pm * 256 + wr * 64 + fr, col0 = u.pn * 256 + wc * 32 + 8 * fq;
#pragma unroll
        for (int ai = 0; ai < 2; ++ai)
#pragma unroll
            for (int m = 0; m < 4; ++m) {
                const size_t row = (size_t)(row0 + ai * 128 + m * 16);
                const float rstd = RS ? rsqrtf(RS[row] * (1.f / DM) + EPS) : 1.f;
#pragma unroll
                for (int bj = 0; bj < 2; ++bj) {
                    const int col = col0 + bj * 128;
                    const pg8::f32x4 v0 = acc[ai][bj][m][0] * rstd, v1 = acc[ai][bj][m][1] * rstd;
                    if (G != nullptr && col >= gcol0) {
                        if (col < gcol0 + 16) {
                            float* gp = G + row * 16 + (col - gcol0); const float* bp = gbias + (col - gcol0);
                            gp[0] = v0[0] + bp[0]; gp[1] = v0[1] + bp[1]; gp[2] = v0[2] + bp[2]; gp[3] = v0[3] + bp[3];
                            gp[4] = v1[0] + bp[4]; gp[5] = v1[1] + bp[5]; gp[6] = v1[2] + bp[6]; gp[7] = v1[3] + bp[7];
                        }
                    } else {
                        u32x4 w; w.x = pk2(v0[0], v0[1]); w.y = pk2(v0[2], v0[3]); w.z = pk2(v1[0], v1[1]); w.w = pk2(v1[2], v1[3]);
                        *(GAS u32x4*)(O + row * ldc + col) = w;
                    }
                }
            }
    }
};
struct EpiResid {
    static constexpr bool PERM = true, AFTER_DRAIN = false;
    const void* R; int r_bf; void* Out; int o_bf; int ldc; bf16_t* XG; const float* gain; float* RS;
    __device__ __forceinline__ void operator()(const pg8::f32x4 (&acc)[2][2][4][2], const pg8::Unit& u, int wr, int wc, int fr, int fq) const {
        const int row0 = u.pm * 256 + wr * 64 + fr, col0 = u.pn * 256 + wc * 32 + 8 * fq;
        pg8::f32x4 gv[2][2];
        if (XG) {
#pragma unroll
            for (int bj = 0; bj < 2; ++bj)
#pragma unroll
                for (int n = 0; n < 2; ++n) gv[bj][n] = *(const GAS pg8::f32x4*)(gain + col0 + bj * 128 + n * 4);
        }
#pragma unroll
        for (int ai = 0; ai < 2; ++ai)
#pragma unroll
            for (int m = 0; m < 4; ++m) {
                const int row = row0 + ai * 128 + m * 16;
                const size_t off = (size_t)row * ldc + col0;
                float ss = 0.f;
#pragma unroll
                for (int bj = 0; bj < 2; ++bj) {
                    const size_t o2 = off + bj * 128;
                    pg8::f32x4 r0, r1;
                    if (r_bf) { const u32x4 rw = *(const GAS u32x4*)((const bf16_t*)R + o2); r0 = (pg8::f32x4){bflo(rw.x), bfhi(rw.x), bflo(rw.y), bfhi(rw.y)}; r1 = (pg8::f32x4){bflo(rw.z), bfhi(rw.z), bflo(rw.w), bfhi(rw.w)}; }
                    else { r0 = *(const GAS pg8::f32x4*)((const float*)R + o2); r1 = *(const GAS pg8::f32x4*)((const float*)R + o2 + 4); }
                    const pg8::f32x4 v0 = r0 + acc[ai][bj][m][0], v1 = r1 + acc[ai][bj][m][1];
                    if (o_bf) { u32x4 w; w.x = pk2(v0[0], v0[1]); w.y = pk2(v0[2], v0[3]); w.z = pk2(v1[0], v1[1]); w.w = pk2(v1[2], v1[3]); *(GAS u32x4*)((bf16_t*)Out + o2) = w; }
                    else { *(GAS pg8::f32x4*)((float*)Out + o2) = v0; *(GAS pg8::f32x4*)((float*)Out + o2 + 4) = v1; }
                    if (XG) {
                        ss += ((v0[0] * v0[0] + v0[1] * v0[1]) + (v0[2] * v0[2] + v0[3] * v0[3])) + ((v1[0] * v1[0] + v1[1] * v1[1]) + (v1[2] * v1[2] + v1[3] * v1[3]));
                        const pg8::f32x4 g0 = gv[bj][0], g1 = gv[bj][1];
                        u32x4 w; w.x = pk2(v0[0] * g0[0], v0[1] * g0[1]); w.y = pk2(v0[2] * g0[2], v0[3] * g0[3]); w.z = pk2(v1[0] * g1[0], v1[1] * g1[1]); w.w = pk2(v1[2] * g1[2], v1[3] * g1[3]);
                        *(GAS u32x4*)(XG + o2) = w;
                    }
                }
                if (XG) {
                    ss += shx(ss, 16); ss += shx(ss, 32);
                    if (fq == 0) __hip_atomic_fetch_add(RS + row, ss, __ATOMIC_RELAXED, __HIP_MEMORY_SCOPE_AGENT);
                }
            }
    }
};
#ifndef RESID_ALIGN
#define RESID_ALIGN true
#endif
template <class Epi> struct EpiAlign { static constexpr bool value = true; };
template <> struct EpiAlign<EpiResid> { static constexpr bool value = RESID_ALIGN; };
template <class Epi> __device__ __forceinline__ void run_gemm(ldsp_t lds, const bf16_t* A, const bf16_t* Bt, int M, int N, int K, const Epi& E, int tid, int Bx, int Gd) {
    pg8::Gemm g{A, Bt, M, N, K}; pg8::StaticOrder S; S.init(M, N, Gd, Bx);
    pg8::gemm_phase<Epi, pg8::StaticOrder, EpiAlign<Epi>::value, true>(lds, g, S, E, tid);
}
template <int CTRL> __device__ __forceinline__ float dppf(float x) { return __builtin_bit_cast(float, __builtin_amdgcn_update_dpp(0, __builtin_bit_cast(int, x), CTRL, 0xf, 0xf, true)); }
struct EpiConvAct {
    static constexpr bool PERM = true, AFTER_DRAIN = false;
    bf16_t* ACT; float* SIDE; const float* cw; const float* cb; const float* RS;
    __device__ __forceinline__ void operator()(const pg8::f32x4 (&acc)[2][2][4][2], const pg8::Unit& u, int wr_, int wc_, int fr_, int fq_) const {
        int wr = wr_, wc = wc_, fr = fr_, fq = fq_; asm volatile("" : "+s"(wr), "+s"(wc), "+v"(fr), "+v"(fq));
        const int ch0 = u.pn * 128 + wc * 32 + 8 * fq;
#pragma unroll
        for (int ai = 0; ai < 2; ++ai) {
            const int rowb = u.pm * 256 + ai * 128 + wr * 64, slab = rowb >> 6;
            float rs[4], rsp[4], rsn[4];
#pragma unroll
            for (int m = 0; m < 4; ++m) rs[m] = rsqrtf(RS[rowb + 16 * m + fr] * (1.f / DM) + EPS);
            { float mir[4];
#pragma unroll
              for (int m = 0; m < 4; ++m) mir[m] = dppf<0x140>(rs[m]);
#pragma unroll
              for (int m = 0; m < 4; ++m) { const float a = dppf<0x111>(rs[m]), b = dppf<0x101>(rs[m]); rsp[m] = fr > 0 ? a : mir[m > 0 ? m - 1 : 0]; rsn[m] = fr < 15 ? b : mir[m < 3 ? m + 1 : 3]; } }
#pragma unroll
            for (int mm = 0; mm < 2; ++mm) {
                const int m = mm ? 3 : 0; const int k = mm ? (fr == 14 ? 2 : fr == 15 ? 3 : -1) : (fr == 0 ? 0 : fr == 1 ? 1 : -1);
                if (k >= 0) {
                    float* sp = SIDE + ((size_t)(slab * 4 + k) * 2) * DFF + ch0;
                    *(GAS pg8::f32x4*)sp = acc[ai][0][m][0] * rs[m]; *(GAS pg8::f32x4*)(sp + 4) = acc[ai][0][m][1] * rs[m];
                    *(GAS pg8::f32x4*)(sp + DFF) = acc[ai][1][m][0] * rs[m]; *(GAS pg8::f32x4*)(sp + DFF + 4) = acc[ai][1][m][1] * rs[m];
                }
            }
#pragma unroll
            for (int eh = 0; eh < 2; ++eh) {
                const int chh = ch0 + 4 * eh;
                const pg8::f32x4 W0g = *(const GAS pg8::f32x4*)(cw + chh), W1g = *(const GAS pg8::f32x4*)(cw + 2 * DFF + chh), W2g = *(const GAS pg8::f32x4*)(cw + 4 * DFF + chh), Bg = *(const GAS pg8::f32x4*)(cb + chh);
                const pg8::f32x4 W0v = *(const GAS pg8::f32x4*)(cw + DFF + chh), W1v = *(const GAS pg8::f32x4*)(cw + 3 * DFF + chh), W2v = *(const GAS pg8::f32x4*)(cw + 5 * DFF + chh), Bv = *(const GAS pg8::f32x4*)(cb + DFF + chh);
#pragma unroll
                for (int m = 0; m < 4; ++m) {
                    float r4[4];
#pragma unroll
                    for (int ei = 0; ei < 4; ++ei) {
                        const float xg = acc[ai][0][m][eh][ei], xv = acc[ai][1][m][eh][ei];
                        const float mgp = dppf<0x140>(acc[ai][0][m > 0 ? m - 1 : 0][eh][ei]), mgn = dppf<0x140>(acc[ai][0][m < 3 ? m + 1 : 3][eh][ei]);
                        const float mvp = dppf<0x140>(acc[ai][1][m > 0 ? m - 1 : 0][eh][ei]), mvn = dppf<0x140>(acc[ai][1][m < 3 ? m + 1 : 3][eh][ei]);
                        const float sg = dppf<0x111>(xg), lg = dppf<0x101>(xg), sv = dppf<0x111>(xv), lv = dppf<0x101>(xv);
                        const float pg_ = fr > 0 ? sg : mgp, ng_ = fr < 15 ? lg : mgn, pv_ = fr > 0 ? sv : mvp, nv_ = fr < 15 ? lv : mvn;
                        const float gte = Bg[ei] + W0g[ei] * (pg_ * rsp[m]) + W1g[ei] * (xg * rs[m]) + W2g[ei] * (ng_ * rsn[m]);
                        const float val = Bv[ei] + W0v[ei] * (pv_ * rsp[m]) + W1v[ei] * (xv * rs[m]) + W2v[ei] * (nv_ * rsn[m]);
                        r4[ei] = gte * __builtin_amdgcn_rcpf(1.f + ex2(-gte * LOG2E)) * val;
                    }
                    const int s_ = 16 * m + fr;
                    if (s_ != 0 && s_ != 63) { u32x2 o; o.x = pk2(r4[0], r4[1]); o.y = pk2(r4[2], r4[3]); *(GAS u32x2*)(ACT + (size_t)(rowb + s_) * DFF + chh) = o; }
                }
                asm volatile("" ::: "memory");
            }
        }
    }
};
__device__ __forceinline__ void ffn_fixup(int pm, bf16_t* ACT, const float* SIDE, const float* cw, const float* cb, int tid) {
    for (int idx = tid; idx < 8 * (DFF / 8); idx += NTHR) {
        const int ri = idx / (DFF / 8), ch = (idx % (DFF / 8)) * 8, slab = pm * 4 + (ri >> 1), last = ri & 1, row = slab * 64 + (last ? 63 : 0), t = row % SEQ;
        const float* sc = SIDE + ((size_t)(slab * 4 + (last ? 3 : 0)) * 2) * DFF + ch;
        const float* sp = last ? SIDE + ((size_t)(slab * 4 + 2) * 2) * DFF + ch : SIDE + ((size_t)((slab - 1) * 4 + 3) * 2) * DFF + ch;
        const float* sn = last ? SIDE + ((size_t)((slab + 1) * 4 + 0) * 2) * DFF + ch : SIDE + ((size_t)(slab * 4 + 1) * 2) * DFF + ch;
        const bool hp = last || t > 0, hn = !last || t < SEQ - 1;
        float r[8];
#pragma unroll
        for (int hlf = 0; hlf < 2; ++hlf) {
            const f32x4 z = {0.f, 0.f, 0.f, 0.f};
            const f32x4 cg = *(const GAS f32x4*)(sc + 4 * hlf), cv = *(const GAS f32x4*)(sc + DFF + 4 * hlf);
            const f32x4 pg_ = hp ? *(const GAS f32x4*)(sp + 4 * hlf) : z, pv_ = hp ? *(const GAS f32x4*)(sp + DFF + 4 * hlf) : z;
            const f32x4 ng_ = hn ? *(const GAS f32x4*)(sn + 4 * hlf) : z, nv_ = hn ? *(const GAS f32x4*)(sn + DFF + 4 * hlf) : z;
#pragma unroll
            for (int i = 0; i < 4; ++i) {
                const int c = ch + 4 * hlf + i;
                const float gte = cb[c] + cw[c] * pg_[i] + cw[2 * DFF + c] * cg[i] + cw[4 * DFF + c] * ng_[i];
                const float val = cb[DFF + c] + cw[DFF + c] * pv_[i] + cw[3 * DFF + c] * cv[i] + cw[5 * DFF + c] * nv_[i];
                r[4 * hlf + i] = gte / (1.f + __expf(-gte)) * val;
            }
        }
        u32x4 o; o.x = pk2(r[0], r[1]); o.y = pk2(r[2], r[3]); o.z = pk2(r[4], r[5]); o.w = pk2(r[6], r[7]);
        *(GAS u32x4*)(ACT + (size_t)row * DFF + ch) = o;
    }
}
template <class Epi> __device__ __forceinline__ void run_gemm_fix(ldsp_t lds, const bf16_t* A, const bf16_t* Bt, int M, int N, int K, const Epi& E, int tid, int Bx, int Gd,
                                                                  bf16_t* ACT, const float* SIDE, const float* cw, const float* cb) {
    pg8::Gemm g{A, Bt, M, N, K}; pg8::StaticOrder S; S.init(M, N, Gd, Bx);
    { pg8::Unit u; int last_pm = -1; for (int i = 0; S.next(i, u); ++i) { if (u.pm != last_pm) ffn_fixup(u.pm, ACT, SIDE, cw, cb, tid); last_pm = u.pm; } }
    asm volatile("s_waitcnt vmcnt(0)" ::: "memory"); __syncthreads();
    pg8::gemm_phase<Epi, pg8::StaticOrder, EpiAlign<Epi>::value, true>(lds, g, S, E, tid);
}
#define XB_TMO      128
#define XB_XCNT(j)  (256  + 64 * (j))
#define XB_XSUB(j)  (1280 + 64 * (j))
#define XB_XGEN(j)  (2304 + 64 * (j))
#define XB_TOP      3328
#define XB_TOPGEN   3392
#define XB_SPIN_CAP (1u << 20)
__device__ __forceinline__ unsigned xb_ld(unsigned* p)              { return __hip_atomic_load(p, __ATOMIC_RELAXED, __HIP_MEMORY_SCOPE_AGENT); }
__device__ __forceinline__ unsigned xb_add(unsigned* p, unsigned v) { return __hip_atomic_fetch_add(p, v, __ATOMIC_RELAXED, __HIP_MEMORY_SCOPE_AGENT); }
__device__ __forceinline__ unsigned xb_xcc_id() { return (unsigned)__builtin_amdgcn_s_getreg((3 << 11) | 20) & 0xFu; }
#define XB_SPIN(cond, bar) do { unsigned _sp = 0; while (cond) { __builtin_amdgcn_s_sleep(1); \
    if ((++_sp & 255u) == 0u) { if (xb_ld(&(bar)[XB_TMO])) break; if (_sp > XB_SPIN_CAP) { atomicAdd(&(bar)[XB_TMO], 1u); break; } } } } while (0)
__device__ __forceinline__ void xb_post(unsigned* bar, int wave_s) {
    if (wave_s == 0 && lane_id() == 0) (void)xb_add(&bar[XB_XCNT(xb_xcc_id())], 1u);
}
__device__ __forceinline__ void xb_complete(unsigned* bar, unsigned x, unsigned& nloc, unsigned& nx) {
    const unsigned G = gridDim.x;
    unsigned sum, cnt, mine, sp = 0u;
    for (;;) {
        sum = 0u; cnt = 0u; mine = 0u;
#pragma unroll
        for (unsigned j = 0; j < 16; ++j) { const unsigned c = xb_ld(&bar[XB_XCNT(j)]); sum += c; cnt += (c > 0u) ? 1u : 0u; mine = (j == x) ? c : mine; }
        if (sum == G) break;
        __builtin_amdgcn_s_sleep(1);
        if ((++sp & 255u) == 0u) { if (xb_ld(&bar[XB_TMO])) break; if (sp > XB_SPIN_CAP) { atomicAdd(&bar[XB_TMO], 1u); break; } }
    }
    nloc = mine > 0u ? mine : 1u; nx = cnt > 0u ? cnt : 1u;
}
__device__ __forceinline__ void gbar(unsigned* bar, volatile LAS unsigned* st, int wave_s) {
    asm volatile("s_waitcnt vmcnt(0) lgkmcnt(0)" ::: "memory");
    __syncthreads();
    if (wave_s == 0 && lane_id() == 0) {
        const unsigned x = xb_xcc_id();
        unsigned nloc = st[0], nx = st[1];
        if (nloc == 0u) { xb_complete(bar, x, nloc, nx); st[0] = nloc; st[1] = nx; }
        const unsigned old = xb_add(&bar[XB_XSUB(x)], 1u);
        const unsigned gen = old / nloc;
        if (old + 1u == (gen + 1u) * nloc) {
            __builtin_amdgcn_fence(__ATOMIC_RELEASE, "agent");
            asm volatile("s_waitcnt vmcnt(0)" ::: "memory");
            const unsigned og = xb_add(&bar[XB_TOP], 1u);
            const unsigned tg = og / nx;
            if (og + 1u == (tg + 1u) * nx) xb_add(&bar[XB_TOPGEN], 1u);
            else XB_SPIN(xb_ld(&bar[XB_TOPGEN]) == tg, bar);
            __builtin_amdgcn_fence(__ATOMIC_ACQUIRE, "agent");
            xb_add(&bar[XB_XGEN(x)], 1u);
            asm volatile("s_waitcnt vmcnt(0)" ::: "memory");
        } else {
            XB_SPIN(xb_ld(&bar[XB_XGEN(x)]) == gen, bar);
            __builtin_amdgcn_fence(__ATOMIC_ACQUIRE, "agent");
            asm volatile("s_waitcnt vmcnt(0)" ::: "memory");
        }
    }
    __syncthreads();
}

__device__ __forceinline__ int rowmap_up(int n) { const int ch = n < DFF ? n : n - DFF; return ((ch >> 7) << 8) + (n < DFF ? 0 : 128) + (ch & 127); }
__device__ __forceinline__ void wt_matrix(const float* W, int K, int N, bf16_t* WT, bool upmap, LAS float* scrf, int gw, int NGW, int lane, int& goff) {
    LAS bf16_t* scr = (LAS bf16_t*)scrf;
    const int nblk = (N + 63) / 64, nitems = (K / 64) * nblk;
    const int first = ((gw - goff) % NGW + NGW) % NGW; goff = (goff + nitems) % NGW;
    for (int item = first; item < nitems; item += NGW) {
        const int kb = item / nblk, nb = item % nblk, k0 = 64 * kb, n0 = 64 * nb;
        const int n4 = (lane & 15) * 4, kq = lane >> 4;
        f32x4 v[16];
#pragma unroll
        for (int i = 0; i < 16; ++i) { v[i] = (f32x4){0.f, 0.f, 0.f, 0.f}; if (n0 + n4 < N) v[i] = *(const GAS f32x4*)(W + (size_t)(k0 + 4 * i + kq) * N + n0 + n4); }
#pragma unroll
        for (int i = 0; i < 16; ++i) { LAS unsigned* d = (LAS unsigned*)(scr + (4 * i + kq) * 66 + n4); d[0] = pk2(v[i].x, v[i].y); d[1] = pk2(v[i].z, v[i].w); }
        LDS_FENCE();
        const int c = lane & 7;
#pragma unroll
        for (int j = 0; j < 8; ++j) {
            const int nl = (lane >> 3) + 8 * j, n = n0 + nl;
            const LAS bf16_t* s = scr + (8 * c) * 66 + nl;
            u32x4 o; o.x = (unsigned)s[0] | ((unsigned)s[66] << 16); o.y = (unsigned)s[132] | ((unsigned)s[198] << 16); o.z = (unsigned)s[264] | ((unsigned)s[330] << 16); o.w = (unsigned)s[396] | ((unsigned)s[462] << 16);
            if (n < N) { const int rr = upmap ? rowmap_up(n) : n; *(GAS u32x4*)(WT + (size_t)rr * K + k0 + 8 * c) = o; }
        }
        LDS_FENCE();
    }
}

__device__ __forceinline__ void rms_rows(const float* X, const float* gain, bf16_t* O, int nrows, int gw, int NGW, int lane) {
    for (int m = gw; m < nrows; m += NGW) {
        const GAS f32x4* xr = (const GAS f32x4*)(X + (size_t)m * DM) + lane;
        f32x4 v[4]; float s = 0.f;
#pragma unroll
        for (int j = 0; j < 4; ++j) { v[j] = xr[64 * j]; s += (v[j].x * v[j].x + v[j].y * v[j].y) + (v[j].z * v[j].z + v[j].w * v[j].w); }
        const float rstd = rsqrtf(wave_sum(s) * (1.f / DM) + EPS);
        GAS u32x2* o8 = (GAS u32x2*)(O + (size_t)m * DM) + lane;
#pragma unroll
        for (int j = 0; j < 4; ++j) { const f32x4 g = ((const f32x4*)gain)[lane + 64 * j]; u32x2 w; w.x = pk2(v[j].x * rstd * g.x, v[j].y * rstd * g.y); w.y = pk2(v[j].z * rstd * g.z, v[j].w * rstd * g.w); o8[64 * j] = w; }
    }
}

template <int GD, bool ROPE>
__device__ __forceinline__ void qknorm_rows(bf16_t* X, int pitch, int c0, int ncols, int nrows, int nq_cols, const float* gq, const float* gk, float sq, float sk,
                                            const float* ropeC, const float* ropeS, int gw, int NGW, int lane) {
    constexpr int LPG = GD / 8;
    const int nchunks = (ncols + 511) / 512;
    const int total = nrows * nchunks;
    for (int it0 = gw; it0 < total; it0 += 4 * NGW) {
      u32x4 raws[4];
#pragma unroll
      for (int j = 0; j < 4; ++j) {
          const int it = it0 + j * NGW; raws[j] = (u32x4){0u, 0u, 0u, 0u};
          if (it < total) { const int row = it / nchunks, ch = it % nchunks, c = ch * 512 + lane * 8; if (c < ncols) raws[j] = *(const GAS u32x4*)(X + (size_t)row * pitch + c0 + c); }
      }
#pragma unroll
      for (int j = 0; j < 4; ++j) {
        const int it = it0 + j * NGW; if (it >= total) break;
        const int row = it / nchunks, ch = it % nchunks;
        const int c = ch * 512 + lane * 8; const bool act = c < ncols;
        bf16_t* p = X + (size_t)row * pitch + c0 + c;
        const u32x4 raw = raws[j];
        float v[8]; v[0] = bflo(raw.x); v[1] = bfhi(raw.x); v[2] = bflo(raw.y); v[3] = bfhi(raw.y); v[4] = bflo(raw.z); v[5] = bfhi(raw.z); v[6] = bflo(raw.w); v[7] = bfhi(raw.w);
        float ss = 0.f;
#pragma unroll
        for (int i = 0; i < 8; ++i) ss += v[i] * v[i];
#pragma unroll
        for (int o = 1; o < LPG; o <<= 1) ss += shx(ss, o);
        const float rstd = rsqrtf(ss * (1.f / GD) + EPS);
        const bool isq = c < nq_cols; const float* g = (isq ? gq : gk) + (c % GD); const float sc = isq ? sq : sk;
        const f32x4 g0 = *(const f32x4*)g, g1 = *(const f32x4*)(g + 4);
        v[0] *= rstd * g0.x; v[1] *= rstd * g0.y; v[2] *= rstd * g0.z; v[3] *= rstd * g0.w; v[4] *= rstd * g1.x; v[5] *= rstd * g1.y; v[6] *= rstd * g1.z; v[7] *= rstd * g1.w;
        if (ROPE) {
            const int d = c & 63, half = d >> 5, dd = d & 31, t = row % SEQ, pos = half ? (t & 63) : (t >> 6), j0 = dd & 15; const bool second = dd >= 16;
#pragma unroll
            for (int i = 0; i < 8; ++i) {
                const float xp = shx(v[i], 2); const float cs = ropeC[pos * 16 + j0 + i], sn = ropeS[pos * 16 + j0 + i];
                v[i] = second ? (xp * sn + v[i] * cs) : (v[i] * cs - xp * sn);
            }
        }
        u32x4 o; o.x = pk2(v[0] * sc, v[1] * sc); o.y = pk2(v[2] * sc, v[3] * sc); o.z = pk2(v[4] * sc, v[5] * sc); o.w = pk2(v[6] * sc, v[7] * sc);
        if (act) *(GAS u32x4*)p = o;
      }
    }
}

__device__ __forceinline__ void transpose_cols(const bf16_t* X, int pitch, int c0, int C, int Sx, int nb, bf16_t* T, LAS bf16_t* scr, int gw, int NGW, int lane) {
    const int tt = Sx / 64, ct = C / 64, nitems = nb * tt * ct;
    for (int it = gw; it < nitems; it += NGW) {
        const int cti = it % ct, r = it / ct, tti = r % tt, b = r / tt;
        const bf16_t* src = X + (size_t)(b * Sx + tti * 64) * pitch + c0 + cti * 64;
#pragma unroll
        for (int i = 0; i < 8; ++i) {
            const int tok = 8 * i + (lane >> 3), chn = lane & 7;
            const u32x4 v = *(const GAS u32x4*)(src + (size_t)tok * pitch + chn * 8);
            LAS unsigned* d = (LAS unsigned*)(scr + tok * 66 + chn * 8);
            d[0] = v.x; d[1] = v.y; d[2] = v.z; d[3] = v.w;
        }
        LDS_FENCE();
#pragma unroll
        for (int i = 0; i < 8; ++i) {
            const int col = 8 * i + (lane >> 3), chn = lane & 7;
            const LAS bf16_t* s = scr + (chn * 8) * 66 + col;
            u32x4 o; o.x = (unsigned)s[0] | ((unsigned)s[66] << 16); o.y = (unsigned)s[132] | ((unsigned)s[198] << 16); o.z = (unsigned)s[264] | ((unsigned)s[330] << 16); o.w = (unsigned)s[396] | ((unsigned)s[462] << 16);
            *(GAS u32x4*)(T + (size_t)(b * C + cti * 64 + col) * Sx + tti * 64 + chn * 8) = o;
        }
        LDS_FENCE();
    }
}

__device__ __forceinline__ float bfsel(const u32x4& v, int i) { const unsigned w = i < 2 ? v.x : i < 4 ? v.y : i < 6 ? v.z : v.w; return (i & 1) ? bfhi(w) : bflo(w); }
__device__ __forceinline__ void conv_gate(const bf16_t* U, bf16_t* ACT, int nrows, const float* cw, const float* cb, int gtid, int nthreads) {
    constexpr int nchunk = DFF / 8, RB = 16;
    const int nitems = (nrows / RB) * nchunk;
    for (int idx = gtid; idx < nitems; idx += nthreads) {
        const int rb = idx / nchunk, chk = idx % nchunk, ch = chk * 8, row0 = rb * RB, t0 = row0 % SEQ;
        const int ucol = ((ch >> 7) << 8) + (ch & 127);
        float wg[3][8], wv[3][8], bg[8], bv[8];
#pragma unroll
        for (int j = 0; j < 3; ++j) {
            const f32x4 a0 = *(const GAS f32x4*)(cw + j * 2 * DFF + ch), a1 = *(const GAS f32x4*)(cw + j * 2 * DFF + ch + 4);
            const f32x4 c0 = *(const GAS f32x4*)(cw + j * 2 * DFF + DFF + ch), c1 = *(const GAS f32x4*)(cw + j * 2 * DFF + DFF + ch + 4);
#pragma unroll
            for (int i = 0; i < 4; ++i) { wg[j][i] = a0[i]; wg[j][4 + i] = a1[i]; wv[j][i] = c0[i]; wv[j][4 + i] = c1[i]; }
        }
        { const f32x4 a0 = *(const GAS f32x4*)(cb + ch), a1 = *(const GAS f32x4*)(cb + ch + 4), c0 = *(const GAS f32x4*)(cb + DFF + ch), c1 = *(const GAS f32x4*)(cb + DFF + ch + 4);
#pragma unroll
          for (int i = 0; i < 4; ++i) { bg[i] = a0[i]; bg[4 + i] = a1[i]; bv[i] = c0[i]; bv[4 + i] = c1[i]; } }
        const bf16_t* up = U + (size_t)row0 * (2 * DFF) + ucol;
        const u32x4 z = {0u, 0u, 0u, 0u};
        u32x4 gp = z, vp = z;
        if (t0 > 0) { gp = *(const GAS u32x4*)(up - 2 * DFF); vp = *(const GAS u32x4*)(up - 2 * DFF + 128); }
        u32x4 gc = *(const GAS u32x4*)up, vc = *(const GAS u32x4*)(up + 128);
#pragma unroll 4
        for (int rr = 0; rr < RB; ++rr) {
            u32x4 gn = z, vn = z;
            if (rr < RB - 1 || t0 + RB < SEQ) { gn = *(const GAS u32x4*)(up + (size_t)(rr + 1) * (2 * DFF)); vn = *(const GAS u32x4*)(up + (size_t)(rr + 1) * (2 * DFF) + 128); }
            float r[8];
#pragma unroll
            for (int i = 0; i < 8; ++i) {
                const float gte = bg[i] + bfsel(gp, i) * wg[0][i] + bfsel(gc, i) * wg[1][i] + bfsel(gn, i) * wg[2][i];
                const float val = bv[i] + bfsel(vp, i) * wv[0][i] + bfsel(vc, i) * wv[1][i] + bfsel(vn, i) * wv[2][i];
                r[i] = gte / (1.f + __expf(-gte)) * val;
            }
            u32x4 o; o.x = pk2(r[0], r[1]); o.y = pk2(r[2], r[3]); o.z = pk2(r[4], r[5]); o.w = pk2(r[6], r[7]);
            *(GAS u32x4*)(ACT + (size_t)(row0 + rr) * DFF + ch) = o;
            gp = gc; vp = vc; gc = gn; vc = vn;
        }
    }
}

#define MFMA32(a, b, c) __builtin_amdgcn_mfma_f32_32x32x16_bf16((a), (b), (c), 0, 0, 0)
constexpr int VSTR = 144, ATT_VOFF = 17408;
template <int DQK> __device__ __forceinline__ void tile_qk(f32x16& p0, f32x16& p1, const bf16x8* qf, const LAS unsigned char* Ks, int r32, int hi, float cinit) {
    constexpr int KSTR = (DQK + 8) * 2;
#pragma unroll
    for (int r = 0; r < 16; ++r) { p0[r] = cinit; p1[r] = cinit; }
    const int pr = (r32 & 0x13) | ((r32 & 4) << 1) | ((r32 & 8) >> 1);
    const LAS unsigned char* kb = Ks + pr * KSTR + hi * 16;
#pragma unroll
    for (int d0 = 0; d0 < DQK / 16; ++d0) {
        const bf16x8 a0 = *(const LAS bf16x8*)(kb + d0 * 32), a1 = *(const LAS bf16x8*)(kb + 32 * KSTR + d0 * 32);
        p0 = MFMA32(a0, qf[d0], p0); p1 = MFMA32(a1, qf[d0], p1);
    }
}
template <int DV> __device__ __forceinline__ void tile_softmax_pv(f32x16& p0, f32x16& p1, float& m, float& l, f32x16* o, const LAS unsigned char* Vts, int r32, int hi) {
    float mx = fmaxf(p0[0], p1[0]);
#pragma unroll
    for (int r = 1; r < 16; ++r) mx = fmaxf(mx, fmaxf(p0[r], p1[r]));
    mx = fmaxf(mx, shx(mx, 32));
    const float mn = fmaxf(m, mx), alpha = ex2(m - mn); m = mn;
    float s = 0.f;
#pragma unroll
    for (int r = 0; r < 16; ++r) { p0[r] = ex2(p0[r] - mn); p1[r] = ex2(p1[r] - mn); s += p0[r] + p1[r]; }
    l = l * alpha + s;
    if (__any(alpha != 1.0f)) {
#pragma unroll
        for (int d0 = 0; d0 < DV / 32; ++d0) o[d0] = o[d0] * alpha;
    }
    u32x4 w[4];
    w[0] = (u32x4){pk2(p0[0], p0[1]), pk2(p0[2], p0[3]), pk2(p0[4], p0[5]), pk2(p0[6], p0[7])};
    w[1] = (u32x4){pk2(p0[8], p0[9]), pk2(p0[10], p0[11]), pk2(p0[12], p0[13]), pk2(p0[14], p0[15])};
    w[2] = (u32x4){pk2(p1[0], p1[1]), pk2(p1[2], p1[3]), pk2(p1[4], p1[5]), pk2(p1[6], p1[7])};
    w[3] = (u32x4){pk2(p1[8], p1[9]), pk2(p1[10], p1[11]), pk2(p1[12], p1[13]), pk2(p1[14], p1[15])};
    const LAS unsigned char* vb = Vts + r32 * VSTR + hi * 16;
#pragma unroll
    for (int j = 0; j < 4; ++j) {
        const bf16x8 pb = __builtin_bit_cast(bf16x8, w[j]);
#pragma unroll
        for (int d0 = 0; d0 < DV / 32; ++d0) {
            const bf16x8 a = *(const LAS bf16x8*)(vb + d0 * 32 * VSTR + j * 32);
            o[d0] = MFMA32(a, pb, o[d0]);
        }
    }
}
template <int DV> __device__ __forceinline__ void tile_exp_pv(f32x16& p0, f32x16& p1, f32x16& oe, f32x16* o, const LAS unsigned char* Vts, int r32, int hi) {
#pragma unroll
    for (int r = 0; r < 16; ++r) { p0[r] = ex2(p0[r]); p1[r] = ex2(p1[r]); }
    u32x4 w[4];
    w[0] = (u32x4){pk2(p0[0], p0[1]), pk2(p0[2], p0[3]), pk2(p0[4], p0[5]), pk2(p0[6], p0[7])};
    w[1] = (u32x4){pk2(p0[8], p0[9]), pk2(p0[10], p0[11]), pk2(p0[12], p0[13]), pk2(p0[14], p0[15])};
    w[2] = (u32x4){pk2(p1[0], p1[1]), pk2(p1[2], p1[3]), pk2(p1[4], p1[5]), pk2(p1[6], p1[7])};
    w[3] = (u32x4){pk2(p1[8], p1[9]), pk2(p1[10], p1[11]), pk2(p1[12], p1[13]), pk2(p1[14], p1[15])};
    const u32x4 onesw = {0x3f803f80u, 0x3f803f80u, 0x3f803f80u, 0x3f803f80u};
    const bf16x8 ones = __builtin_bit_cast(bf16x8, onesw);
    const LAS unsigned char* vb = Vts + r32 * VSTR + hi * 16;
#pragma unroll
    for (int j = 0; j < 4; ++j) {
        const bf16x8 pb = __builtin_bit_cast(bf16x8, w[j]);
        oe = MFMA32(ones, pb, oe);
#pragma unroll
        for (int d0 = 0; d0 < DV / 32; ++d0) {
            const bf16x8 a = *(const LAS bf16x8*)(vb + d0 * 32 * VSTR + j * 32);
            o[d0] = MFMA32(a, pb, o[d0]);
        }
    }
}
template <int D> __device__ __forceinline__ float score_bound(const float* gq, const float* gk, int lane) {
    float a = fabsf(gq[lane & (D - 1)]), b = fabsf(gk[lane & (D - 1)]);
    if (D == 128) { a = fmaxf(a, fabsf(gq[64 + lane])); b = fmaxf(b, fabsf(gk[64 + lane])); }
#pragma unroll
    for (int o = 1; o < 64; o <<= 1) { a = fmaxf(a, shx(a, o)); b = fmaxf(b, shx(b, o)); }
    return (D == 64 ? 8.0f : 11.3137085f) * a * b * LOG2E * 1.02f;
}
template <int DQK, int DV> struct KVRegs { u32x4 k[DQK / 64]; u32x4 v[DV / 64]; };
template <int DQK, int DV> __device__ __forceinline__ void kv_load(KVRegs<DQK, DV>& R, const bf16_t* Kt, int kpitch, const bf16_t* Vt, int vtpitch, int tid) {
#pragma unroll
    for (int i = 0; i < DQK / 64; ++i) { const int ci = tid + 512 * i, row = ci / (DQK / 8), cc = ci % (DQK / 8); R.k[i] = *(const GAS u32x4*)(Kt + (size_t)row * kpitch + cc * 8); }
#pragma unroll
    for (int i = 0; i < DV / 64; ++i) { const int ci = tid + 512 * i, d = ci >> 3, cc = ci & 7; R.v[i] = *(const GAS u32x4*)(Vt + (size_t)d * vtpitch + cc * 8); }
}
template <int DQK, int DV> __device__ __forceinline__ void kv_store(const KVRegs<DQK, DV>& R, LAS unsigned char* Ks, LAS unsigned char* Vts, int tid) {
    constexpr int KSTR = (DQK + 8) * 2;
#pragma unroll
    for (int i = 0; i < DQK / 64; ++i) { const int ci = tid + 512 * i, row = ci / (DQK / 8), cc = ci % (DQK / 8); *(LAS u32x4*)(Ks + row * KSTR + cc * 16) = R.k[i]; }
#pragma unroll
    for (int i = 0; i < DV / 64; ++i) { const int ci = tid + 512 * i, d = ci >> 3, cc = ci & 7; *(LAS u32x4*)(Vts + d * VSTR + cc * 16) = R.v[i]; }
}
constexpr int ATT_BUF = 35840;
template <int DQK, int BIAS>
__device__ __forceinline__ void qk_biased(f32x16& p0, f32x16& p1, const bf16x8* qf, const LAS unsigned char* Ks, int t, int q0w, const float* tb, float cneg, float cpos, float sref, int r32, int hi) {
    float cinit = -sref; bool near = false;
    if (BIAS == 1) { const int lo = t * 64 - (q0w + 31), hh = t * 64 + 63 - q0w; if (hh <= -91) cinit = cneg; else if (lo >= 91) cinit = cpos; else near = true; }
    tile_qk<DQK>(p0, p1, qf, Ks, r32, hi, cinit);
    if (BIAS == 1 && near) {
        const GAS float* tq = (const GAS float*)(tb + (t * 64 + 8 * hi - (q0w + r32)));
#pragma unroll
        for (int r = 0; r < 16; ++r) { const int kk = 16 * (r >> 3) + (r & 7); p0[r] += tq[kk]; p1[r] += tq[kk + 32]; }
    }
}
template <int DQK, bool ROPE> __device__ __forceinline__ void qf_norm(bf16x8* qf, const float* qgain, float qscale, int hi, const float* ropeC, const float* ropeS, int prow, int pcol) {
    float v[DQK / 16][8]; float ss = 0.f;
#pragma unroll
    for (int d0 = 0; d0 < DQK / 16; ++d0) { const u32x4 w = __builtin_bit_cast(u32x4, qf[d0]);
        v[d0][0] = bflo(w.x); v[d0][1] = bfhi(w.x); v[d0][2] = bflo(w.y); v[d0][3] = bfhi(w.y); v[d0][4] = bflo(w.z); v[d0][5] = bfhi(w.z); v[d0][6] = bflo(w.w); v[d0][7] = bfhi(w.w);
#pragma unroll
        for (int i = 0; i < 8; ++i) ss += v[d0][i] * v[d0][i]; }
    ss += shx(ss, 32);
    const float rs = rsqrtf(ss * (1.f / DQK) + EPS);
#pragma unroll
    for (int d0 = 0; d0 < DQK / 16; ++d0) { const f32x4 g0 = *(const f32x4*)(qgain + d0 * 16 + hi * 8), g1 = *(const f32x4*)(qgain + d0 * 16 + hi * 8 + 4);
        v[d0][0] *= rs * g0.x; v[d0][1] *= rs * g0.y; v[d0][2] *= rs * g0.z; v[d0][3] *= rs * g0.w; v[d0][4] *= rs * g1.x; v[d0][5] *= rs * g1.y; v[d0][6] *= rs * g1.z; v[d0][7] *= rs * g1.w; }
    if constexpr (ROPE && DQK == 64) {
#pragma unroll
        for (int hf = 0; hf < 2; ++hf) {
            const float* cp = ropeC + (hf ? pcol : prow) * 16 + 8 * hi; const float* sp = ropeS + (hf ? pcol : prow) * 16 + 8 * hi;
            const f32x4 c0 = *(const f32x4*)cp, c1 = *(const f32x4*)(cp + 4), s0 = *(const f32x4*)sp, s1 = *(const f32x4*)(sp + 4);
#pragma unroll
            for (int i = 0; i < 8; ++i) { const float cs = i < 4 ? c0[i & 3] : c1[i & 3], sn = i < 4 ? s0[i & 3] : s1[i & 3]; const float t1 = v[2 * hf][i], t2 = v[2 * hf + 1][i];
                v[2 * hf][i] = t1 * cs - t2 * sn; v[2 * hf + 1][i] = t1 * sn + t2 * cs; }
        }
    }
#pragma unroll
    for (int d0 = 0; d0 < DQK / 16; ++d0) { u32x4 r; r.x = pk2(v[d0][0] * qscale, v[d0][1] * qscale); r.y = pk2(v[d0][2] * qscale, v[d0][3] * qscale); r.z = pk2(v[d0][4] * qscale, v[d0][5] * qscale); r.w = pk2(v[d0][6] * qscale, v[d0][7] * qscale);
        qf[d0] = __builtin_bit_cast(bf16x8, r); }
}
template <int DQK, int DV, int BIAS, bool PIPE, bool FIXED>
__device__ __forceinline__ void attn_pass(const bf16_t* Qw, int qpitch, const bf16_t* Kb, int kpitch, const bf16_t* Vtb, int vtpitch, int ntiles,
                                          int q0w, const float* tb, float cneg, float cpos, ldsp_t lds, float& m, float& l, f32x16* o, int tid, int r32, int hi,
                                          const float* qgain = nullptr, float qscale = 1.f, const float* ropeC = nullptr, const float* ropeS = nullptr, int qprow = 0, int qpcol = 0) {
    bf16x8 qf[DQK / 16];
#pragma unroll
    for (int d0 = 0; d0 < DQK / 16; ++d0) qf[d0] = *(const GAS bf16x8*)(Qw + (size_t)r32 * qpitch + d0 * 16 + hi * 8);
    if (qgain) { if (ropeC) qf_norm<DQK, true>(qf, qgain, qscale, hi, ropeC, ropeS, qprow, qpcol); else qf_norm<DQK, false>(qf, qgain, qscale, hi, nullptr, nullptr, 0, 0); }
    const float sref = FIXED ? m : 0.f;
    if (FIXED) { cneg -= sref; cpos -= sref; }
    m = -1e30f; l = 0.f;
#pragma unroll
    for (int d0 = 0; d0 < DV / 32; ++d0)
#pragma unroll
        for (int r = 0; r < 16; ++r) o[d0][r] = 0.f;
    f32x16 oe;
#pragma unroll
    for (int r = 0; r < 16; ++r) oe[r] = 0.f;
    KVRegs<DQK, DV> R; kv_load<DQK, DV>(R, Kb, kpitch, Vtb, vtpitch, tid);
    __syncthreads();
    kv_store<DQK, DV>(R, lds, lds + ATT_VOFF, tid);
    if (ntiles > 1) kv_load<DQK, DV>(R, Kb + (size_t)64 * kpitch, kpitch, Vtb + 64, vtpitch, tid);
    __syncthreads();
    int cur = 0;
    if constexpr (PIPE) {
    f32x16 pa0, pa1, pb0, pb1;
    qk_biased<DQK, BIAS>(pa0, pa1, qf, lds, 0, q0w, tb, cneg, cpos, sref, r32, hi);
#define ATT_STEP(P0, P1, N0, N1, T) do { \
        const int t_ = (T); const int nxt = cur == 2 * ATT_BUF ? 0 : cur + ATT_BUF; \
        if (t_ + 1 < ntiles) kv_store<DQK, DV>(R, lds + nxt, lds + nxt + ATT_VOFF, tid); \
        __syncthreads(); \
        if (t_ + 2 < ntiles) kv_load<DQK, DV>(R, Kb + (size_t)(t_ + 2) * 64 * kpitch, kpitch, Vtb + (t_ + 2) * 64, vtpitch, tid); \
        if (t_ + 1 < ntiles) qk_biased<DQK, BIAS>(N0, N1, qf, lds + nxt, t_ + 1, q0w, tb, cneg, cpos, sref, r32, hi); \
        if constexpr (FIXED) tile_exp_pv<DV>(P0, P1, oe, o, lds + cur + ATT_VOFF, r32, hi); else tile_softmax_pv<DV>(P0, P1, m, l, o, lds + cur + ATT_VOFF, r32, hi); \
        cur = nxt; } while (0)
#pragma nounroll
    for (int t = 0; t < ntiles; t += 2) {
        ATT_STEP(pa0, pa1, pb0, pb1, t);
        ATT_STEP(pb0, pb1, pa0, pa1, t + 1);
    }
#undef ATT_STEP
    } else {
#pragma nounroll
    for (int t = 0; t < ntiles; ++t) {
        const int nxt = cur == 2 * ATT_BUF ? 0 : cur + ATT_BUF;
        if (t + 1 < ntiles) kv_store<DQK, DV>(R, lds + nxt, lds + nxt + ATT_VOFF, tid);
        __syncthreads();
        if (t + 2 < ntiles) kv_load<DQK, DV>(R, Kb + (size_t)(t + 2) * 64 * kpitch, kpitch, Vtb + (t + 2) * 64, vtpitch, tid);
        f32x16 p0, p1;
        qk_biased<DQK, BIAS>(p0, p1, qf, lds + cur, t, q0w, tb, cneg, cpos, sref, r32, hi);
        if constexpr (FIXED) tile_exp_pv<DV>(p0, p1, oe, o, lds + cur + ATT_VOFF, r32, hi); else tile_softmax_pv<DV>(p0, p1, m, l, o, lds + cur + ATT_VOFF, r32, hi);
        cur = nxt;
    }
    }
    if constexpr (FIXED) l = 0.5f * oe[0];
}
template <int DV> __device__ __forceinline__ void store_o(const f32x16* o, float inv, bf16_t* Ow, int opitch, int r32, int hi) {
#pragma unroll
    for (int d0 = 0; d0 < DV / 32; ++d0)
#pragma unroll
        for (int g = 0; g < 4; ++g) {
            u32x2 w; w.x = pk2(o[d0][4 * g] * inv, o[d0][4 * g + 1] * inv); w.y = pk2(o[d0][4 * g + 2] * inv, o[d0][4 * g + 3] * inv);
            *(GAS u32x2*)(Ow + (size_t)r32 * opitch + 32 * d0 + 8 * g + 4 * hi) = w;
        }
}
__device__ __forceinline__ int vcu_of(int bx, int G) { return (G % 8 == 0) ? (bx % 8) * (G / 8) + bx / 8 : bx; }

__device__ __forceinline__ void gqa_phase(const bf16_t* QKV, const bf16_t* VaT, bf16_t* Y, const float* gqk, const float* ropeC, const float* ropeS, ldsp_t lds, int tid, int wave, int r32, int hi, int Bx, int Gd) {
    const int G = Gd, vcu = vcu_of(Bx, G);
    const float sref = score_bound<64>(gqk, gqk + 64, tid & 63);
    for (int u = vcu; u < BATCH * 8 * 32; u += G) {
        const int qt = u & 31, hq = (u >> 5) & 3, kvh = (u >> 7) & 1, b = u >> 8, hqf = kvh * 4 + hq;
        const size_t row0 = (size_t)b * SEQ + qt * 256 + wave * 32;
        float m = sref, l; f32x16 o[2];
        if (sref < 40.f) attn_pass<64, 64, 0, true, true>(QKV + row0 * QKVP + hqf * 64, QKVP, QKV + (size_t)b * SEQ * QKVP + 512 + kvh * 64, QKVP, VaT + (size_t)((b * 2 + kvh) * 64) * SEQ, SEQ, SEQ / 64,
                             0, nullptr, 0.f, 0.f, lds, m, l, o, tid, r32, hi, gqk, 0.125f * LOG2E, ropeC, ropeS, (qt * 256 + wave * 32 + r32) >> 6, (wave * 32 + r32) & 63);
        else attn_pass<64, 64, 0, false, false>(QKV + row0 * QKVP + hqf * 64, QKVP, QKV + (size_t)b * SEQ * QKVP + 512 + kvh * 64, QKVP, VaT + (size_t)((b * 2 + kvh) * 64) * SEQ, SEQ, SEQ / 64,
                             0, nullptr, 0.f, 0.f, lds, m, l, o, tid, r32, hi, gqk, 0.125f * LOG2E, ropeC, ropeS, (qt * 256 + wave * 32 + r32) >> 6, (wave * 32 + r32) & 63);
        l += shx(l, 32);
        store_o<64>(o, 1.f / l, Y + row0 * DM + hqf * 64, DM, r32, hi);
    }
}
__device__ __forceinline__ void cross_phase(const bf16_t* QC, const bf16_t* KVC, const bf16_t* VTC, bf16_t* OC, const float* gqk, ldsp_t lds, int tid, int wave, int r32, int hi, int Bx, int Gd) {
    const int G = Gd, vcu = vcu_of(Bx, G);
    const float sref = score_bound<128>(gqk, gqk + 128, tid & 63);
    for (int u = vcu; u < BATCH * 4 * 32; u += G) {
        const int qt = u & 31, h = (u >> 5) & 3, b = u >> 7;
        const size_t row0 = (size_t)b * SEQ + qt * 256 + wave * 32;
        float m = sref, l; f32x16 o[4];
        if (sref < 40.f) attn_pass<128, 128, 0, false, true>(QC + row0 * 512 + h * 128, 512, KVC + (size_t)b * MEMLEN * 1024 + h * 128, 1024, VTC + (size_t)((b * 4 + h) * 128) * MEMLEN, MEMLEN, MEMLEN / 64,
                               0, nullptr, 0.f, 0.f, lds, m, l, o, tid, r32, hi, gqk, 0.08838834764831845f * LOG2E);
        else attn_pass<128, 128, 0, false, false>(QC + row0 * 512 + h * 128, 512, KVC + (size_t)b * MEMLEN * 1024 + h * 128, 1024, VTC + (size_t)((b * 4 + h) * 128) * MEMLEN, MEMLEN, MEMLEN / 64,
                               0, nullptr, 0.f, 0.f, lds, m, l, o, tid, r32, hi, gqk, 0.08838834764831845f * LOG2E);
        l += shx(l, 32);
        store_o<128>(o, 1.f / l, OC + row0 * 512 + h * 128, 512, r32, hi);
    }
}
__device__ __forceinline__ void diff_phase(const bf16_t* QKV, const bf16_t* VdT, bf16_t* Y, const float* t5tab, const float* t5raw, const float* lamv, const float* dgain, const float* gqk, float lam_init,
                                           float* stash, ldsp_t lds, int tid, int wave, int lane, int r32, int hi, int Bx, int Gd) {
    const int G = Gd, vcu = vcu_of(Bx, G);
    f32x4* st = (f32x4*)(stash + ((size_t)(Bx * NWAVES + wave) * 64 + lane) * 64);
    float bmax = fmaxf(fabsf(t5raw[lane]), fabsf(t5raw[64 + lane]));
#pragma unroll
    for (int o = 1; o < 64; o <<= 1) bmax = fmaxf(bmax, shx(bmax, o));
    const float sref = score_bound<64>(gqk, gqk + 64, lane) + bmax * LOG2E;
    const float lam = __expf(wave_sum(lamv[lane] * lamv[64 + lane])) - __expf(wave_sum(lamv[128 + lane] * lamv[192 + lane])) + lam_init;
    for (int u = vcu; u < BATCH * 4 * 32; u += G) {
        const int qt = u & 31, h = (u >> 5) & 3, b = u >> 7;
        const int q0w = qt * 256 + wave * 32; const size_t row0 = (size_t)b * SEQ + q0w;
        const float cneg = t5raw[15 * 4 + h] * LOG2E, cpos = t5raw[31 * 4 + h] * LOG2E; const float* tb = t5tab + h * 16384 + 8192;
        const bf16_t* Kb = QKV + (size_t)b * SEQ * QKVP + 2048 + h * 128; const bf16_t* Vt = VdT + (size_t)((b * 4 + h) * 128) * SEQ;
        float m, l; f32x16 o1[4];
        { f32x16 o2[4];
          m = sref;
          if (sref < 40.f) attn_pass<64, 128, 1, false, true>(QKV + row0 * QKVP + 1536 + h * 128 + 64, QKVP, Kb + 64, QKVP, Vt, SEQ, SEQ / 64, q0w, tb, cneg, cpos, lds, m, l, o2, tid, r32, hi, gqk, 0.125f * LOG2E);
          else attn_pass<64, 128, 1, false, false>(QKV + row0 * QKVP + 1536 + h * 128 + 64, QKVP, Kb + 64, QKVP, Vt, SEQ, SEQ / 64, q0w, tb, cneg, cpos, lds, m, l, o2, tid, r32, hi, gqk, 0.125f * LOG2E);
          l += shx(l, 32);
          const float inv = lam / l;
#pragma unroll
          for (int d0 = 0; d0 < 4; ++d0)
#pragma unroll
              for (int g = 0; g < 4; ++g) st[d0 * 4 + g] = (f32x4){o2[d0][4 * g] * inv, o2[d0][4 * g + 1] * inv, o2[d0][4 * g + 2] * inv, o2[d0][4 * g + 3] * inv}; }
        asm volatile("" ::: "memory");
        m = sref;
        if (sref < 40.f) attn_pass<64, 128, 1, false, true>(QKV + row0 * QKVP + 1536 + h * 128, QKVP, Kb, QKVP, Vt, SEQ, SEQ / 64, q0w, tb, cneg, cpos, lds, m, l, o1, tid, r32, hi, gqk, 0.125f * LOG2E);
        else attn_pass<64, 128, 1, false, false>(QKV + row0 * QKVP + 1536 + h * 128, QKVP, Kb, QKVP, Vt, SEQ, SEQ / 64, q0w, tb, cneg, cpos, lds, m, l, o1, tid, r32, hi, gqk, 0.125f * LOG2E);
        l += shx(l, 32);
        float ss = 0.f;
        { const float inv = 1.f / l;
#pragma unroll
          for (int d0 = 0; d0 < 4; ++d0)
#pragma unroll
              for (int g = 0; g < 4; ++g) { const f32x4 sv = st[d0 * 4 + g];
#pragma unroll
                  for (int e = 0; e < 4; ++e) { const float v = o1[d0][4 * g + e] * inv - sv[e]; o1[d0][4 * g + e] = v; ss += v * v; } } }
        asm volatile("" ::: "memory");
        ss += shx(ss, 32);
        const float rstd = rsqrtf(ss * (1.f / 128.f) + EPS) * (1.f - lam_init);
        bf16_t* Ow = Y + row0 * DM + 512 + h * 128;
#pragma unroll
        for (int d0 = 0; d0 < 4; ++d0)
#pragma unroll
            for (int g = 0; g < 4; ++g) {
                const int d = 32 * d0 + 8 * g + 4 * hi; const f32x4 gn = *(const f32x4*)(dgain + h * 128 + d);
                u32x2 w; w.x = pk2(o1[d0][4 * g] * rstd * gn.x, o1[d0][4 * g + 1] * rstd * gn.y); w.y = pk2(o1[d0][4 * g + 2] * rstd * gn.z, o1[d0][4 * g + 3] * rstd * gn.w);
                *(u32x2*)(Ow + (size_t)r32 * DM + d) = w;
            }
    }
}
__device__ __forceinline__ void na_phase(const bf16_t* QKV, const bf16_t* VcT, bf16_t* Y, const float* rpb, const float* gq, const float* gk, ldsp_t lds, int tid, int wave, int r32, int hi, int Bx, int Gd) {
    const int G = Gd, vcu = vcu_of(Bx, G);
    LAS unsigned char* Ks = lds; LAS unsigned char* Vts = lds + ATT_VOFF; LAS float* rpl = (LAS float*)(lds + 3 * ATT_BUF);
    float bmax = 0.f;
    for (int i = (tid & 63); i < 8 * 465; i += 64) bmax = fmaxf(bmax, fabsf(rpb[i]));
#pragma unroll
    for (int o_ = 1; o_ < 64; o_ <<= 1) bmax = fmaxf(bmax, shx(bmax, o_));
    const float sref = score_bound<64>(gq, gk, tid & 63) + bmax * LOG2E;
    const bool fast = sref < 40.f;
    for (int u = vcu; u < BATCH * 8 * 32; u += G) {
        const int rg = u & 31, h = (u >> 5) & 7, b = u >> 8;
        const int R0 = 4 * rg, Rw = R0 + (wave >> 1), qc = 32 * (wave & 1) + r32;
        const int r0w = clampi(Rw - 4, 0, 120), ulo = clampi(R0 - 4, 0, 120), uhi = clampi(R0 - 1, 0, 120) + 7, nt = uhi - ulo + 1;
        const int c0 = clampi(qc - 8, 0, 48);
        __syncthreads();
        if (tid < 465) rpl[tid] = rpb[h * 465 + tid] * LOG2E;
        const size_t row0 = (size_t)b * SEQ + Rw * 64 + 32 * (wave & 1);
        const bf16_t* Qw = QKV + row0 * QKVP + h * 64;
        const bf16_t* Kb = QKV + ((size_t)b * SEQ + ulo * 64) * QKVP + 512 + h * 64;
        const bf16_t* Vtb = VcT + (size_t)((b * 8 + h) * 64) * SEQ + ulo * 64;
        bf16x8 qf[4];
#pragma unroll
        for (int d0 = 0; d0 < 4; ++d0) qf[d0] = *(const GAS bf16x8*)(Qw + (size_t)r32 * QKVP + d0 * 16 + hi * 8);
        qf_norm<64, false>(qf, gq, 0.125f * LOG2E, hi, nullptr, nullptr, 0, 0);
        float m = -1e30f, l = 0.f; f32x16 o[2], oe;
#pragma unroll
        for (int r = 0; r < 16; ++r) oe[r] = 0.f;
#pragma unroll
        for (int d0 = 0; d0 < 2; ++d0)
#pragma unroll
            for (int r = 0; r < 16; ++r) o[d0][r] = 0.f;
        KVRegs<64, 64> R; kv_load<64, 64>(R, Kb, QKVP, Vtb, SEQ, tid);
        for (int t = 0; t < nt; ++t) {
            __syncthreads();
            kv_store<64, 64>(R, Ks, Vts, tid);
            __syncthreads();
            if (t + 1 < nt) kv_load<64, 64>(R, Kb + (size_t)(t + 1) * 64 * QKVP, QKVP, Vtb + (t + 1) * 64, SEQ, tid);
            const int kr = ulo + t;
            if (kr >= r0w && kr < r0w + 8) {
                f32x16 p0, p1; tile_qk<64>(p0, p1, qf, Ks, r32, hi, fast ? -sref : 0.f);
                const LAS float* rp = rpl + (kr - Rw + 7) * 31 + 15 - qc;
#pragma unroll
                for (int r = 0; r < 16; ++r) {
                    const int kc = 16 * (r >> 3) + (r & 7) + 8 * hi, kc2 = kc + 32;
                    p0[r] = (kc >= c0 && kc < c0 + 16) ? p0[r] + rp[kc] : -1e30f;
                    p1[r] = (kc2 >= c0 && kc2 < c0 + 16) ? p1[r] + rp[kc2] : -1e30f;
                }
                if (fast) tile_exp_pv<64>(p0, p1, oe, o, Vts, r32, hi); else tile_softmax_pv<64>(p0, p1, m, l, o, Vts, r32, hi);
            }
        }
        l += shx(l, 32); if (fast) l = oe[0];
        store_o<64>(o, 1.f / l, Y + row0 * DM + h * 64, DM, r32, hi);
    }
}

constexpr float KSCALE = 0.08838834764831845f;
__device__ __forceinline__ void mlstm_a_phase(const float* Gt, const bf16_t* KmT, const bf16_t* VmT, bf16_t* CST, float* NST, float* SC, ldsp_t lds, int tid, int wave, int r32, int hi, int Bx, int Gd) {
    LAS float* fl = (LAS float*)lds; LAS float* ab = fl + 128; LAS float* wv = fl + 256;
    for (int u = Bx; u < BATCH * 4 * 64 * 2; u += Gd) {
        const int dir = u & 1, c = (u >> 1) & 63, h = (u >> 7) & 3, b = u >> 9, chain = (b * 4 + h) * 2 + dir;
        const size_t tok0 = (size_t)b * SEQ + c * 128;
        __syncthreads();
        float gi = 0.f;
        if (tid < 128) { const float* gp = Gt + (tok0 + tid) * 16 + dir * 8 + h; gi = gp[0]; fl[tid] = logsig(gp[4]); }
        __syncthreads();
        if (tid < 128) {
            float cum = 0.f, tot = 0.f;
            for (int s = 0; s < 128; ++s) { const float f = fl[s]; tot += f; if (dir == 0 ? s <= tid : s >= tid) cum += f; }
            ab[tid] = tot - cum + gi;
            if (tid == 0) SC[(chain * 64 + c) * 2] = tot;
        }
        __syncthreads();
        if (tid < 128) {
            float mx = -1e30f;
            for (int s = 0; s < 128; ++s) mx = fmaxf(mx, ab[s]);
            wv[tid] = __expf(ab[tid] - mx) * KSCALE;
            if (tid == 0) SC[(chain * 64 + c) * 2 + 1] = mx;
        }
        __syncthreads();
        const int mi = wave >> 1, nh = wave & 1;
        const bf16_t* vp = VmT + ((size_t)((b * 4 + h) * 128 + 32 * mi + r32)) * SEQ + c * 128 + 8 * hi;
        const bf16_t* kp = KmT + ((size_t)((b * 4 + h) * 128 + 64 * nh + r32)) * SEQ + c * 128 + 8 * hi;
        f32x16 acc[2];
#pragma unroll
        for (int ni = 0; ni < 2; ++ni)
#pragma unroll
            for (int r = 0; r < 16; ++r) acc[ni][r] = 0.f;
#pragma unroll
        for (int ks = 0; ks < 8; ++ks) {
            const bf16x8 a = *(const GAS bf16x8*)(vp + 16 * ks);
            const LAS float* wp = wv + 16 * ks + 8 * hi;
#pragma unroll
            for (int ni = 0; ni < 2; ++ni) {
                const u32x4 kr = *(const GAS u32x4*)(kp + (size_t)(32 * ni) * SEQ + 16 * ks);
                u32x4 kw; kw.x = pk2(bflo(kr.x) * wp[0], bfhi(kr.x) * wp[1]); kw.y = pk2(bflo(kr.y) * wp[2], bfhi(kr.y) * wp[3]);
                kw.z = pk2(bflo(kr.z) * wp[4], bfhi(kr.z) * wp[5]); kw.w = pk2(bflo(kr.w) * wp[6], bfhi(kr.w) * wp[7]);
                acc[ni] = MFMA32(a, __builtin_bit_cast(bf16x8, kw), acc[ni]);
            }
        }
        bf16_t* cp = CST + (size_t)(chain * 64 + c) * 16384;
#pragma unroll
        for (int ni = 0; ni < 2; ++ni)
#pragma unroll
            for (int r = 0; r < 16; ++r) { const int dv = 32 * mi + crow(r, hi), dk = 64 * nh + 32 * ni + r32; cp[dv * 128 + dk] = (bf16_t)(pk2(acc[ni][r], 0.f) & 0xffffu); }
        if (tid < 128) {
            const bf16_t* kq = KmT + ((size_t)((b * 4 + h) * 128 + tid)) * SEQ + c * 128; float s = 0.f;
#pragma unroll 4
            for (int j = 0; j < 16; ++j) { const u32x4 kr = *(const GAS u32x4*)(kq + 8 * j); const LAS float* wp = wv + 8 * j;
                s += bflo(kr.x) * wp[0] + bfhi(kr.x) * wp[1] + bflo(kr.y) * wp[2] + bfhi(kr.y) * wp[3] + bflo(kr.z) * wp[4] + bfhi(kr.z) * wp[5] + bflo(kr.w) * wp[6] + bfhi(kr.w) * wp[7]; }
            NST[(size_t)(chain * 64 + c) * 128 + tid] = s;
        }
    }
}
__device__ __forceinline__ void mlstm_scan_phase(bf16_t* CST, float* NST, const float* SC, float* MST, int gtid, int nthreads) {
    for (int idx = gtid; idx < 64 * 2048; idx += nthreads) {
        const int chain = idx >> 11, e = idx & 2047, dir = chain & 1; const bool hasn = e < 16;
        float C[8], N[8]; float m = 0.f;
#pragma unroll
        for (int i = 0; i < 8; ++i) { C[i] = 0.f; N[i] = 0.f; }
        for (int step = 0; step < 64; ++step) {
            const int c = dir ? 63 - step : step; const int base = chain * 64 + c;
            const float g = SC[base * 2], ml = SC[base * 2 + 1];
            const float mn = fmaxf(g + m, ml), dec = __expf(g + m - mn), sc = __expf(ml - mn);
            GAS u32x4* p = (GAS u32x4*)(CST + (size_t)base * 16384 + e * 8);
            const u32x4 kl = *p;
            u32x4 st; st.x = pk2(C[0], C[1]); st.y = pk2(C[2], C[3]); st.z = pk2(C[4], C[5]); st.w = pk2(C[6], C[7]);
            *p = st;
            if (e == 0) MST[base] = m;
            C[0] = dec * C[0] + sc * bflo(kl.x); C[1] = dec * C[1] + sc * bfhi(kl.x); C[2] = dec * C[2] + sc * bflo(kl.y); C[3] = dec * C[3] + sc * bfhi(kl.y);
            C[4] = dec * C[4] + sc * bflo(kl.z); C[5] = dec * C[5] + sc * bfhi(kl.z); C[6] = dec * C[6] + sc * bflo(kl.w); C[7] = dec * C[7] + sc * bfhi(kl.w);
            if (hasn) {
                GAS f32x4* q = (GAS f32x4*)(NST + (size_t)base * 128 + e * 8);
                const f32x4 n0 = q[0], n1 = q[1];
                q[0] = (f32x4){N[0], N[1], N[2], N[3]}; q[1] = (f32x4){N[4], N[5], N[6], N[7]};
                N[0] = dec * N[0] + sc * n0.x; N[1] = dec * N[1] + sc * n0.y; N[2] = dec * N[2] + sc * n0.z; N[3] = dec * N[3] + sc * n0.w;
                N[4] = dec * N[4] + sc * n1.x; N[5] = dec * N[5] + sc * n1.y; N[6] = dec * N[6] + sc * n1.z; N[7] = dec * N[7] + sc * n1.w;
            }
            m = mn;
        }
    }
}
__device__ __forceinline__ void mlstm_c_phase(const bf16_t* QKV, const float* Gt, const bf16_t* VmT, const bf16_t* CST, const float* NST, const float* MST, const float* mgain, bf16_t* Y,
                                              ldsp_t lds, int tid, int wave, int r32, int hi, int Bx, int Gd) {
    LAS float* bc = (LAS float*)lds; LAS float* rbv = bc + 128; LAS float* aif = bc + 256; LAS float* aib = bc + 384; LAS float* nst = bc + 512; LAS float* hb = bc + 1024;
    const int dir = wave >> 2, tb = wave & 3, t = 32 * tb + r32;
    for (int u = Bx; u < BATCH * 4 * 64; u += Gd) {
        const int c = u & 63, h = (u >> 6) & 3, b = u >> 8;
        const size_t tok0 = (size_t)b * SEQ + c * 128;
        __syncthreads();
        float i_f = 0.f, i_b = 0.f;
        if (tid < 128) { const float* gp = Gt + (tok0 + tid) * 16 + h; i_f = gp[0]; hb[tid] = logsig(gp[4]); i_b = gp[8]; hb[128 + tid] = logsig(gp[12]); }
        else if (tid < 384) { const int d2 = (tid - 128) >> 7, dk = (tid - 128) & 127; nst[d2 * 128 + dk] = NST[(size_t)(((b * 4 + h) * 2 + d2) * 64 + c) * 128 + dk]; }
        __syncthreads();
        if (tid < 128) {
            float cf = 0.f, cb = 0.f;
            for (int s = 0; s < 128; ++s) { if (s <= tid) cf += hb[s]; if (s >= tid) cb += hb[128 + s]; }
            bc[tid] = cf; rbv[tid] = cb; aif[tid] = i_f - cf; aib[tid] = i_b - cb;
        }
        __syncthreads();
        const int chain = (b * 4 + h) * 2 + dir;
        const float mst = MST[chain * 64 + c];
        const float bct = dir ? rbv[t] : bc[t];
        const LAS float* ai = dir ? aib : aif;
        bf16x8 qf[8];
        { const bf16_t* qp = QKV + (tok0 + t) * QKVP + 768 + h * 128 + 8 * hi;
#pragma unroll
          for (int k0 = 0; k0 < 8; ++k0) qf[k0] = *(const GAS bf16x8*)(qp + 16 * k0); }
        float mmax = -1e30f;
        for (int s = hi; s < 128; s += 2) { const bool ok = dir == 0 ? s <= t : s >= t; const float v = bct + ai[s]; if (ok) mmax = fmaxf(mmax, v); }
        mmax = fmaxf(mmax, shx(mmax, 32));
        const float mt = fmaxf(mmax, bct + mst);
        const float inter = __expf(bct + mst - mt);
        f32x16 acc[4];
#pragma unroll
        for (int d0 = 0; d0 < 4; ++d0) {
#pragma unroll
            for (int r = 0; r < 16; ++r) acc[d0][r] = 0.f;
            const bf16_t* cp = CST + (size_t)(chain * 64 + c) * 16384 + (32 * d0 + r32) * 128 + 8 * hi;
#pragma unroll
            for (int k0 = 0; k0 < 8; ++k0) { const bf16x8 cf = *(const GAS bf16x8*)(cp + 16 * k0); acc[d0] = MFMA32(cf, qf[k0], acc[d0]); }
            acc[d0] = acc[d0] * inter;
        }
        float den = 0.f;
#pragma unroll 1
        for (int sb = 0; sb < 4; ++sb) {
            const bool actv = dir == 0 ? sb <= tb : sb >= tb;
            if (!actv) continue;
            f32x16 p;
#pragma unroll
            for (int r = 0; r < 16; ++r) p[r] = 0.f;
            const bf16_t* kp = QKV + (tok0 + 32 * sb + r32) * QKVP + 1280 + h * 128 + 8 * hi;
#pragma unroll
            for (int k0 = 0; k0 < 8; ++k0) { const bf16x8 kf = *(const GAS bf16x8*)(kp + 16 * k0); p = MFMA32(kf, qf[k0], p); }
#pragma unroll
            for (int r = 0; r < 16; ++r) { const int s = 32 * sb + crow(r, hi); const bool ok = dir == 0 ? s <= t : s >= t;
                const float v = ok ? p[r] * KSCALE * __expf(bct + ai[s] - mt) : 0.f; p[r] = v; den += v; }
#pragma unroll
            for (int j = 0; j < 2; ++j) {
                const u32x4 w = {pk2(p[8 * j], p[8 * j + 1]), pk2(p[8 * j + 2], p[8 * j + 3]), pk2(p[8 * j + 4], p[8 * j + 5]), pk2(p[8 * j + 6], p[8 * j + 7])};
                const bf16x8 pb = __builtin_bit_cast(bf16x8, w);
#pragma unroll
                for (int d0 = 0; d0 < 4; ++d0) {
                    const bf16_t* vp = VmT + ((size_t)((b * 4 + h) * 128 + 32 * d0 + r32)) * SEQ + c * 128 + 32 * sb + 16 * j + 4 * hi;
                    const s16x4 lo = *(const GAS s16x4*)vp, h4 = *(const GAS s16x4*)(vp + 8);
                    const bf16x8 a = {lo[0], lo[1], lo[2], lo[3], h4[0], h4[1], h4[2], h4[3]};
                    acc[d0] = MFMA32(a, pb, acc[d0]);
                }
            }
        }
        den += shx(den, 32);
        float qn = 0.f;
#pragma unroll
        for (int k0 = 0; k0 < 8; ++k0) { const u32x4 qw = __builtin_bit_cast(u32x4, qf[k0]); const LAS float* np = nst + dir * 128 + 16 * k0 + 8 * hi;
            qn += bflo(qw.x) * np[0] + bfhi(qw.x) * np[1] + bflo(qw.y) * np[2] + bfhi(qw.y) * np[3] + bflo(qw.z) * np[4] + bfhi(qw.z) * np[5] + bflo(qw.w) * np[6] + bfhi(qw.w) * np[7]; }
        qn += shx(qn, 32);
        den += inter * qn;
        const float rden = 1.f / fmaxf(fabsf(den), __expf(-mt));
        __syncthreads();
        if (dir == 1) {
#pragma unroll
            for (int d0 = 0; d0 < 4; ++d0)
#pragma unroll
                for (int r = 0; r < 16; ++r) hb[(32 * d0 + crow(r, hi)) * 129 + t] = acc[d0][r] * rden;
        }
        __syncthreads();
        if (dir == 0) {
            float ss = 0.f;
#pragma unroll
            for (int d0 = 0; d0 < 4; ++d0)
#pragma unroll
                for (int r = 0; r < 16; ++r) { const float v = acc[d0][r] * rden + hb[(32 * d0 + crow(r, hi)) * 129 + t]; acc[d0][r] = v; ss += v * v; }
            ss += shx(ss, 32);
            const float rstd = rsqrtf(ss * (1.f / 128.f) + EPS);
            const bf16_t* op = QKV + (tok0 + t) * QKVP + 2304 + h * 128; bf16_t* yp = Y + (tok0 + t) * DM + 512 + h * 128;
#pragma unroll
            for (int d0 = 0; d0 < 4; ++d0)
#pragma unroll
                for (int g = 0; g < 4; ++g) {
                    const int d = 32 * d0 + 8 * g + 4 * hi; const f32x4 gn = *(const f32x4*)(mgain + h * 128 + d); const u32x2 ow = *(const u32x2*)(op + d);
                    const float s0 = 1.f / (1.f + __expf(-bflo(ow.x))), s1 = 1.f / (1.f + __expf(-bfhi(ow.x))), s2 = 1.f / (1.f + __expf(-bflo(ow.y))), s3 = 1.f / (1.f + __expf(-bfhi(ow.y)));
                    u32x2 w; w.x = pk2(acc[d0][4 * g] * rstd * gn.x * s0, acc[d0][4 * g + 1] * rstd * gn.y * s1); w.y = pk2(acc[d0][4 * g + 2] * rstd * gn.z * s2, acc[d0][4 * g + 3] * rstd * gn.w * s3);
                    *(u32x2*)(yp + d) = w;
                }
        }
    }
}
constexpr size_t WS_GP = 1008 * MiB, WS_WC = 1016 * MiB;
__device__ __forceinline__ void mlstm_gates_phase(const float* Gt, float* GP, float* WC, float* SC, int gw, int NGW, int lane) {
    for (int u = gw; u < BATCH * 4 * 64; u += NGW) {
        const int c = u & 63, h = (u >> 6) & 3, b = u >> 8;
        const size_t tok0 = (size_t)b * SEQ + c * 128;
        const int t0 = 2 * lane;
        const float* g0 = Gt + (tok0 + t0) * 16 + h; const float* g1 = g0 + 16;
        const float if0 = g0[0], ff0 = logsig(g0[4]), ib0 = g0[8], fb0 = logsig(g0[12]);
        const float if1 = g1[0], ff1 = logsig(g1[4]), ib1 = g1[8], fb1 = logsig(g1[12]);
        const float sf = ff0 + ff1, sb = fb0 + fb1;
        float xf = sf, xb = sb;
#pragma unroll
        for (int o = 1; o < 64; o <<= 1) { const float yf = shup(xf, o), yb = shup(xb, o); if (lane >= o) { xf += yf; xb += yb; } }
        const float totf = shl_(xf, 63), totb = shl_(xb, 63);
        const float bc0 = (xf - sf) + ff0, bc1 = bc0 + ff1;
        const float cb0 = (xb - sb) + fb0, cb1 = cb0 + fb1;
        const float rb0 = totb - cb0 + fb0, rb1 = totb - cb1 + fb1;
        const float aif0 = if0 - bc0, aif1 = if1 - bc1, aib0 = ib0 - rb0, aib1 = ib1 - rb1;
        float px = fmaxf(aif0, aif1);
#pragma unroll
        for (int o = 1; o < 64; o <<= 1) { const float y = shup(px, o); if (lane >= o) px = fmaxf(px, y); }
        float pe = shup(px, 1); if (lane == 0) pe = -3.0e38f;
        const float pmf0 = fmaxf(pe, aif0), pmf1 = fmaxf(pmf0, aif1);
        float sx = fmaxf(aib0, aib1);
#pragma unroll
        for (int o = 1; o < 64; o <<= 1) { const float y = shdn(sx, o); if (lane + o < 64) sx = fmaxf(sx, y); }
        float se = shdn(sx, 1); if (lane == 63) se = -3.0e38f;
        const float pmb1 = fmaxf(se, aib1), pmb0 = fmaxf(pmb1, aib0);
        const float mxf = shl_(px, 63), mxb = shl_(sx, 0);
        const float wf0 = __expf(aif0 - mxf) * KSCALE, wf1 = __expf(aif1 - mxf) * KSCALE, wb0 = __expf(aib0 - mxb) * KSCALE, wb1 = __expf(aib1 - mxb) * KSCALE;
        GAS f32x4* gp = (GAS f32x4*)(GP + ((size_t)(b * 4 + h) * SEQ + c * 128 + t0) * 8);
        gp[0] = (f32x4){bc0, rb0, aif0, aib0}; gp[1] = (f32x4){wf0, wb0, pmf0, pmb0}; gp[2] = (f32x4){bc1, rb1, aif1, aib1}; gp[3] = (f32x4){wf1, wb1, pmf1, pmb1};
        const int chf = (b * 4 + h) * 2;
        *(GAS f32x2*)(WC + (size_t)(chf * 64 + c) * 128 + t0) = (f32x2){wf0, wf1};
        *(GAS f32x2*)(WC + (size_t)((chf + 1) * 64 + c) * 128 + t0) = (f32x2){wb0, wb1};
        if (lane == 0) { SC[(chf * 64 + c) * 2] = totf; SC[(chf * 64 + c) * 2 + 1] = totf + mxf; SC[((chf + 1) * 64 + c) * 2] = totb; SC[((chf + 1) * 64 + c) * 2 + 1] = totb + mxb; }
    }
}
__device__ __forceinline__ void mlstm_a2_phase(const float* WC, const bf16_t* KmT, const bf16_t* VmT, bf16_t* CST, float* NST, int gw, int NGW, int r32, int hi) {
    for (int u = gw; u < BATCH * 4 * 64 * 2 * 4; u += NGW) {
        const int mi = u & 3, dir = (u >> 2) & 1, c = (u >> 3) & 63, h = (u >> 9) & 3, b = u >> 11, chain = (b * 4 + h) * 2 + dir;
        const float* wp0 = WC + (size_t)(chain * 64 + c) * 128 + 8 * hi;
        const bf16_t* vp = VmT + ((size_t)((b * 4 + h) * 128 + 32 * mi + r32)) * SEQ + c * 128 + 8 * hi;
        const bf16_t* kp = KmT + ((size_t)((b * 4 + h) * 128 + r32)) * SEQ + c * 128 + 8 * hi;
        f32x16 acc[4]; float nl[4];
#pragma unroll
        for (int ni = 0; ni < 4; ++ni) { nl[ni] = 0.f;
#pragma unroll
            for (int r = 0; r < 16; ++r) acc[ni][r] = 0.f; }
#pragma unroll 2
        for (int ks = 0; ks < 8; ++ks) {
            const bf16x8 a = *(const GAS bf16x8*)(vp + 16 * ks);
            const f32x4 w0 = *(const GAS f32x4*)(wp0 + 16 * ks), w1 = *(const GAS f32x4*)(wp0 + 16 * ks + 4);
#pragma unroll
            for (int ni = 0; ni < 4; ++ni) {
                const u32x4 kr = *(const GAS u32x4*)(kp + (size_t)(32 * ni) * SEQ + 16 * ks);
                const float p0 = bflo(kr.x) * w0.x, p1 = bfhi(kr.x) * w0.y, p2 = bflo(kr.y) * w0.z, p3 = bfhi(kr.y) * w0.w, p4 = bflo(kr.z) * w1.x, p5 = bfhi(kr.z) * w1.y, p6 = bflo(kr.w) * w1.z, p7 = bfhi(kr.w) * w1.w;
                nl[ni] += ((p0 + p1) + (p2 + p3)) + ((p4 + p5) + (p6 + p7));
                const u32x4 kw = {pk2(p0, p1), pk2(p2, p3), pk2(p4, p5), pk2(p6, p7)};
                acc[ni] = MFMA32(a, __builtin_bit_cast(bf16x8, kw), acc[ni]);
            }
        }
#pragma unroll
        for (int g = 0; g < 4; ++g) {
            GAS bf16_t* cp = (GAS bf16_t*)(CST + (size_t)(chain * 64 + c) * 16384 + (32 * mi + 8 * g + 4 * hi) * 128 + r32);
            asm volatile("" : "+v"(cp));
#pragma unroll
            for (int e = 0; e < 4; ++e)
#pragma unroll
                for (int ni = 0; ni < 4; ++ni) cp[e * 128 + 32 * ni] = (bf16_t)(pk2(acc[ni][4 * g + e], 0.f) & 0xffffu);
        }
#pragma unroll
        for (int ni = 0; ni < 4; ++ni) { const float v = nl[ni] + shx(nl[ni], 32); if (mi == 0 && hi == 0) NST[(size_t)(chain * 64 + c) * 128 + 32 * ni + r32] = v; }
    }
}
__device__ __forceinline__ void mlstm_c2_phase(const bf16_t* QKV, const float* GP, const bf16_t* VmT, const bf16_t* CST, const float* NST, const float* MST, const float* mgain, bf16_t* Y,
                                               LAS float* wl, int gw, int NGW, int lane_, int r32_, int hi_) {
    LAS float* hs = wl; LAS float* aiL = wl + 4096;
    for (int u = gw; u < BATCH * 4 * 64 * 4; u += NGW) {
        const int lane = lane_id(), r32 = lane & 31, hi = lane >> 5; (void)lane_; (void)r32_; (void)hi_;
        const int tb = u & 3, c = (u >> 2) & 63, h = (u >> 8) & 3, b = u >> 10, t = 32 * tb + r32;
        const size_t tok0 = (size_t)b * SEQ + c * 128;
        const GAS f32x4* gpc = (const GAS f32x4*)(GP + ((size_t)(b * 4 + h) * SEQ + c * 128) * 8);
        { const f32x4 e0 = gpc[(2 * lane) * 2], e1 = gpc[(2 * lane + 1) * 2]; aiL[2 * lane] = e0.z; aiL[128 + 2 * lane] = e0.w; aiL[2 * lane + 1] = e1.z; aiL[128 + 2 * lane + 1] = e1.w; }
        LDS_FENCE();
#pragma nounroll
        for (int dir_ = 0; dir_ < 2; ++dir_) {
            int dir = dir_; asm volatile("" : "+s"(dir));
            bf16x8 qf[8];
            { const bf16_t* qp = QKV + (tok0 + t) * QKVP + 768 + h * 128 + 8 * hi;
#pragma unroll
              for (int k0 = 0; k0 < 8; ++k0) qf[k0] = *(const GAS bf16x8*)(qp + 16 * k0); }
            const int chain = (b * 4 + h) * 2 + dir;
            const float mst = MST[chain * 64 + c];
            const GAS float* gpt = (const GAS float*)(gpc + t * 2) + dir;
            const float bct = gpt[0], pm = gpt[6];
            const LAS float* ai = aiL + dir * 128;
            const float mt = fmaxf(bct + pm, bct + mst), inter = __expf(bct + mst - mt);
            f32x16 acc[4];
#pragma unroll
            for (int d0 = 0; d0 < 4; ++d0) {
#pragma unroll
                for (int r = 0; r < 16; ++r) acc[d0][r] = 0.f;
                const bf16_t* cp = CST + (size_t)(chain * 64 + c) * 16384 + (32 * d0 + r32) * 128 + 8 * hi;
#pragma unroll
                for (int k0 = 0; k0 < 8; ++k0) { const bf16x8 cf = *(const GAS bf16x8*)(cp + 16 * k0); acc[d0] = MFMA32(cf, qf[k0], acc[d0]); }
                acc[d0] = acc[d0] * inter;
            }
            float den = 0.f;
#pragma unroll 1
            for (int sb = 0; sb < 4; ++sb) {
                const bool actv = dir == 0 ? sb <= tb : sb >= tb;
                if (!actv) continue;
                f32x16 p;
#pragma unroll
                for (int r = 0; r < 16; ++r) p[r] = 0.f;
                const int pr = (r32 & 0x13) | ((r32 & 4) << 1) | ((r32 & 8) >> 1);
                const bf16_t* kp = QKV + (tok0 + 32 * sb + pr) * QKVP + 1280 + h * 128 + 8 * hi;
#pragma unroll
                for (int k0 = 0; k0 < 8; ++k0) { const bf16x8 kf = *(const GAS bf16x8*)(kp + 16 * k0); p = MFMA32(kf, qf[k0], p); }
#pragma unroll
                for (int r = 0; r < 16; ++r) { const int s = 32 * sb + 16 * (r >> 3) + 8 * hi + (r & 7); const bool ok = dir == 0 ? s <= t : s >= t;
                    const float v = ok ? p[r] * KSCALE * __expf(bct + ai[s] - mt) : 0.f; p[r] = v; den += v; }
#pragma unroll
                for (int j = 0; j < 2; ++j) {
                    const u32x4 w = {pk2(p[8 * j], p[8 * j + 1]), pk2(p[8 * j + 2], p[8 * j + 3]), pk2(p[8 * j + 4], p[8 * j + 5]), pk2(p[8 * j + 6], p[8 * j + 7])};
                    const bf16x8 pb = __builtin_bit_cast(bf16x8, w);
#pragma unroll
                    for (int d0 = 0; d0 < 4; ++d0) {
                        const bf16_t* vp = VmT + ((size_t)((b * 4 + h) * 128 + 32 * d0 + r32)) * SEQ + c * 128 + 32 * sb + 16 * j + 8 * hi;
                        const bf16x8 a = *(const GAS bf16x8*)vp;
                        acc[d0] = MFMA32(a, pb, acc[d0]);
                    }
                }
            }
            den += shx(den, 32);
            float qn = 0.f;
            { const float* np0 = NST + (size_t)(chain * 64 + c) * 128 + 8 * hi;
#pragma unroll
              for (int k0 = 0; k0 < 8; ++k0) { const u32x4 qw = __builtin_bit_cast(u32x4, qf[k0]); const f32x4 n0 = *(const GAS f32x4*)(np0 + 16 * k0), n1 = *(const GAS f32x4*)(np0 + 16 * k0 + 4);
                  qn += bflo(qw.x) * n0.x + bfhi(qw.x) * n0.y + bflo(qw.y) * n0.z + bfhi(qw.y) * n0.w + bflo(qw.z) * n1.x + bfhi(qw.z) * n1.y + bflo(qw.w) * n1.z + bfhi(qw.w) * n1.w; } }
            qn += shx(qn, 32);
            den += inter * qn;
            const float rden = 1.f / fmaxf(fabsf(den), __expf(-mt));
            if (dir == 0) {
#pragma unroll
                for (int d0 = 0; d0 < 4; ++d0)
#pragma unroll
                    for (int r = 0; r < 16; ++r) hs[(32 * d0 + crow(r, hi)) * 32 + r32] = acc[d0][r] * rden;
                LDS_FENCE();
            } else {
                float ss = 0.f;
#pragma unroll
                for (int d0 = 0; d0 < 4; ++d0)
#pragma unroll
                    for (int r = 0; r < 16; ++r) { const float v = acc[d0][r] * rden + hs[(32 * d0 + crow(r, hi)) * 32 + r32]; acc[d0][r] = v; ss += v * v; }
                ss += shx(ss, 32);
                const float rstd = rsqrtf(ss * (1.f / 128.f) + EPS);
                const bf16_t* op = QKV + (tok0 + t) * QKVP + 2304 + h * 128; bf16_t* yp = Y + (tok0 + t) * DM + 512 + h * 128;
#pragma unroll
                for (int d0 = 0; d0 < 4; ++d0)
#pragma unroll
                    for (int g = 0; g < 4; ++g) {
                        const int d = 32 * d0 + 8 * g + 4 * hi; const f32x4 gn = *(const GAS f32x4*)(mgain + h * 128 + d); const u32x2 ow = *(const GAS u32x2*)(op + d);
                        const float s0 = 1.f / (1.f + __expf(-bflo(ow.x))), s1 = 1.f / (1.f + __expf(-bfhi(ow.x))), s2 = 1.f / (1.f + __expf(-bflo(ow.y))), s3 = 1.f / (1.f + __expf(-bfhi(ow.y)));
                        u32x2 w; w.x = pk2(acc[d0][4 * g] * rstd * gn.x * s0, acc[d0][4 * g + 1] * rstd * gn.y * s1); w.y = pk2(acc[d0][4 * g + 2] * rstd * gn.z * s2, acc[d0][4 * g + 3] * rstd * gn.w * s3);
                        *(GAS u32x2*)(yp + d) = w;
                    }
            }
        }
        LDS_FENCE();
    }
}
#define PH_BEGIN { int tid = wave_s * 64 + lane_id(); asm volatile("" : "+v"(tid)); const int lane = tid & 63, wave = wave_s, r32 = lane & 31, hi = lane >> 5; \
    int Bx = blockIdx.x, Gd = gridDim.x; asm volatile("" : "+s"(Bx), "+s"(Gd)); \
    const int gw = Bx * NWAVES + wave, NGW = Gd * NWAVES, gtid = Bx * NTHR + tid, nthreads = Gd * NTHR; \
    LAS float* scrf = (LAS float*)(lds + wave * 16384); LAS bf16_t* scrh = (LAS bf16_t*)(lds + wave * 16384); \
    (void)Bx; (void)Gd; (void)lane; (void)r32; (void)hi; (void)gw; (void)NGW; (void)gtid; (void)nthreads; (void)scrf; (void)scrh;
#define PH_END }
__global__ void __launch_bounds__(NTHR) fwd_megakernel(Args args) {
    extern __shared__ __attribute__((aligned(16))) unsigned char lds_raw[];
    cg::grid_group grid = cg::this_grid();
    ldsp_t lds = (ldsp_t)lds_raw;
    const int wave_s = __builtin_amdgcn_readfirstlane(threadIdx.x >> 6);
    unsigned char* wsl = args.ws;
    if (threadIdx.x < 2) ((LAS unsigned*)(lds + (LDS_BYTES - 16)))[threadIdx.x] = 0u;
    __syncthreads();
    xb_post((unsigned*)wsl, wave_s);
    grid.sync();
#define GSYNC() do { gbar((unsigned*)wsl, (volatile LAS unsigned*)(lds + (LDS_BYTES - 16)), wave_s); asm volatile("" : "+s"(wsl)); } while (0)
#define WSP wsl
#define x_in (args.in[0])
#define mem (args.in[1])
#define t5raw (args.in[2])
#define out (args.out)
#define RSB(k) ((float*)(WSP + WS_RS) + (size_t)(k) * MTOK)
#define GPB ((float*)(WSP + WS_GP))
#define WCB ((float*)(WSP + WS_WC))
#define XB ((bf16_t*)out + (size_t)MTOK * DM)
#define XB2 ((bf16_t*)(WSP + WS_Y))
#define HN ((bf16_t*)(WSP + WS_HN))
#define QKV ((bf16_t*)(WSP + WS_QKV))
#define VT ((bf16_t*)(WSP + WS_VT))
#define Y ((bf16_t*)(WSP + WS_Y))
#define CST ((bf16_t*)(WSP + WS_CST))
#define Gt ((float*)(WSP + WS_G))
#define NST ((float*)(WSP + WS_NST))
#define SC ((float*)(WSP + WS_SC))
#define MST ((float*)(WSP + WS_MST))
#define QC ((bf16_t*)(WSP + WS_QC))
#define KVC(l_) ((bf16_t*)(WSP + WS_KVC + (size_t)(l_) * 4 * MiB))
#define VTC(l_) ((bf16_t*)(WSP + WS_VTC + (size_t)(l_) * 2 * MiB))
#define MEMN ((bf16_t*)(WSP + WS_MEMN))
#define OC ((bf16_t*)(WSP + WS_OC))
#define SIDEB ((float*)(WSP + WS_SIDE))
#define ACT ((bf16_t*)(WSP + WS_ACT))
#define T5T ((float*)(WSP + WS_T5))
#define ROPEC ((float*)(WSP + WS_ROPE))
#define ROPES (ROPEC + 2048)

    PH_BEGIN
#ifdef PROBE_P0
    for (int rep = 0; rep < 2; ++rep) {
#else
    {
#endif
    int goff = 0;
    wt_matrix(args.in[7], 1024, 2832, (bf16_t*)(WSP + WS_WIN0), false, scrf, gw, NGW, lane, goff);
    wt_matrix(args.in[11], 1024, 1024, (bf16_t*)(WSP + WS_WOUT0), false, scrf, gw, NGW, lane, goff);
    wt_matrix(args.in[12], 1024, 3072, (bf16_t*)(WSP + WS_WIN1), false, scrf, gw, NGW, lane, goff);
    wt_matrix(args.in[18], 1024, 1024, (bf16_t*)(WSP + WS_WOUT1), false, scrf, gw, NGW, lane, goff);
    for (int l = 0; l < 2; ++l) {
        wt_matrix(args.in[19] + (size_t)l * 1024 * 512, 1024, 512, (bf16_t*)(WSP + WS_WQ + l * MiB), false, scrf, gw, NGW, lane, goff);
        wt_matrix(args.in[20] + (size_t)l * 1024 * 1024, 1024, 1024, (bf16_t*)(WSP + WS_WKV + 2 * l * MiB), false, scrf, gw, NGW, lane, goff);
        wt_matrix(args.in[22] + (size_t)l * 512 * 1024, 512, 1024, (bf16_t*)(WSP + WS_WO + l * MiB), false, scrf, gw, NGW, lane, goff);
        wt_matrix(args.in[23] + (size_t)l * 1024 * 5632, 1024, 5632, (bf16_t*)(WSP + WS_WUP + 11 * l * MiB), true, scrf, gw, NGW, lane, goff);
        wt_matrix(args.in[26] + (size_t)l * 2816 * 1024, 2816, 1024, (bf16_t*)(WSP + WS_WDN + 6 * l * MiB), false, scrf, gw, NGW, lane, goff);
    }
    for (int i = gtid; i < 4 * 16384; i += nthreads) {
        const int h = i >> 14, rel = (i & 16383) - 8192, n = rel < 0 ? -rel : rel;
        int bk;
        if (n < 8) bk = n; else { const int lg = 8 + (int)(logf((float)n / 8.0f) / logf(16.0f) * 8.0f); bk = lg < 15 ? lg : 15; }
        bk += rel > 0 ? 16 : 0;
        T5T[i] = t5raw[bk * 4 + h] * LOG2E;
    }
    for (int i = gtid; i < 2048; i += nthreads) {
        const int pos = i >> 4, j = i & 15;
        const float inv = exp2f(-(float)j * (13.287712379549449f / 16.0f));
        const double rev = (double)((float)pos * inv) * 0.15915494309189535; const float fr = (float)(rev - floor(rev));
        ROPEC[i] = __builtin_amdgcn_cosf(fr); ROPES[i] = __builtin_amdgcn_sinf(fr);
    }
    }
    rms_rows(x_in, args.in[3], HN, MTOK, gw, NGW, lane);
#ifdef PROBE_RMS
    rms_rows(x_in, args.in[3], HN, MTOK, gw, NGW, lane);
#endif
    rms_rows(mem, args.in[5], MEMN, BATCH * MEMLEN, gw, NGW, lane);
    rms_rows(mem, args.in[5] + DM, MEMN + (size_t)BATCH * MEMLEN * DM, BATCH * MEMLEN, gw, NGW, lane);
    for (int i = gtid; i < 5 * MTOK / 4; i += nthreads) ((GAS f32x4*)RSB(0))[i] = (f32x4){0.f, 0.f, 0.f, 0.f};
    PH_END
    GSYNC();

#pragma nounroll
    for (int l = 0; l < 2; ++l) {
#ifndef NO_GEMM
        if (l == 0) { PH_BEGIN EpiBf16G E{QKV, QKVP, Gt, args.in[8], 2816, nullptr}; run_gemm(lds, HN, (const bf16_t*)(WSP + WS_WIN0), MTOK, 3072, 1024, E, tid, Bx, Gd); PH_END
            PH_BEGIN EpiBf16G E{KVC(0), 1024, nullptr, nullptr, 0, nullptr}; run_gemm(lds, MEMN, (const bf16_t*)(WSP + WS_WKV), BATCH * MEMLEN, 1024, 1024, E, tid, Bx, Gd); PH_END
            PH_BEGIN EpiBf16G E{KVC(1), 1024, nullptr, nullptr, 0, nullptr}; run_gemm(lds, MEMN + (size_t)BATCH * MEMLEN * DM, (const bf16_t*)(WSP + WS_WKV + 2 * MiB), BATCH * MEMLEN, 1024, 1024, E, tid, Bx, Gd); PH_END }
        else        PH_BEGIN EpiBf16G E{QKV, QKVP, nullptr, nullptr, 0, RSB(2)};  run_gemm(lds, HN, (const bf16_t*)(WSP + WS_WIN1), MTOK, 3072, 1024, E, tid, Bx, Gd); PH_END
#endif
        GSYNC();
        PH_BEGIN
        if (l == 0) {
            qknorm_rows<64, true>(QKV, QKVP, 512, 128, MTOK, 0, args.in[9], args.in[9] + 64, 1.f, 1.f, ROPEC, ROPES, gw, NGW, lane);
            transpose_cols(QKV, QKVP, 640, 128, SEQ, BATCH, VT, scrh, gw, NGW, lane);
#ifdef PROBE_TR
            transpose_cols(QKV, QKVP, 640, 128, SEQ, BATCH, VT, scrh, gw, NGW, lane);
#endif
            transpose_cols(QKV, QKVP, 1280, 512, SEQ, BATCH, VT + (size_t)8 * MiB, scrh, gw, NGW, lane);
#ifdef PROBE_TR
            transpose_cols(QKV, QKVP, 1280, 512, SEQ, BATCH, VT + (size_t)8 * MiB, scrh, gw, NGW, lane);
#endif
            transpose_cols(QKV, QKVP, 1792, 512, SEQ, BATCH, VT + (size_t)40 * MiB, scrh, gw, NGW, lane);
#ifdef PROBE_TR
            transpose_cols(QKV, QKVP, 1792, 512, SEQ, BATCH, VT + (size_t)40 * MiB, scrh, gw, NGW, lane);
#endif
            mlstm_gates_phase(Gt, GPB, WCB, SC, gw, NGW, lane);
            for (int lc = 0; lc < 2; ++lc) {
                qknorm_rows<128, false>(KVC(lc), 1024, 0, 512, BATCH * MEMLEN, 0, args.in[21] + lc * 256, args.in[21] + lc * 256 + 128, 1.f, 1.f, nullptr, nullptr, gw, NGW, lane);
                transpose_cols(KVC(lc), 1024, 512, 512, MEMLEN, BATCH, VTC(lc), scrh, gw, NGW, lane);
#ifdef PROBE_TR
                transpose_cols(KVC(lc), 1024, 512, 512, MEMLEN, BATCH, VTC(lc), scrh, gw, NGW, lane);
#endif
            }
        } else {
            qknorm_rows<64, false>(QKV, QKVP, 512, 512, MTOK, 0, args.in[13], args.in[13] + 64, 1.f, 1.f, nullptr, nullptr, gw, NGW, lane);
            qknorm_rows<64, false>(QKV, QKVP, 2048, 512, MTOK, 0, args.in[15], args.in[15] + 64, 1.f, 1.f, nullptr, nullptr, gw, NGW, lane);
            transpose_cols(QKV, QKVP, 1024, 512, SEQ, BATCH, VT, scrh, gw, NGW, lane);
#ifdef PROBE_TR
            transpose_cols(QKV, QKVP, 1024, 512, SEQ, BATCH, VT, scrh, gw, NGW, lane);
#endif
            transpose_cols(QKV, QKVP, 2560, 512, SEQ, BATCH, VT + (size_t)32 * MiB, scrh, gw, NGW, lane);
#ifdef PROBE_TR
            transpose_cols(QKV, QKVP, 2560, 512, SEQ, BATCH, VT + (size_t)32 * MiB, scrh, gw, NGW, lane);
#endif
        }
        PH_END
        GSYNC();
        if (l == 0) {
            const bf16_t* VaT = VT; const bf16_t* KmT = VT + (size_t)8 * MiB; const bf16_t* VmT = VT + (size_t)40 * MiB;
            (void)VaT; (void)KmT; (void)VmT;
#ifndef NO_MA
            PH_BEGIN mlstm_a2_phase(WCB, KmT, VmT, CST, NST, gw, NGW, r32, hi); PH_END
#ifdef PROBE_MA
            PH_BEGIN mlstm_a2_phase(WCB, KmT, VmT, CST, NST, gw, NGW, r32, hi); PH_END
#endif
#endif
            GSYNC();
            PH_BEGIN mlstm_scan_phase(CST, NST, SC, MST, gtid, nthreads); PH_END
            GSYNC();
#ifndef NO_MC
            PH_BEGIN mlstm_c2_phase(QKV, GPB, VmT, CST, NST, MST, args.in[10], Y, (LAS float*)(lds + wave * 20480), gw, NGW, lane, r32, hi); PH_END
#ifdef PROBE_MC
            PH_BEGIN mlstm_c2_phase(QKV, GPB, VmT, CST, NST, MST, args.in[10], Y, (LAS float*)(lds + wave * 20480), gw, NGW, lane, r32, hi); PH_END
#endif
#if defined(PROBE_B) || defined(PROBE_MLSTM)
            GSYNC();
            PH_BEGIN mlstm_a2_phase(WCB, KmT, VmT, CST, NST, gw, NGW, r32, hi); PH_END
            GSYNC();
            PH_BEGIN mlstm_scan_phase(CST, NST, SC, MST, gtid, nthreads); PH_END
            GSYNC();
            PH_BEGIN mlstm_c2_phase(QKV, GPB, VmT, CST, NST, MST, args.in[10], Y, (LAS float*)(lds + wave * 20480), gw, NGW, lane, r32, hi); PH_END
#endif
#endif
#ifndef NO_GQA
            PH_BEGIN gqa_phase(QKV, VaT, Y, args.in[9], ROPEC, ROPES, lds, tid, wave, r32, hi, Bx, Gd); PH_END
#ifdef PROBE_A
            __syncthreads();
            PH_BEGIN gqa_phase(QKV, VaT, Y, args.in[9], ROPEC, ROPES, lds, tid, wave, r32, hi, Bx, Gd); PH_END
#endif
#endif
        } else {
            const bf16_t* VcT = VT; const bf16_t* VdT = VT + (size_t)32 * MiB;
            (void)VcT; (void)VdT;
#ifndef NO_NA
            PH_BEGIN na_phase(QKV, VcT, Y, args.in[14], args.in[13], args.in[13] + 64, lds, tid, wave, r32, hi, Bx, Gd); PH_END
#if defined(PROBE_B) || defined(PROBE_NA)
            __syncthreads();
            PH_BEGIN na_phase(QKV, VcT, Y, args.in[14], args.in[13], args.in[13] + 64, lds, tid, wave, r32, hi, Bx, Gd); PH_END
#endif
#endif
#ifndef NO_DIFF
            const float lam_init = 0.8f - 0.6f * 0.7408182206817179f;
            PH_BEGIN diff_phase(QKV, VdT, Y, T5T, t5raw, args.in[16], args.in[17], args.in[15], lam_init, (float*)CST, lds, tid, wave, lane, r32, hi, Bx, Gd); PH_END
#ifdef PROBE_A
            __syncthreads();
            PH_BEGIN diff_phase(QKV, VdT, Y, T5T, t5raw, args.in[16], args.in[17], args.in[15], lam_init, (float*)CST, lds, tid, wave, lane, r32, hi, Bx, Gd); PH_END
#endif
#endif
        }
        GSYNC();
#ifndef NO_GEMM
        PH_BEGIN EpiResid E{l == 0 ? (const void*)x_in : (const void*)XB, l == 0 ? 0 : 1, XB, 1, DM, HN, args.in[4] + l * DM, RSB(l == 0 ? 0 : 3)}; run_gemm(lds, Y, (const bf16_t*)(WSP + (l == 0 ? WS_WOUT0 : WS_WOUT1)), MTOK, 1024, 1024, E, tid, Bx, Gd); PH_END
#endif
        GSYNC();
#ifndef NO_GEMM
        PH_BEGIN EpiBf16G E{QC, 512, nullptr, nullptr, 0, RSB(l == 0 ? 0 : 3)}; run_gemm(lds, HN, (const bf16_t*)(WSP + WS_WQ + l * MiB), MTOK, 512, 1024, E, tid, Bx, Gd); PH_END
#endif
        GSYNC();
#ifndef NO_CROSS
        PH_BEGIN cross_phase(QC, KVC(l), VTC(l), OC, args.in[21] + l * 256, lds, tid, wave, r32, hi, Bx, Gd); PH_END
#if defined(PROBE_B) || defined(PROBE_CROSS)
        __syncthreads();
        PH_BEGIN cross_phase(QC, KVC(l), VTC(l), OC, args.in[21] + l * 256, lds, tid, wave, r32, hi, Bx, Gd); PH_END
#endif
#endif
        GSYNC();
#ifndef NO_GEMM
        PH_BEGIN EpiResid E{XB, 1, l == 0 ? XB : XB2, 1, DM, HN, args.in[6] + l * DM, RSB(l == 0 ? 1 : 4)}; run_gemm(lds, OC, (const bf16_t*)(WSP + WS_WO + l * MiB), MTOK, 1024, 512, E, tid, Bx, Gd); PH_END
#endif
        GSYNC();
#ifndef NO_GEMM
        PH_BEGIN EpiConvAct E{ACT, SIDEB, args.in[24] + (size_t)l * 3 * 2 * DFF, args.in[25] + (size_t)l * 2 * DFF, RSB(l == 0 ? 1 : 4)};
                 run_gemm(lds, HN, (const bf16_t*)(WSP + WS_WUP + 11 * l * MiB), MTOK, 2 * DFF, 1024, E, tid, Bx, Gd); PH_END
#endif
        GSYNC();
#ifndef NO_GEMM
        PH_BEGIN EpiResid E{l == 0 ? XB : XB2, 1, l == 0 ? (void*)XB : (void*)out, l == 0 ? 1 : 0, DM, l == 0 ? HN : nullptr, args.in[3] + DM, RSB(2)};
                 run_gemm_fix(lds, ACT, (const bf16_t*)(WSP + WS_WDN + 6 * l * MiB), MTOK, 1024, DFF, E, tid, Bx, Gd, ACT, SIDEB, args.in[24] + (size_t)l * 3 * 2 * DFF, args.in[25] + (size_t)l * 2 * DFF); PH_END
#endif
        GSYNC();
    }
}

#undef WSP
#undef HN
#undef XB
#undef XB2
#undef GPB
#undef WCB
#undef RSB
#undef QKV
#undef VT
#undef Y
#undef CST
#undef Gt
#undef NST
#undef SC
#undef MST
#undef QC
#undef KVC
#undef VTC
#undef MEMN
#undef OC
#undef SIDEB
#undef ACT
#undef T5T
#undef ROPEC
#undef ROPES
#undef x_in
#undef mem
#undef t5raw
#undef out
extern "C" void kernel_launch(void* const* d_in, const int* in_sizes, int n_in, void* d_out, int out_size, void* d_ws, size_t ws_size, hipStream_t stream) {
    static int grid_blocks = 0;
    if (grid_blocks == 0) {
        int dev = 0, cus = 0, per_cu = 0;
        (void)hipGetDevice(&dev);
        (void)hipDeviceGetAttribute(&cus, hipDeviceAttributeMultiprocessorCount, dev);
        (void)hipFuncSetAttribute((const void*)fwd_megakernel, hipFuncAttributeMaxDynamicSharedMemorySize, LDS_BYTES);
        (void)hipOccupancyMaxActiveBlocksPerMultiprocessor(&per_cu, (const void*)fwd_megakernel, NTHR, LDS_BYTES);
        if (per_cu < 1) per_cu = 1;
        grid_blocks = cus * per_cu;
        if (n_in != 27 || ws_size < 1000 * MiB) fprintf(stderr, "kernel_launch: unexpected n_in %d / ws_size %zu\n", n_in, ws_size);
    }
    Args a{};
    for (int i = 0; i < 27; ++i) a.in[i] = (const float*)d_in[i];
    a.out = (float*)d_out; a.ws = (unsigned char*)d_ws;
    (void)hipMemsetAsync(d_ws, 0, 16384, stream);
    void* kargs[] = {&a};
    hipError_t e = hipLaunchCooperativeKernel((const void*)fwd_megakernel, dim3(grid_blocks), dim3(NTHR), kargs, LDS_BYTES, stream);
    if (e != hipSuccess) fprintf(stderr, "cooperative launch failed: %s (grid %d)\n", hipGetErrorString(e), grid_blocks);
}
```

```cpp
#include <hip/hip_runtime.h>
#include <hip/hip_cooperative_groups.h>
#include <cstdio>
#include <cstdint>
namespace cg = cooperative_groups;
namespace pg8 {
#define PG8_LAS __attribute__((address_space(3)))
typedef unsigned short bf16_t;
typedef short bf16x8 __attribute__((ext_vector_type(8)));
typedef float f32x4 __attribute__((ext_vector_type(4)));
typedef unsigned u32x4 __attribute__((ext_vector_type(4)));
constexpr int BM = 256, BK = 64, HALF = 128, HTB = HALF * BK * 2  , STAGE_BYTES = 8 * HTB, NXCD = 8, WGM = 8;

__host__ __device__ __forceinline__ int lds_byte(int r, int c) { const int st = (r >> 4) * 2 + (c >> 5), rr = r & 15, cc = c & 31, ob = rr * 64 + cc * 2; return st * 1024 + (ob ^ (((ob >> 9) & 1) << 5)); }
__host__ __device__ __forceinline__ void stage_rc(int b, int& R, int& C) { const int st = b / 1024, sb = b % 1024, swz = sb ^ (((sb >> 9) & 1) << 5); R = (st >> 1) * 16 + swz / 64; C = (st & 1) * 32 + (swz % 64) / 2; }
__host__ __device__ __forceinline__ int perm32(int rho) { const int n = rho >> 4, i = rho & 15; return 8 * (i >> 2) + 4 * n + (i & 3); }

struct Unit { int pm, pn; };
struct Gemm { const bf16_t* A; const bf16_t* Bt; int M, N, K; };

struct StaticOrder {
    int nM, nN, nwg, G, c;
    __host__ __device__ void init(int M, int N, int G_, int c_) { nM = M / BM; nN = N / BM; nwg = nM * nN; G = G_; c = c_; }
    __host__ __device__ bool next(int i, Unit& u) const {
        const long L = (long)i * G + c; if (L >= nwg) return false;
        int wgid = (int)L; { const int q = nwg / NXCD, r = nwg % NXCD, xcd = wgid % NXCD, off = wgid / NXCD; wgid = (xcd < r ? xcd * (q + 1) : r * (q + 1) + (xcd - r) * q) + off; }
        const int nig = WGM * nN, gid = wgid / nig, fm = gid * WGM, gsz = (nM - fm) < WGM ? (nM - fm) : WGM;
        u.pm = fm + ((wgid % nig) % gsz); u.pn = (wgid % nig) / gsz; return true;
    }
    __device__ __forceinline__ void a_ready(const Unit&) const {}
    __device__ __forceinline__ void done(const Unit&) const {}
};

__device__ __forceinline__ unsigned cvt_pk_bf16(float lo, float hi) { unsigned r; asm volatile("v_cvt_pk_bf16_f32 %0, %1, %2" : "=v"(r) : "v"(lo), "v"(hi)); return r; }
typedef float f32x2 __attribute__((ext_vector_type(2)));
template <class Epi, class Sched, bool ALIGN_EPI = false, bool SP2 = false>
__device__ __forceinline__ void gemm_phase(PG8_LAS unsigned char* lds, const Gemm g, const Sched& S, const Epi& E, int tid_in) {
    int tid_l = tid_in; asm volatile("" : "+v"(tid_l)); const int tid = tid_l, wid = __builtin_amdgcn_readfirstlane(tid >> 6), lane = tid & 63, wr = wid >> 2, wc = wid & 3, fr = lane & 15, fq = lane >> 4;
    const int K = g.K, nt = K / BK;
    unsigned voffA[2], voffB[2];
#pragma unroll
    for (int i = 0; i < 2; ++i) { int R, C; stage_rc(tid * 16 + i * 8192, R, C); const int Rb = Epi::PERM ? ((R & ~31) + perm32(R & 31)) : R;
        voffA[i] = (unsigned)(R * K + C) * 2u; voffB[i] = (unsigned)(Rb * K + C) * 2u; }
    const size_t kstep = (size_t)(BK * 2);
    const size_t hstep = (size_t)HALF * K * 2;
    const size_t tstep = 2 * hstep;
    const unsigned ldsw = (unsigned)wid * 1024u;
    const int aoff = lds_byte(wr * 64 + fr, fq * 8), boff = lds_byte(wc * 32 + fr, fq * 8);
#define PG8_SA(b, h) (((b) * 2 + (h)) * HTB)
#define PG8_SB(b, h) ((4 + (b) * 2 + (h)) * HTB)
#define PG8_STAGE(bufoff, gbase, voff) do { _Pragma("unroll") for (int _i = 0; _i < 2; ++_i) \
        __builtin_amdgcn_global_load_lds((const unsigned*)((const char*)(gbase) + (voff)[_i]), (PG8_LAS unsigned*)(lds + (bufoff) + ldsw + _i * 8192), 16, 0, 0); } while (0)
#define PG8_LDA(dst, b, h) do { _Pragma("unroll") for (int m = 0; m < 4; ++m) _Pragma("unroll") for (int k = 0; k < 2; ++k) dst[m][k] = *(const PG8_LAS bf16x8*)(lds + PG8_SA(b, h) + aoff + m * 2048 + k * 1024); } while (0)
#define PG8_LDB(dst, b, h) do { _Pragma("unroll") for (int n = 0; n < 2; ++n) _Pragma("unroll") for (int k = 0; k < 2; ++k) dst[n][k] = *(const PG8_LAS bf16x8*)(lds + PG8_SB(b, h) + boff + n * 2048 + k * 1024); } while (0)
#define PG8_MMA(ai, bj, At, Bt) do { __builtin_amdgcn_s_setprio(1); _Pragma("unroll") for (int m = 0; m < 4; ++m) _Pragma("unroll") for (int n = 0; n < 2; ++n) _Pragma("unroll") for (int k = 0; k < 2; ++k) \
        acc[ai][bj][m][n] = __builtin_amdgcn_mfma_f32_16x16x32_bf16(Bt[n][k], At[m][k], acc[ai][bj][m][n], 0, 0, 0); __builtin_amdgcn_s_setprio(0); } while (0)
#define PG8_WAIT_V(n) asm volatile("s_waitcnt vmcnt(" #n ")" ::: "memory")
#define PG8_WAIT_L(n) asm volatile("s_waitcnt lgkmcnt(" #n ")" ::: "memory")
#define PG8_BAR __builtin_amdgcn_s_barrier()
#define PG8_SCHED __builtin_amdgcn_sched_barrier(0)
    Unit cur, nxt; int ui = 0;
    if (!S.next(0, cur)) return;
    f32x4 acc[2][2][4][2];
#pragma unroll
    for (int a = 0; a < 2; ++a)
#pragma unroll
        for (int b = 0; b < 2; ++b)
#pragma unroll
            for (int m = 0; m < 4; ++m)
#pragma unroll
                for (int n = 0; n < 2; ++n) acc[a][b][m][n] = (f32x4){0.f, 0.f, 0.f, 0.f};
    bf16x8 At[4][2], B0[2][2], B1[2][2];
    const char* cA = (const char*)g.A + (size_t)cur.pm * tstep; const char* cB = (const char*)g.Bt + (size_t)cur.pn * tstep;
    S.a_ready(cur);
    if constexpr (SP2) {
        PG8_STAGE(PG8_SB(0, 0), cB, voffB); PG8_STAGE(PG8_SB(0, 1), cB + hstep, voffB); PG8_STAGE(PG8_SA(0, 0), cA, voffA); PG8_STAGE(PG8_SA(0, 1), cA + hstep, voffA);
        if (wr == 1) PG8_BAR;
        PG8_WAIT_V(2); PG8_BAR;
        PG8_STAGE(PG8_SB(1, 0), cB + kstep, voffB); PG8_STAGE(PG8_SA(1, 0), cA + kstep, voffA); PG8_STAGE(PG8_SB(1, 1), cB + hstep + kstep, voffB);
        PG8_WAIT_V(6); PG8_BAR;
    } else {
        PG8_STAGE(PG8_SB(0, 0), cB, voffB); PG8_STAGE(PG8_SA(0, 0), cA, voffA); PG8_STAGE(PG8_SB(0, 1), cB + hstep, voffB); PG8_STAGE(PG8_SA(0, 1), cA + hstep, voffA);
        if (wr == 1) PG8_BAR;
        PG8_WAIT_V(4); PG8_BAR;
        PG8_STAGE(PG8_SB(1, 0), cB + kstep, voffB); PG8_STAGE(PG8_SA(1, 0), cA + kstep, voffA); PG8_STAGE(PG8_SB(1, 1), cB + hstep + kstep, voffB);
        PG8_WAIT_V(6); PG8_BAR;
    }
    for (;;) {
        const bool has_next = S.next(ui + 1, nxt);
        const char* nA = has_next ? (const char*)g.A + (size_t)nxt.pm * tstep : cA; const char* nB = has_next ? (const char*)g.Bt + (size_t)nxt.pn * tstep : cB;
        for (int t = 0; t < nt; t += 2) {
            const bool last = (t == nt - 2);
            const char* a1 = cA + (size_t)(t + 1) * kstep;
            const char* a2 = last ? nA : cA + (size_t)(t + 2) * kstep; const char* b2 = last ? nB : cB + (size_t)(t + 2) * kstep;
            const char* a3 = a2 + kstep; const char* b3 = b2 + kstep;
            if (last && has_next) S.a_ready(nxt);
            if constexpr (SP2) {
            PG8_LDB(B0, 0, 0); PG8_LDB(B1, 0, 1); PG8_SCHED; PG8_LDA(At, 0, 0); PG8_STAGE(PG8_SA(1, 1), a1 + hstep, voffA);
            PG8_WAIT_V(8); PG8_WAIT_L(0); PG8_BAR; PG8_MMA(0, 0, At, B0); PG8_MMA(0, 1, At, B1); PG8_BAR; PG8_SCHED;
            PG8_LDA(At, 0, 1); PG8_STAGE(PG8_SB(0, 0), b2, voffB); PG8_STAGE(PG8_SB(0, 1), b2 + hstep, voffB); PG8_STAGE(PG8_SA(0, 0), a2, voffA);
            PG8_WAIT_V(8); PG8_WAIT_L(0); PG8_BAR; PG8_MMA(1, 0, At, B0); PG8_MMA(1, 1, At, B1); PG8_BAR; PG8_SCHED;
            PG8_LDB(B0, 1, 0); PG8_LDB(B1, 1, 1); PG8_SCHED; PG8_LDA(At, 1, 0); PG8_STAGE(PG8_SA(0, 1), a2 + hstep, voffA);
            PG8_WAIT_V(8); PG8_WAIT_L(0); PG8_BAR; PG8_MMA(0, 0, At, B0); PG8_MMA(0, 1, At, B1); PG8_BAR; PG8_SCHED;
            PG8_LDA(At, 1, 1); PG8_STAGE(PG8_SB(1, 0), b3, voffB); PG8_STAGE(PG8_SB(1, 1), b3 + hstep, voffB); PG8_STAGE(PG8_SA(1, 0), a3, voffA);
            PG8_WAIT_V(8); PG8_WAIT_L(0); PG8_BAR; PG8_MMA(1, 0, At, B0); PG8_MMA(1, 1, At, B1); PG8_BAR; PG8_SCHED;
            } else {
            PG8_LDB(B0, 0, 0); PG8_SCHED; PG8_LDA(At, 0, 0); PG8_STAGE(PG8_SA(1, 1), a1 + hstep, voffA);
            PG8_WAIT_L(8); PG8_BAR; PG8_WAIT_L(0); PG8_MMA(0, 0, At, B0); PG8_BAR; PG8_SCHED;
            PG8_LDB(B1, 0, 1); PG8_STAGE(PG8_SB(0, 0), b2, voffB);
            PG8_BAR; PG8_WAIT_L(0); PG8_MMA(0, 1, At, B1); PG8_BAR;
            PG8_LDA(At, 0, 1); PG8_STAGE(PG8_SA(0, 0), a2, voffA);
            PG8_BAR; PG8_WAIT_L(0); PG8_MMA(1, 0, At, B0); PG8_BAR; PG8_SCHED;
            PG8_STAGE(PG8_SB(0, 1), b2 + hstep, voffB);
            PG8_WAIT_V(6); PG8_BAR; PG8_MMA(1, 1, At, B1); PG8_BAR;
            PG8_LDB(B0, 1, 0); PG8_SCHED; PG8_LDA(At, 1, 0); PG8_STAGE(PG8_SA(0, 1), a2 + hstep, voffA);
            PG8_WAIT_L(8); PG8_BAR; PG8_WAIT_L(0); PG8_MMA(0, 0, At, B0); PG8_BAR; PG8_SCHED;
            PG8_LDB(B1, 1, 1); PG8_STAGE(PG8_SB(1, 0), b3, voffB);
            PG8_BAR; PG8_WAIT_L(0); PG8_MMA(0, 1, At, B1); PG8_BAR;
            PG8_LDA(At, 1, 1); PG8_STAGE(PG8_SA(1, 0), a3, voffA);
            PG8_BAR; PG8_WAIT_L(0); PG8_MMA(1, 0, At, B0); PG8_BAR; PG8_SCHED;
            PG8_STAGE(PG8_SB(1, 1), b3 + hstep, voffB);
            PG8_WAIT_V(6); PG8_BAR; PG8_MMA(1, 1, At, B1); PG8_BAR;
            }
        }
        if constexpr (ALIGN_EPI) { if (wr == 0) PG8_BAR; }
        if constexpr (!Epi::AFTER_DRAIN) { E(acc, cur, wr, wc, fr, fq); S.done(cur); }
        if (!has_next) break;
#pragma unroll
        for (int a = 0; a < 2; ++a)
#pragma unroll
            for (int b = 0; b < 2; ++b)
#pragma unroll
                for (int m = 0; m < 4; ++m)
#pragma unroll
                    for (int n = 0; n < 2; ++n) acc[a][b][m][n] = (f32x4){0.f, 0.f, 0.f, 0.f};
        cur = nxt; cA = nA; cB = nB; ++ui;
        if constexpr (ALIGN_EPI) { if (wr == 1) PG8_BAR; }
    }
    PG8_WAIT_V(0);
    if constexpr (!ALIGN_EPI) { if (wr == 0) PG8_BAR; }
    PG8_BAR;
    if constexpr (Epi::AFTER_DRAIN) { E.fused(acc, cur, wr, wc, fr, fq, lds, wid, lane); S.done(cur); }
#undef PG8_SA
#undef PG8_SB
#undef PG8_STAGE
#undef PG8_LDA
#undef PG8_LDB
#undef PG8_MMA
#undef PG8_WAIT_V
#undef PG8_WAIT_L
#undef PG8_BAR
#undef PG8_SCHED
}
}
#define LAS __attribute__((address_space(3)))
typedef unsigned short bf16_t;
typedef short bf16x8 __attribute__((ext_vector_type(8)));
typedef short s16x4 __attribute__((ext_vector_type(4)));
typedef float f32x16 __attribute__((ext_vector_type(16)));
typedef float f32x4 __attribute__((ext_vector_type(4)));
typedef float f32x2 __attribute__((ext_vector_type(2)));
typedef unsigned u32x4 __attribute__((ext_vector_type(4)));
typedef unsigned u32x2 __attribute__((ext_vector_type(2)));
typedef LAS unsigned char* ldsp_t;

constexpr int BATCH = 8, SEQ = 8192, DM = 1024, MTOK = BATCH * SEQ, MEMLEN = 256, DFF = 2816;
constexpr float EPS = 1e-6f, LOG2E = 1.4426950408889634f;
constexpr size_t MiB = 1ull << 20;
constexpr int NWAVES = 8, NTHR = 512;
constexpr int LDS_BYTES = 163840;
constexpr int QKVP = 3072;
constexpr size_t WS_WIN0 = 1 * MiB, WS_WOUT0 = 7 * MiB, WS_WIN1 = 9 * MiB, WS_WOUT1 = 15 * MiB, WS_WQ = 17 * MiB, WS_WKV = 19 * MiB, WS_WO = 23 * MiB,
                 WS_WUP = 25 * MiB, WS_WDN = 47 * MiB, WS_T5 = 59 * MiB, WS_ROPE = 59 * MiB + 512 * 1024;
constexpr size_t WS_HN = 64 * MiB;
constexpr size_t WS_QKV = 192 * MiB;
constexpr size_t WS_VT = 576 * MiB;
constexpr size_t WS_Y = 720 * MiB;
constexpr size_t WS_CST = 848 * MiB;
constexpr size_t WS_G = 976 * MiB, WS_NST = 980 * MiB, WS_SC = 982 * MiB, WS_MST = 983 * MiB;
constexpr size_t WS_QC = 192 * MiB, WS_OC = 272 * MiB, WS_KVC = 994 * MiB, WS_VTC = 1002 * MiB;
constexpr size_t WS_RS = 984 * MiB, WS_MEMN = 986 * MiB;
constexpr size_t WS_ACT = 192 * MiB, WS_SIDE = 544 * MiB;

struct Args { const float* in[27]; float* out; unsigned char* ws; };

#define GAS __attribute__((address_space(1)))
#define LDS_FENCE() asm volatile("s_waitcnt lgkmcnt(0)" ::: "memory")
__device__ __forceinline__ unsigned pk2(float lo, float hi) { typedef __bf16 b2 __attribute__((ext_vector_type(2))); f32x2 v = {lo, hi}; b2 b = __builtin_convertvector(v, b2); return __builtin_bit_cast(unsigned, b); }
__device__ __forceinline__ float bflo(unsigned w) { return __uint_as_float(w << 16); }
__device__ __forceinline__ float bfhi(unsigned w) { return __uint_as_float(w & 0xffff0000u); }
__device__ __forceinline__ float bf1(bf16_t v) { return __uint_as_float(((unsigned)v) << 16); }
__device__ __forceinline__ int lane_id() { int l; asm volatile("v_mbcnt_lo_u32_b32 %0, -1, 0\n\tv_mbcnt_hi_u32_b32 %0, -1, %0" : "=v"(l)); return l; }
__device__ __forceinline__ float bperm(float v, int src) { return __builtin_bit_cast(float, __builtin_amdgcn_ds_bpermute(src << 2, __builtin_bit_cast(int, v))); }
__device__ __forceinline__ float shx(float v, int o) { return bperm(v, lane_id() ^ o); }
__device__ __forceinline__ float shup(float v, int o) { const int l = lane_id(); return bperm(v, l >= o ? l - o : l); }
__device__ __forceinline__ float shdn(float v, int o) { const int l = lane_id(); return bperm(v, l + o < 64 ? l + o : l); }
__device__ __forceinline__ float shl_(float v, int k) { return bperm(v, k); }
__device__ __forceinline__ float wave_sum(float v) {
#pragma unroll
    for (int o = 1; o < 64; o <<= 1) v += shx(v, o);
    return v;
}
__device__ __forceinline__ float ex2(float x) { return __builtin_amdgcn_exp2f(x); }
__device__ __forceinline__ float logsig(float x) { return fminf(x, 0.f) - __logf(1.f + __expf(-fabsf(x))); }
__device__ __forceinline__ int crow(int r, int hi) { return (r & 3) + 8 * (r >> 2) + 4 * hi; }
__device__ __forceinline__ int clampi(int v, int lo, int hi) { return v < lo ? lo : (v > hi ? hi : v); }

struct EpiBf16G {
    static constexpr bool PERM = true, AFTER_DRAIN = false;
    bf16_t* O; int ldc; float* G; const float* gbias; int gcol0; const float* RS;
    __device__ __forceinline__ void operator()(const pg8::f32x4 (&acc)[2][2][4][2], const pg8::Unit& u, int wr, int wc, int fr, int fq) const {
        const int row0 = u.pm * 256 + wr * 64 + fr, col0 = u.pn * 256 + wc * 32 + 8 * fq;
#pragma unroll
        for (int ai = 0; ai < 2; ++ai)
#pragma unroll
            for (int m = 0; m < 4; ++m) {
                const size_t row = (size_t)(row0 + ai * 128 + m * 16);
                const float rstd = RS ? rsqrtf(RS[row] * (1.f / DM) + EPS) : 1.f;
#pragma unroll
                for (int bj = 0; bj < 2; ++bj) {
                    const int col = col0 + bj * 128;
                    const pg8::f32x4 v0 = acc[ai][bj][m][0] * rstd, v1 = acc[ai][bj][m][1] * rstd;
                    if (G != nullptr && col >= gcol0) {
                        if (col < gcol0 + 16) {
                            float* gp = G + row * 16 + (col - gcol0); const float* bp = gbias + (col - gcol0);
                            gp[0] = v0[0] + bp[0]; gp[1] = v0[1] + bp[1]; gp[2] = v0[2] + bp[2]; gp[3] = v0[3] + bp[3];
                            gp[4] = v1[0] + bp[4]; gp[5] = v1[1] + bp[5]; gp[6] = v1[2] + bp[6]; gp[7] = v1[3] + bp[7];
                        }
                    } else {
                        u32x4 w; w.x = pk2(v0[0], v0[1]); w.y = pk2(v0[2], v0[3]); w.z = pk2(v1[0], v1[1]); w.w = pk2(v1[2], v1[3]);
                        *(GAS u32x4*)(O + row * ldc + col) = w;
                    }
                }
            }
    }
};
struct EpiResid {
    static constexpr bool PERM = true, AFTER_DRAIN = false;
    const void* R; int r_bf; void* Out; int o_bf; int ldc; bf16_t* XG; const float* gain; float* RS;
    __device__ __forceinline__ void operator()(const pg8::f32x4 (&acc)[2][2][4][2], const pg8::Unit& u, int wr, int wc, int fr, int fq) const {
        const int row0 = u.pm * 256 + wr * 64 + fr, col0 = u.pn * 256 + wc * 32 + 8 * fq;
        pg8::f32x4 gv[2][2];
        if (XG) {
#pragma unroll
            for (int bj = 0; bj < 2; ++bj)
#pragma unroll
                for (int n = 0; n < 2; ++n) gv[bj][n] = *(const GAS pg8::f32x4*)(gain + col0 + bj * 128 + n * 4);
        }
#pragma unroll
        for (int ai = 0; ai < 2; ++ai)
#pragma unroll
            for (int m = 0; m < 4; ++m) {
                const int row = row0 + ai * 128 + m * 16;
                const size_t off = (size_t)row * ldc + col0;
                float ss = 0.f;
#pragma unroll
                for (int bj = 0; bj < 2; ++bj) {
                    const size_t o2 = off + bj * 128;
                    pg8::f32x4 r0, r1;
                    if (r_bf) { const u32x4 rw = *(const GAS u32x4*)((const bf16_t*)R + o2); r0 = (pg8::f32x4){bflo(rw.x), bfhi(rw.x), bflo(rw.y), bfhi(rw.y)}; r1 = (pg8::f32x4){bflo(rw.z), bfhi(rw.z), bflo(rw.w), bfhi(rw.w)}; }
                    else { r0 = *(const GAS pg8::f32x4*)((const float*)R + o2); r1 = *(const GAS pg8::f32x4*)((const float*)R + o2 + 4); }
                    const pg8::f32x4 v0 = r0 + acc[ai][bj][m][0], v1 = r1 + acc[ai][bj][m][1];
                    if (o_bf) { u32x4 w; w.x = pk2(v0[0], v0[1]); w.y = pk2(v0[2], v0[3]); w.z = pk2(v1[0], v1[1]); w.w = pk2(v1[2], v1[3]); *(GAS u32x4*)((bf16_t*)Out + o2) = w; }
                    else { *(GAS pg8::f32x4*)((float*)Out + o2) = v0; *(GAS pg8::f32x4*)((float*)Out + o2 + 4) = v1; }
                    if (XG) {
                        ss += ((v0[0] * v0[0] + v0[1] * v0[1]) + (v0[2] * v0[2] + v0[3] * v0[3])) + ((v1[0] * v1[0] + v1[1] * v1[1]) + (v1[2] * v1[2] + v1[3] * v1[3]));
                        const pg8::f32x4 g0 = gv[bj][0], g1 = gv[bj][1];
                        u32x4 w; w.x = pk2(v0[0] * g0[0], v0[1] * g0[1]); w.y = pk2(v0[2] * g0[2], v0[3] * g0[3]); w.z = pk2(v1[0] * g1[0], v1[1] * g1[1]); w.w = pk2(v1[2] * g1[2], v1[3] * g1[3]);
                        *(GAS u32x4*)(XG + o2) = w;
                    }
                }
                if (XG) {
                    ss += shx(ss, 16); ss += shx(ss, 32);
                    if (fq == 0) __hip_atomic_fetch_add(RS + row, ss, __ATOMIC_RELAXED, __HIP_MEMORY_SCOPE_AGENT);
                }
            }
    }
};
#ifndef RESID_ALIGN
#define RESID_ALIGN true
#endif
template <class Epi> struct EpiAlign { static constexpr bool value = true; };
template <> struct EpiAlign<EpiResid> { static constexpr bool value = RESID_ALIGN; };
template <class Epi> __device__ __forceinline__ void run_gemm(ldsp_t lds, const bf16_t* A, const bf16_t* Bt, int M, int N, int K, const Epi& E, int tid, int Bx, int Gd) {
    pg8::Gemm g{A, Bt, M, N, K}; pg8::StaticOrder S; S.init(M, N, Gd, Bx);
    pg8::gemm_phase<Epi, pg8::StaticOrder, EpiAlign<Epi>::value, true>(lds, g, S, E, tid);
}
template <int CTRL> __device__ __forceinline__ float dppf(float x) { return __builtin_bit_cast(float, __builtin_amdgcn_update_dpp(0, __builtin_bit_cast(int, x), CTRL, 0xf, 0xf, true)); }
struct EpiConvAct {
    static constexpr bool PERM = true, AFTER_DRAIN = false;
    bf16_t* ACT; float* SIDE; const float* cw; const float* cb; const float* RS;
    __device__ __forceinline__ void operator()(const pg8::f32x4 (&acc)[2][2][4][2], const pg8::Unit& u, int wr_, int wc_, int fr_, int fq_) const {
        int wr = wr_, wc = wc_, fr = fr_, fq = fq_; asm volatile("" : "+s"(wr), "+s"(wc), "+v"(fr), "+v"(fq));
        const int ch0 = u.pn * 128 + wc * 32 + 8 * fq;
#pragma unroll
        for (int ai = 0; ai < 2; ++ai) {
            const int rowb = u.pm * 256 + ai * 128 + wr * 64, slab = rowb >> 6;
            float rs[4], rsp[4], rsn[4];
#pragma unroll
            for (int m = 0; m < 4; ++m) rs[m] = rsqrtf(RS[rowb + 16 * m + fr] * (1.f / DM) + EPS);
            { float mir[4];
#pragma unroll
              for (int m = 0; m < 4; ++m) mir[m] = dppf<0x140>(rs[m]);
#pragma unroll
              for (int m = 0; m < 4; ++m) { const float a = dppf<0x111>(rs[m]), b = dppf<0x101>(rs[m]); rsp[m] = fr > 0 ? a : mir[m > 0 ? m - 1 : 0]; rsn[m] = fr < 15 ? b : mir[m < 3 ? m + 1 : 3]; } }
#pragma unroll
            for (int mm = 0; mm < 2; ++mm) {
                const int m = mm ? 3 : 0; const int k = mm ? (fr == 14 ? 2 : fr == 15 ? 3 : -1) : (fr == 0 ? 0 : fr == 1 ? 1 : -1);
                if (k >= 0) {
                    float* sp = SIDE + ((size_t)(slab * 4 + k) * 2) * DFF + ch0;
                    *(GAS pg8::f32x4*)sp = acc[ai][0][m][0] * rs[m]; *(GAS pg8::f32x4*)(sp + 4) = acc[ai][0][m][1] * rs[m];
                    *(GAS pg8::f32x4*)(sp + DFF) = acc[ai][1][m][0] * rs[m]; *(GAS pg8::f32x4*)(sp + DFF + 4) = acc[ai][1][m][1] * rs[m];
                }
            }
#pragma unroll
            for (int eh = 0; eh < 2; ++eh) {
                const int chh = ch0 + 4 * eh;
                const pg8::f32x4 W0g = *(const GAS pg8::f32x4*)(cw + chh), W1g = *(const GAS pg8::f32x4*)(cw + 2 * DFF + chh), W2g = *(const GAS pg8::f32x4*)(cw + 4 * DFF + chh), Bg = *(const GAS pg8::f32x4*)(cb + chh);
                const pg8::f32x4 W0v = *(const GAS pg8::f32x4*)(cw + DFF + chh), W1v = *(const GAS pg8::f32x4*)(cw + 3 * DFF + chh), W2v = *(const GAS pg8::f32x4*)(cw + 5 * DFF + chh), Bv = *(const GAS pg8::f32x4*)(cb + DFF + chh);
#pragma unroll
                for (int m = 0; m < 4; ++m) {
                    float r4[4];
#pragma unroll
                    for (int ei = 0; ei < 4; ++ei) {
                        const float xg = acc[ai][0][m][eh][ei], xv = acc[ai][1][m][eh][ei];
                        const float mgp = dppf<0x140>(acc[ai][0][m > 0 ? m - 1 : 0][eh][ei]), mgn = dppf<0x140>(acc[ai][0][m < 3 ? m + 1 : 3][eh][ei]);
                        const float mvp = dppf<0x140>(acc[ai][1][m > 0 ? m - 1 : 0][eh][ei]), mvn = dppf<0x140>(acc[ai][1][m < 3 ? m + 1 : 3][eh][ei]);
                        const float sg = dppf<0x111>(xg), lg = dppf<0x101>(xg), sv = dppf<0x111>(xv), lv = dppf<0x101>(xv);
                        const float pg_ = fr > 0 ? sg : mgp, ng_ = fr < 15 ? lg : mgn, pv_ = fr > 0 ? sv : mvp, nv_ = fr < 15 ? lv : mvn;
                        const float gte = Bg[ei] + W0g[ei] * (pg_ * rsp[m]) + W1g[ei] * (xg * rs[m]) + W2g[ei] * (ng_ * rsn[m]);
                        const float val = Bv[ei] + W0v[ei] * (pv_ * rsp[m]) + W1v[ei] * (xv * rs[m]) + W2v[ei] * (nv_ * rsn[m]);
                        r4[ei] = gte * __builtin_amdgcn_rcpf(1.f + ex2(-gte * LOG2E)) * val;
                    }
                    const int s_ = 16 * m + fr;
                    if (s_ != 0 && s_ != 63) { u32x2 o; o.x = pk2(r4[0], r4[1]); o.y = pk2(r4[2], r4[3]); *(GAS u32x2*)(ACT + (size_t)(rowb + s_) * DFF + chh) = o; }
                }
                asm volatile("" ::: "memory");
            }
        }
    }
};
__device__ __forceinline__ void ffn_fixup(int pm, bf16_t* ACT, const float* SIDE, const float* cw, const float* cb, int tid) {
    for (int idx = tid; idx < 8 * (DFF / 8); idx += NTHR) {
        const int ri = idx / (DFF / 8), ch = (idx % (DFF / 8)) * 8, slab = pm * 4 + (ri >> 1), last = ri & 1, row = slab * 64 + (last ? 63 : 0), t = row % SEQ;
        const float* sc = SIDE + ((size_t)(slab * 4 + (last ? 3 : 0)) * 2) * DFF + ch;
        const float* sp = last ? SIDE + ((size_t)(slab * 4 + 2) * 2) * DFF + ch : SIDE + ((size_t)((slab - 1) * 4 + 3) * 2) * DFF + ch;
        const float* sn = last ? SIDE + ((size_t)((slab + 1) * 4 + 0) * 2) * DFF + ch : SIDE + ((size_t)(slab * 4 + 1) * 2) * DFF + ch;
        const bool hp = last || t > 0, hn = !last || t < SEQ - 1;
        float r[8];
#pragma unroll
        for (int hlf = 0; hlf < 2; ++hlf) {
            const f32x4 z = {0.f, 0.f, 0.f, 0.f};
            const f32x4 cg = *(const GAS f32x4*)(sc + 4 * hlf), cv = *(const GAS f32x4*)(sc + DFF + 4 * hlf);
            const f32x4 pg_ = hp ? *(const GAS f32x4*)(sp + 4 * hlf) : z, pv_ = hp ? *(const GAS f32x4*)(sp + DFF + 4 * hlf) : z;
            const f32x4 ng_ = hn ? *(const GAS f32x4*)(sn + 4 * hlf) : z, nv_ = hn ? *(const GAS f32x4*)(sn + DFF + 4 * hlf) : z;
#pragma unroll
            for (int i = 0; i < 4; ++i) {
                const int c = ch + 4 * hlf + i;
                const float gte = cb[c] + cw[c] * pg_[i] + cw[2 * DFF + c] * cg[i] + cw[4 * DFF + c] * ng_[i];
                const float val = cb[DFF + c] + cw[DFF + c] * pv_[i] + cw[3 * DFF + c] * cv[i] + cw[5 * DFF + c] * nv_[i];
                r[4 * hlf + i] = gte / (1.f + __expf(-gte)) * val;
            }
        }
        u32x4 o; o.x = pk2(r[0], r[1]); o.y = pk2(r[2], r[3]); o.z = pk2(r[4], r[5]); o.w = pk2(r[6], r[7]);
        *(GAS u32x4*)(ACT + (size_t)row * DFF + ch) = o;
    }
}
template <class Epi> __device__ __forceinline__ void run_gemm_fix(ldsp_t lds, const bf16_t* A, const bf16_t* Bt, int M, int N, int K, const Epi& E, int tid, int Bx, int Gd,
                                                                  bf16_t* ACT, const float* SIDE, const float* cw, const float* cb) {
    pg8::Gemm g{A, Bt, M, N, K}; pg8::StaticOrder S; S.init(M, N, Gd, Bx);
    { pg8::Unit u; int last_pm = -1; for (int i = 0; S.next(i, u); ++i) { if (u.pm != last_pm) ffn_fixup(u.pm, ACT, SIDE, cw, cb, tid); last_pm = u.pm; } }
    asm volatile("s_waitcnt vmcnt(0)" ::: "memory"); __syncthreads();
    pg8::gemm_phase<Epi, pg8::StaticOrder, EpiAlign<Epi>::value, true>(lds, g, S, E, tid);
}
#define XB_TMO      128
#define XB_XCNT(j)  (256  + 64 * (j))
#define XB_XSUB(j)  (1280 + 64 * (j))
#define XB_XGEN(j)  (2304 + 64 * (j))
#define XB_TOP      3328
#define XB_TOPGEN   3392
#define XB_SPIN_CAP (1u << 20)
__device__ __forceinline__ unsigned xb_ld(unsigned* p)              { return __hip_atomic_load(p, __ATOMIC_RELAXED, __HIP_MEMORY_SCOPE_AGENT); }
__device__ __forceinline__ unsigned xb_add(unsigned* p, unsigned v) { return __hip_atomic_fetch_add(p, v, __ATOMIC_RELAXED, __HIP_MEMORY_SCOPE_AGENT); }
__device__ __forceinline__ unsigned xb_xcc_id() { return (unsigned)__builtin_amdgcn_s_getreg((3 << 11) | 20) & 0xFu; }
#define XB_SPIN(cond, bar) do { unsigned _sp = 0; while (cond) { __builtin_amdgcn_s_sleep(1); \
    if ((++_sp & 255u) == 0u) { if (xb_ld(&(bar)[XB_TMO])) break; if (_sp > XB_SPIN_CAP) { atomicAdd(&(bar)[XB_TMO], 1u); break; } } } } while (0)
__device__ __forceinline__ void xb_post(unsigned* bar, int wave_s) {
    if (wave_s == 0 && lane_id() == 0) (void)xb_add(&bar[XB_XCNT(xb_xcc_id())], 1u);
}
__device__ __forceinline__ void xb_complete(unsigned* bar, unsigned x, unsigned& nloc, unsigned& nx) {
    const unsigned G = gridDim.x;
    unsigned sum, cnt, mine, sp = 0u;
    for (;;) {
        sum = 0u; cnt = 0u; mine = 0u;
#pragma unroll
        for (unsigned j = 0; j < 16; ++j) { const unsigned c = xb_ld(&bar[XB_XCNT(j)]); sum += c; cnt += (c > 0u) ? 1u : 0u; mine = (j == x) ? c : mine; }
        if (sum == G) break;
        __builtin_amdgcn_s_sleep(1);
        if ((++sp & 255u) == 0u) { if (xb_ld(&bar[XB_TMO])) break; if (sp > XB_SPIN_CAP) { atomicAdd(&bar[XB_TMO], 1u); break; } }
    }
    nloc = mine > 0u ? mine : 1u; nx = cnt > 0u ? cnt : 1u;
}
__device__ __forceinline__ void gbar(unsigned* bar, volatile LAS unsigned* st, int wave_s) {
    asm volatile("s_waitcnt vmcnt(0) lgkmcnt(0)" ::: "memory");
    __syncthreads();
    if (wave_s == 0 && lane_id() == 0) {
        const unsigned x = xb_xcc_id();
        unsigned nloc = st[0], nx = st[1];
        if (nloc == 0u) { xb_complete(bar, x, nloc, nx); st[0] = nloc; st[1] = nx; }
        const unsigned old = xb_add(&bar[XB_XSUB(x)], 1u);
        const unsigned gen = old / nloc;
        if (old + 1u == (gen + 1u) * nloc) {
            __builtin_amdgcn_fence(__ATOMIC_RELEASE, "agent");
            asm volatile("s_waitcnt vmcnt(0)" ::: "memory");
            const unsigned og = xb_add(&bar[XB_TOP], 1u);
            const unsigned tg = og / nx;
            if (og + 1u == (tg + 1u) * nx) xb_add(&bar[XB_TOPGEN], 1u);
            else XB_SPIN(xb_ld(&bar[XB_TOPGEN]) == tg, bar);
            __builtin_amdgcn_fence(__ATOMIC_ACQUIRE, "agent");
            xb_add(&bar[XB_XGEN(x)], 1u);
            asm volatile("s_waitcnt vmcnt(0)" ::: "memory");
        } else {
            XB_SPIN(xb_ld(&bar[XB_XGEN(x)]) == gen, bar);
            __builtin_amdgcn_fence(__ATOMIC_ACQUIRE, "agent");
            asm volatile("s_waitcnt vmcnt(0)" ::: "memory");
        }
    }
    __syncthreads();
}

__device__ __forceinline__ int rowmap_up(int n) { const int ch = n < DFF ? n : n - DFF; return ((ch >> 7) << 8) + (n < DFF ? 0 : 128) + (ch & 127); }
__device__ __forceinline__ void wt_matrix(const float* W, int K, int N, bf16_t* WT, bool upmap, LAS float* scrf, int gw, int NGW, int lane, int& goff) {
    LAS bf16_t* scr = (LAS bf16_t*)scrf;
    const int nblk = (N + 63) / 64, nitems = (K / 64) * nblk;
    const int first = ((gw - goff) % NGW + NGW) % NGW; goff = (goff + nitems) % NGW;
    for (int item = first; item < nitems; item += NGW) {
        const int kb = item / nblk, nb = item % nblk, k0 = 64 * kb, n0 = 64 * nb;
        const int n4 = (lane & 15) * 4, kq = lane >> 4;
        f32x4 v[16];
#pragma unroll
        for (int i = 0; i < 16; ++i) { v[i] = (f32x4){0.f, 0.f, 0.f, 0.f}; if (n0 + n4 < N) v[i] = *(const GAS f32x4*)(W + (size_t)(k0 + 4 * i + kq) * N + n0 + n4); }
#pragma unroll
        for (int i = 0; i < 16; ++i) { LAS unsigned* d = (LAS unsigned*)(scr + (4 * i + kq) * 66 + n4); d[0] = pk2(v[i].x, v[i].y); d[1] = pk2(v[i].z, v[i].w); }
        LDS_FENCE();
        const int c = lane & 7;
#pragma unroll
        for (int j = 0; j < 8; ++j) {
            const int nl = (lane >> 3) + 8 * j, n = n0 + nl;
            const LAS bf16_t* s = scr + (8 * c) * 66 + nl;
            u32x4 o; o.x = (unsigned)s[0] | ((unsigned)s[66] << 16); o.y = (unsigned)s[132] | ((unsigned)s[198] << 16); o.z = (unsigned)s[264] | ((unsigned)s[330] << 16); o.w = (unsigned)s[396] | ((unsigned)s[462] << 16);
            if (n < N) { const int rr = upmap ? rowmap_up(n) : n; *(GAS u32x4*)(WT + (size_t)rr * K + k0 + 8 * c) = o; }
        }
        LDS_FENCE();
    }
}

__device__ __forceinline__ void rms_rows(const float* X, const float* gain, bf16_t* O, int nrows, int gw, int NGW, int lane) {
    for (int m = gw; m < nrows; m += NGW) {
        const GAS f32x4* xr = (const GAS f32x4*)(X + (size_t)m * DM) + lane;
        f32x4 v[4]; float s = 0.f;
#pragma unroll
        for (int j = 0; j < 4; ++j) { v[j] = xr[64 * j]; s += (v[j].x * v[j].x + v[j].y * v[j].y) + (v[j].z * v[j].z + v[j].w * v[j].w); }
        const float rstd = rsqrtf(wave_sum(s) * (1.f / DM) + EPS);
        GAS u32x2* o8 = (GAS u32x2*)(O + (size_t)m * DM) + lane;
#pragma unroll
        for (int j = 0; j < 4; ++j) { const f32x4 g = ((const f32x4*)gain)[lane + 64 * j]; u32x2 w; w.x = pk2(v[j].x * rstd * g.x, v[j].y * rstd * g.y); w.y = pk2(v[j].z * rstd * g.z, v[j].w * rstd * g.w); o8[64 * j] = w; }
    }
}

template <int GD, bool ROPE>
__device__ __forceinline__ void qknorm_rows(bf16_t* X, int pitch, int c0, int ncols, int nrows, int nq_cols, const float* gq, const float* gk, float sq, float sk,
                                            const float* ropeC, const float* ropeS, int gw, int NGW, int lane) {
    constexpr int LPG = GD / 8;
    const int nchunks = (ncols + 511) / 512;
    const int total = nrows * nchunks;
    for (int it0 = gw; it0 < total; it0 += 4 * NGW) {
      u32x4 raws[4];
#pragma unroll
      for (int j = 0; j < 4; ++j) {
          const int it = it0 + j * NGW; raws[j] = (u32x4){0u, 0u, 0u, 0u};
          if (it < total) { const int row = it / nchunks, ch = it % nchunks, c = ch * 512 + lane * 8; if (c < ncols) raws[j] = *(const GAS u32x4*)(X + (size_t)row * pitch + c0 + c); }
      }
#pragma unroll
      for (int j = 0; j < 4; ++j) {
        const int it = it0 + j * NGW; if (it >= total) break;
        const int row = it / nchunks, ch = it % nchunks;
        const int c = ch * 512 + lane * 8; const bool act = c < ncols;
        bf16_t* p = X + (size_t)row * pitch + c0 + c;
        const u32x4 raw = raws[j];
        float v[8]; v[0] = bflo(raw.x); v[1] = bfhi(raw.x); v[2] = bflo(raw.y); v[3] = bfhi(raw.y); v[4] = bflo(raw.z); v[5] = bfhi(raw.z); v[6] = bflo(raw.w); v[7] = bfhi(raw.w);
        float ss = 0.f;
#pragma unroll
        for (int i = 0; i < 8; ++i) ss += v[i] * v[i];
#pragma unroll
        for (int o = 1; o < LPG; o <<= 1) ss += shx(ss, o);
        const float rstd = rsqrtf(ss * (1.f / GD) + EPS);
        const bool isq = c < nq_cols; const float* g = (isq ? gq : gk) + (c % GD); const float sc = isq ? sq : sk;
        const f32x4 g0 = *(const f32x4*)g, g1 = *(const f32x4*)(g + 4);
        v[0] *= rstd * g0.x; v[1] *= rstd * g0.y; v[2] *= rstd * g0.z; v[3] *= rstd * g0.w; v[4] *= rstd * g1.x; v[5] *= rstd * g1.y; v[6] *= rstd * g1.z; v[7] *= rstd * g1.w;
        if (ROPE) {
            const int d = c & 63, half = d >> 5, dd = d & 31, t = row % SEQ, pos = half ? (t & 63) : (t >> 6), j0 = dd & 15; const bool second = dd >= 16;
#pragma unroll
            for (int i = 0; i < 8; ++i) {
                const float xp = shx(v[i], 2); const float cs = ropeC[pos * 16 + j0 + i], sn = ropeS[pos * 16 + j0 + i];
                v[i] = second ? (xp * sn + v[i] * cs) : (v[i] * cs - xp * sn);
            }
        }
        u32x4 o; o.x = pk2(v[0] * sc, v[1] * sc); o.y = pk2(v[2] * sc, v[3] * sc); o.z = pk2(v[4] * sc, v[5] * sc); o.w = pk2(v[6] * sc, v[7] * sc);
        if (act) *(GAS u32x4*)p = o;
      }
    }
}

__device__ __forceinline__ void transpose_cols(const bf16_t* X, int pitch, int c0, int C, int Sx, int nb, bf16_t* T, LAS bf16_t* scr, int gw, int NGW, int lane) {
    const int tt = Sx / 64, ct = C / 64, nitems = nb * tt * ct;
    for (int it = gw; it < nitems; it += NGW) {
        const int cti = it % ct, r = it / ct, tti = r % tt, b = r / tt;
        const bf16_t* src = X + (size_t)(b * Sx + tti * 64) * pitch + c0 + cti * 64;
#pragma unroll
        for (int i = 0; i < 8; ++i) {
            const int tok = 8 * i + (lane >> 3), chn = lane & 7;
            const u32x4 v = *(const GAS u32x4*)(src + (size_t)tok * pitch + chn * 8);
            LAS unsigned* d = (LAS unsigned*)(scr + tok * 66 + chn * 8);
            d[0] = v.x; d[1] = v.y; d[2] = v.z; d[3] = v.w;
        }
        LDS_FENCE();
#pragma unroll
        for (int i = 0; i < 8; ++i) {
            const int col = 8 * i + (lane >> 3), chn = lane & 7;
            const LAS bf16_t* s = scr + (chn * 8) * 66 + col;
            u32x4 o; o.x = (unsigned)s[0] | ((unsigned)s[66] << 16); o.y = (unsigned)s[132] | ((unsigned)s[198] << 16); o.z = (unsigned)s[264] | ((unsigned)s[330] << 16); o.w = (unsigned)s[396] | ((unsigned)s[462] << 16);
            *(GAS u32x4*)(T + (size_t)(b * C + cti * 64 + col) * Sx + tti * 64 + chn * 8) = o;
        }
        LDS_FENCE();
    }
}

__device__ __forceinline__ float bfsel(const u32x4& v, int i) { const unsigned w = i < 2 ? v.x : i < 4 ? v.y : i < 6 ? v.z : v.w; return (i & 1) ? bfhi(w) : bflo(w); }
__device__ __forceinline__ void conv_gate(const bf16_t* U, bf16_t* ACT, int nrows, const float* cw, const float* cb, int gtid, int nthreads) {
    constexpr int nchunk = DFF / 8, RB = 16;
    const int nitems = (nrows / RB) * nchunk;
    for (int idx = gtid; idx < nitems; idx += nthreads) {
        const int rb = idx / nchunk, chk = idx % nchunk, ch = chk * 8, row0 = rb * RB, t0 = row0 % SEQ;
        const int ucol = ((ch >> 7) << 8) + (ch & 127);
        float wg[3][8], wv[3][8], bg[8], bv[8];
#pragma unroll
        for (int j = 0; j < 3; ++j) {
            const f32x4 a0 = *(const GAS f32x4*)(cw + j * 2 * DFF + ch), a1 = *(const GAS f32x4*)(cw + j * 2 * DFF + ch + 4);
            const f32x4 c0 = *(const GAS f32x4*)(cw + j * 2 * DFF + DFF + ch), c1 = *(const GAS f32x4*)(cw + j * 2 * DFF + DFF + ch + 4);
#pragma unroll
            for (int i = 0; i < 4; ++i) { wg[j][i] = a0[i]; wg[j][4 + i] = a1[i]; wv[j][i] = c0[i]; wv[j][4 + i] = c1[i]; }
        }
        { const f32x4 a0 = *(const GAS f32x4*)(cb + ch), a1 = *(const GAS f32x4*)(cb + ch + 4), c0 = *(const GAS f32x4*)(cb + DFF + ch), c1 = *(const GAS f32x4*)(cb + DFF + ch + 4);
#pragma unroll
          for (int i = 0; i < 4; ++i) { bg[i] = a0[i]; bg[4 + i] = a1[i]; bv[i] = c0[i]; bv[4 + i] = c1[i]; } }
        const bf16_t* up = U + (size_t)row0 * (2 * DFF) + ucol;
        const u32x4 z = {0u, 0u, 0u, 0u};
        u32x4 gp = z, vp = z;
        if (t0 > 0) { gp = *(const GAS u32x4*)(up - 2 * DFF); vp = *(const GAS u32x4*)(up - 2 * DFF + 128); }
        u32x4 gc = *(const GAS u32x4*)up, vc = *(const GAS u32x4*)(up + 128);
#pragma unroll 4
        for (int rr = 0; rr < RB; ++rr) {
            u32x4 gn = z, vn = z;
            if (rr < RB - 1 || t0 + RB < SEQ) { gn = *(const GAS u32x4*)(up + (size_t)(rr + 1) * (2 * DFF)); vn = *(const GAS u32x4*)(up + (size_t)(rr + 1) * (2 * DFF) + 128); }
            float r[8];
#pragma unroll
            for (int i = 0; i < 8; ++i) {
                const float gte = bg[i] + bfsel(gp, i) * wg[0][i] + bfsel(gc, i) * wg[1][i] + bfsel(gn, i) * wg[2][i];
                const float val = bv[i] + bfsel(vp, i) * wv[0][i] + bfsel(vc, i) * wv[1][i] + bfsel(vn, i) * wv[2][i];
                r[i] = gte / (1.f + __expf(-gte)) * val;
            }
            u32x4 o; o.x = pk2(r[0], r[1]); o.y = pk2(r[2], r[3]); o.z = pk2(r[4], r[5]); o.w = pk2(r[6], r[7]);
            *(GAS u32x4*)(ACT + (size_t)(row0 + rr) * DFF + ch) = o;
            gp = gc; vp = vc; gc = gn; vc = vn;
        }
    }
}

#define MFMA32(a, b, c) __builtin_amdgcn_mfma_f32_32x32x16_bf16((a), (b), (c), 0, 0, 0)
constexpr int VSTR = 144, ATT_VOFF = 17408;
template <int DQK> __device__ __forceinline__ void tile_qk(f32x16& p0, f32x16& p1, const bf16x8* qf, const LAS unsigned char* Ks, int r32, int hi, float cinit) {
    constexpr int KSTR = (DQK + 8) * 2;
#pragma unroll
    for (int r = 0; r < 16; ++r) { p0[r] = cinit; p1[r] = cinit; }
    const int pr = (r32 & 0x13) | ((r32 & 4) << 1) | ((r32 & 8) >> 1);
    const LAS unsigned char* kb = Ks + pr * KSTR + hi * 16;
#pragma unroll
    for (int d0 = 0; d0 < DQK / 16; ++d0) {
        const bf16x8 a0 = *(const LAS bf16x8*)(kb + d0 * 32), a1 = *(const LAS bf16x8*)(kb + 32 * KSTR + d0 * 32);
        p0 = MFMA32(a0, qf[d0], p0); p1 = MFMA32(a1, qf[d0], p1);
    }
}
template <int DV> __device__ __forceinline__ void tile_softmax_pv(f32x16& p0, f32x16& p1, float& m, float& l, f32x16* o, const LAS unsigned char* Vts, int r32, int hi) {
    float mx = fmaxf(p0[0], p1[0]);
#pragma unroll
    for (int r = 1; r < 16; ++r) mx = fmaxf(mx, fmaxf(p0[r], p1[r]));
    mx = fmaxf(mx, shx(mx, 32));
    const float mn = fmaxf(m, mx), alpha = ex2(m - mn); m = mn;
    float s = 0.f;
#pragma unroll
    for (int r = 0; r < 16; ++r) { p0[r] = ex2(p0[r] - mn); p1[r] = ex2(p1[r] - mn); s += p0[r] + p1[r]; }
    l = l * alpha + s;
    if (__any(alpha != 1.0f)) {
#pragma unroll
        for (int d0 = 0; d0 < DV / 32; ++d0) o[d0] = o[d0] * alpha;
    }
    u32x4 w[4];
    w[0] = (u32x4){pk2(p0[0], p0[1]), pk2(p0[2], p0[3]), pk2(p0[4], p0[5]), pk2(p0[6], p0[7])};
    w[1] = (u32x4){pk2(p0[8], p0[9]), pk2(p0[10], p0[11]), pk2(p0[12], p0[13]), pk2(p0[14], p0[15])};
    w[2] = (u32x4){pk2(p1[0], p1[1]), pk2(p1[2], p1[3]), pk2(p1[4], p1[5]), pk2(p1[6], p1[7])};
    w[3] = (u32x4){pk2(p1[8], p1[9]), pk2(p1[10], p1[11]), pk2(p1[12], p1[13]), pk2(p1[14], p1[15])};
    const LAS unsigned char* vb = Vts + ((r32 & 0x13) | ((r32 & 4) << 1) | ((r32 & 8) >> 1)) * VSTR + hi * 16;
#pragma unroll
    for (int j = 0; j < 4; ++j) {
        const bf16x8 pb = __builtin_bit_cast(bf16x8, w[j]);
#pragma unroll
        for (int d0 = 0; d0 < DV / 32; ++d0) {
            const bf16x8 a = *(const LAS bf16x8*)(vb + d0 * 32 * VSTR + j * 32);
            o[d0] = MFMA32(a, pb, o[d0]);
        }
    }
}
template <int DV> __device__ __forceinline__ void tile_exp_pv(f32x16& p0, f32x16& p1, f32x16& oe, f32x16* o, const LAS unsigned char* Vts, int r32, int hi) {
#pragma unroll
    for (int r = 0; r < 16; ++r) { p0[r] = ex2(p0[r]); p1[r] = ex2(p1[r]); }
    u32x4 w[4];
    w[0] = (u32x4){pk2(p0[0], p0[1]), pk2(p0[2], p0[3]), pk2(p0[4], p0[5]), pk2(p0[6], p0[7])};
    w[1] = (u32x4){pk2(p0[8], p0[9]), pk2(p0[10], p0[11]), pk2(p0[12], p0[13]), pk2(p0[14], p0[15])};
    w[2] = (u32x4){pk2(p1[0], p1[1]), pk2(p1[2], p1[3]), pk2(p1[4], p1[5]), pk2(p1[6], p1[7])};
    w[3] = (u32x4){pk2(p1[8], p1[9]), pk2(p1[10], p1[11]), pk2(p1[12], p1[13]), pk2(p1[14], p1[15])};
    const u32x4 onesw = {0x3f803f80u, 0x3f803f80u, 0x3f803f80u, 0x3f803f80u};
    const bf16x8 ones = __builtin_bit_cast(bf16x8, onesw);
    const LAS unsigned char* vb = Vts + ((r32 & 0x13) | ((r32 & 4) << 1) | ((r32 & 8) >> 1)) * VSTR + hi * 16;
#pragma unroll
    for (int j = 0; j < 4; ++j) {
        const bf16x8 pb = __builtin_bit_cast(bf16x8, w[j]);
        oe = MFMA32(ones, pb, oe);
#pragma unroll
        for (int d0 = 0; d0 < DV / 32; ++d0) {
            const bf16x8 a = *(const LAS bf16x8*)(vb + d0 * 32 * VSTR + j * 32);
            o[d0] = MFMA32(a, pb, o[d0]);
        }
    }
}
template <int D> __device__ __forceinline__ float score_bound(const float* gq, const float* gk, int lane) {
    float a = fabsf(gq[lane & (D - 1)]), b = fabsf(gk[lane & (D - 1)]);
    if (D == 128) { a = fmaxf(a, fabsf(gq[64 + lane])); b = fmaxf(b, fabsf(gk[64 + lane])); }
#pragma unroll
    for (int o = 1; o < 64; o <<= 1) { a = fmaxf(a, shx(a, o)); b = fmaxf(b, shx(b, o)); }
    return (D == 64 ? 8.0f : 11.3137085f) * a * b * LOG2E * 1.02f;
}
template <int DQK, int DV> struct KVRegs { u32x4 k[DQK / 64]; u32x4 v[DV / 64]; };
template <int DQK, int DV> __device__ __forceinline__ void kv_load(KVRegs<DQK, DV>& R, const bf16_t* Kt, int kpitch, const bf16_t* Vt, int vtpitch, int tid) {
#pragma unroll
    for (int i = 0; i < DQK / 64; ++i) { const int ci = tid + 512 * i, row = ci / (DQK / 8), cc = ci % (DQK / 8); R.k[i] = *(const GAS u32x4*)(Kt + (size_t)row * kpitch + cc * 8); }
#pragma unroll
    for (int i = 0; i < DV / 64; ++i) { const int ci = tid + 512 * i, d = ci >> 3, cc = ci & 7; R.v[i] = *(const GAS u32x4*)(Vt + (size_t)d * vtpitch + cc * 8); }
}
template <int DQK, int DV> __device__ __forceinline__ void kv_store(const KVRegs<DQK, DV>& R, LAS unsigned char* Ks, LAS unsigned char* Vts, int tid) {
    constexpr int KSTR = (DQK + 8) * 2;
#pragma unroll
    for (int i = 0; i < DQK / 64; ++i) { const int ci = tid + 512 * i, row = ci / (DQK / 8), cc = ci % (DQK / 8); *(LAS u32x4*)(Ks + row * KSTR + cc * 16) = R.k[i]; }
#pragma unroll
    for (int i = 0; i < DV / 64; ++i) { const int ci = tid + 512 * i, d = ci >> 3, cc = ci & 7; *(LAS u32x4*)(Vts + d * VSTR + cc * 16) = R.v[i]; }
}
constexpr int ATT_BUF = 35840;
template <int DQK, int BIAS>
__device__ __forceinline__ void qk_biased(f32x16& p0, f32x16& p1, const bf16x8* qf, const LAS unsigned char* Ks, int t, int q0w, const float* tb, float cneg, float cpos, float sref, int r32, int hi) {
    float cinit = -sref; bool near = false;
    if (BIAS == 1) { const int lo = t * 64 - (q0w + 31), hh = t * 64 + 63 - q0w; if (hh <= -91) cinit = cneg; else if (lo >= 91) cinit = cpos; else near = true; }
    tile_qk<DQK>(p0, p1, qf, Ks, r32, hi, cinit);
    if (BIAS == 1 && near) {
        const GAS float* tq = (const GAS float*)(tb + (t * 64 + 8 * hi - (q0w + r32)));
#pragma unroll
        for (int r = 0; r < 16; ++r) { const int kk = 16 * (r >> 3) + (r & 7); p0[r] += tq[kk]; p1[r] += tq[kk + 32]; }
    }
}
template <int DQK, bool ROPE> __device__ __forceinline__ void qf_norm(bf16x8* qf, const float* qgain, float qscale, int hi, const float* ropeC, const float* ropeS, int prow, int pcol) {
    float v[DQK / 16][8]; float ss = 0.f;
#pragma unroll
    for (int d0 = 0; d0 < DQK / 16; ++d0) { const u32x4 w = __builtin_bit_cast(u32x4, qf[d0]);
        v[d0][0] = bflo(w.x); v[d0][1] = bfhi(w.x); v[d0][2] = bflo(w.y); v[d0][3] = bfhi(w.y); v[d0][4] = bflo(w.z); v[d0][5] = bfhi(w.z); v[d0][6] = bflo(w.w); v[d0][7] = bfhi(w.w);
#pragma unroll
        for (int i = 0; i < 8; ++i) ss += v[d0][i] * v[d0][i]; }
    ss += shx(ss, 32);
    const float rs = rsqrtf(ss * (1.f / DQK) + EPS);
#pragma unroll
    for (int d0 = 0; d0 < DQK / 16; ++d0) { const f32x4 g0 = *(const f32x4*)(qgain + d0 * 16 + hi * 8), g1 = *(const f32x4*)(qgain + d0 * 16 + hi * 8 + 4);
        v[d0][0] *= rs * g0.x; v[d0][1] *= rs * g0.y; v[d0][2] *= rs * g0.z; v[d0][3] *= rs * g0.w; v[d0][4] *= rs * g1.x; v[d0][5] *= rs * g1.y; v[d0][6] *= rs * g1.z; v[d0][7] *= rs * g1.w; }
    if constexpr (ROPE && DQK == 64) {
#pragma unroll
        for (int hf = 0; hf < 2; ++hf) {
            const float* cp = ropeC + (hf ? pcol : prow) * 16 + 8 * hi; const float* sp = ropeS + (hf ? pcol : prow) * 16 + 8 * hi;
            const f32x4 c0 = *(const f32x4*)cp, c1 = *(const f32x4*)(cp + 4), s0 = *(const f32x4*)sp, s1 = *(const f32x4*)(sp + 4);
#pragma unroll
            for (int i = 0; i < 8; ++i) { const float cs = i < 4 ? c0[i & 3] : c1[i & 3], sn = i < 4 ? s0[i & 3] : s1[i & 3]; const float t1 = v[2 * hf][i], t2 = v[2 * hf + 1][i];
                v[2 * hf][i] = t1 * cs - t2 * sn; v[2 * hf + 1][i] = t1 * sn + t2 * cs; }
        }
    }
#pragma unroll
    for (int d0 = 0; d0 < DQK / 16; ++d0) { u32x4 r; r.x = pk2(v[d0][0] * qscale, v[d0][1] * qscale); r.y = pk2(v[d0][2] * qscale, v[d0][3] * qscale); r.z = pk2(v[d0][4] * qscale, v[d0][5] * qscale); r.w = pk2(v[d0][6] * qscale, v[d0][7] * qscale);
        qf[d0] = __builtin_bit_cast(bf16x8, r); }
}
template <int DQK, int DV, int BIAS, bool PIPE, bool FIXED>
__device__ __forceinline__ void attn_pass(const bf16_t* Qw, int qpitch, const bf16_t* Kb, int kpitch, const bf16_t* Vtb, int vtpitch, int ntiles,
                                          int q0w, const float* tb, float cneg, float cpos, ldsp_t lds, float& m, float& l, f32x16* o, int tid, int r32, int hi,
                                          const float* qgain = nullptr, float qscale = 1.f, const float* ropeC = nullptr, const float* ropeS = nullptr, int qprow = 0, int qpcol = 0) {
    bf16x8 qf[DQK / 16];
#pragma unroll
    for (int d0 = 0; d0 < DQK / 16; ++d0) qf[d0] = *(const GAS bf16x8*)(Qw + (size_t)r32 * qpitch + d0 * 16 + hi * 8);
    if (qgain) { if (ropeC) qf_norm<DQK, true>(qf, qgain, qscale, hi, ropeC, ropeS, qprow, qpcol); else qf_norm<DQK, false>(qf, qgain, qscale, hi, nullptr, nullptr, 0, 0); }
    const float sref = FIXED ? m : 0.f;
    if (FIXED) { cneg -= sref; cpos -= sref; }
    m = -1e30f; l = 0.f;
#pragma unroll
    for (int d0 = 0; d0 < DV / 32; ++d0)
#pragma unroll
        for (int r = 0; r < 16; ++r) o[d0][r] = 0.f;
    f32x16 oe;
#pragma unroll
    for (int r = 0; r < 16; ++r) oe[r] = 0.f;
    KVRegs<DQK, DV> R; kv_load<DQK, DV>(R, Kb, kpitch, Vtb, vtpitch, tid);
    __syncthreads();
    kv_store<DQK, DV>(R, lds, lds + ATT_VOFF, tid);
    if (ntiles > 1) kv_load<DQK, DV>(R, Kb + (size_t)64 * kpitch, kpitch, Vtb + 64, vtpitch, tid);
    __syncthreads();
    int cur = 0;
    if constexpr (PIPE) {
    f32x16 pa0, pa1, pb0, pb1;
    qk_biased<DQK, BIAS>(pa0, pa1, qf, lds, 0, q0w, tb, cneg, cpos, sref, r32, hi);
#define ATT_STEP(P0, P1, N0, N1, T) do { \
        const int t_ = (T); const int nxt = cur == 2 * ATT_BUF ? 0 : cur + ATT_BUF; \
        if (t_ + 1 < ntiles) kv_store<DQK, DV>(R, lds + nxt, lds + nxt + ATT_VOFF, tid); \
        __syncthreads(); \
        if (t_ + 2 < ntiles) kv_load<DQK, DV>(R, Kb + (size_t)(t_ + 2) * 64 * kpitch, kpitch, Vtb + (t_ + 2) * 64, vtpitch, tid); \
        if (t_ + 1 < ntiles) qk_biased<DQK, BIAS>(N0, N1, qf, lds + nxt, t_ + 1, q0w, tb, cneg, cpos, sref, r32, hi); \
        if constexpr (FIXED) tile_exp_pv<DV>(P0, P1, oe, o, lds + cur + ATT_VOFF, r32, hi); else tile_softmax_pv<DV>(P0, P1, m, l, o, lds + cur + ATT_VOFF, r32, hi); \
        cur = nxt; } while (0)
#pragma nounroll
    for (int t = 0; t < ntiles; t += 2) {
        ATT_STEP(pa0, pa1, pb0, pb1, t);
        ATT_STEP(pb0, pb1, pa0, pa1, t + 1);
    }
#undef ATT_STEP
    } else {
#pragma nounroll
    for (int t = 0; t < ntiles; ++t) {
        const int nxt = cur == 2 * ATT_BUF ? 0 : cur + ATT_BUF;
        if (t + 1 < ntiles) kv_store<DQK, DV>(R, lds + nxt, lds + nxt + ATT_VOFF, tid);
        __syncthreads();
        if (t + 2 < ntiles) kv_load<DQK, DV>(R, Kb + (size_t)(t + 2) * 64 * kpitch, kpitch, Vtb + (t + 2) * 64, vtpitch, tid);
        f32x16 p0, p1;
        qk_biased<DQK, BIAS>(p0, p1, qf, lds + cur, t, q0w, tb, cneg, cpos, sref, r32, hi);
        if constexpr (FIXED) tile_exp_pv<DV>(p0, p1, oe, o, lds + cur + ATT_VOFF, r32, hi); else tile_softmax_pv<DV>(p0, p1, m, l, o, lds + cur + ATT_VOFF, r32, hi);
        cur = nxt;
    }
    }
    if constexpr (FIXED) l = 0.5f * oe[0];
}
template <int DV> __device__ __forceinline__ void store_o(const f32x16* o, float inv, bf16_t* Ow, int opitch, int r32, int hi) {
#pragma unroll
    for (int d0 = 0; d0 < DV / 32; ++d0)
#pragma unroll
        for (int j = 0; j < 2; ++j) {
            u32x4 w; w.x = pk2(o[d0][8 * j] * inv, o[d0][8 * j + 1] * inv); w.y = pk2(o[d0][8 * j + 2] * inv, o[d0][8 * j + 3] * inv);
            w.z = pk2(o[d0][8 * j + 4] * inv, o[d0][8 * j + 5] * inv); w.w = pk2(o[d0][8 * j + 6] * inv, o[d0][8 * j + 7] * inv);
            *(GAS u32x4*)(Ow + (size_t)r32 * opitch + 32 * d0 + 16 * j + 8 * hi) = w;
        }
}
__device__ __forceinline__ int vcu_of(int bx, int G) { return (G % 8 == 0) ? (bx % 8) * (G / 8) + bx / 8 : bx; }

__device__ __forceinline__ void gqa_phase(const bf16_t* QKV, const bf16_t* VaT, bf16_t* Y, const float* gqk, const float* ropeC, const float* ropeS, ldsp_t lds, int tid, int wave, int r32, int hi, int Bx, int Gd) {
    const int G = Gd, vcu = vcu_of(Bx, G);
    const float sref = score_bound<64>(gqk, gqk + 64, tid & 63);
    for (int u = vcu; u < BATCH * 8 * 32; u += G) {
        const int qt = u & 31, hq = (u >> 5) & 3, kvh = (u >> 7) & 1, b = u >> 8, hqf = kvh * 4 + hq;
        const size_t row0 = (size_t)b * SEQ + qt * 256 + wave * 32;
        float m = sref, l; f32x16 o[2];
        if (sref < 40.f) attn_pass<64, 64, 0, true, true>(QKV + row0 * QKVP + hqf * 64, QKVP, QKV + (size_t)b * SEQ * QKVP + 512 + kvh * 64, QKVP, VaT + (size_t)((b * 2 + kvh) * 64) * SEQ, SEQ, SEQ / 64,
                             0, nullptr, 0.f, 0.f, lds, m, l, o, tid, r32, hi, gqk, 0.125f * LOG2E, ropeC, ropeS, (qt * 256 + wave * 32 + r32) >> 6, (wave * 32 + r32) & 63);
        else attn_pass<64, 64, 0, false, false>(QKV + row0 * QKVP + hqf * 64, QKVP, QKV + (size_t)b * SEQ * QKVP + 512 + kvh * 64, QKVP, VaT + (size_t)((b * 2 + kvh) * 64) * SEQ, SEQ, SEQ / 64,
                             0, nullptr, 0.f, 0.f, lds, m, l, o, tid, r32, hi, gqk, 0.125f * LOG2E, ropeC, ropeS, (qt * 256 + wave * 32 + r32) >> 6, (wave * 32 + r32) & 63);
        l += shx(l, 32);
        store_o<64>(o, 1.f / l, Y + row0 * DM + hqf * 64, DM, r32, hi);
    }
}
__device__ __forceinline__ void cross_phase(const bf16_t* QC, const bf16_t* KVC, const bf16_t* VTC, bf16_t* OC, const float* gqk, ldsp_t lds, int tid, int wave, int r32, int hi, int Bx, int Gd) {
    const int G = Gd, vcu = vcu_of(Bx, G);
    const float sref = score_bound<128>(gqk, gqk + 128, tid & 63);
    for (int u = vcu; u < BATCH * 4 * 32; u += G) {
        const int qt = u & 31, h = (u >> 5) & 3, b = u >> 7;
        const size_t row0 = (size_t)b * SEQ + qt * 256 + wave * 32;
        float m = sref, l; f32x16 o[4];
        if (sref < 40.f) attn_pass<128, 128, 0, false, true>(QC + row0 * 512 + h * 128, 512, KVC + (size_t)b * MEMLEN * 1024 + h * 128, 1024, VTC + (size_t)((b * 4 + h) * 128) * MEMLEN, MEMLEN, MEMLEN / 64,
                               0, nullptr, 0.f, 0.f, lds, m, l, o, tid, r32, hi, gqk, 0.08838834764831845f * LOG2E);
        else attn_pass<128, 128, 0, false, false>(QC + row0 * 512 + h * 128, 512, KVC + (size_t)b * MEMLEN * 1024 + h * 128, 1024, VTC + (size_t)((b * 4 + h) * 128) * MEMLEN, MEMLEN, MEMLEN / 64,
                               0, nullptr, 0.f, 0.f, lds, m, l, o, tid, r32, hi, gqk, 0.08838834764831845f * LOG2E);
        l += shx(l, 32);
        store_o<128>(o, 1.f / l, OC + row0 * 512 + h * 128, 512, r32, hi);
    }
}
__device__ __forceinline__ void diff_phase(const bf16_t* QKV, const bf16_t* VdT, bf16_t* Y, const float* t5tab, const float* t5raw, const float* lamv, const float* dgain, const float* gqk, float lam_init,
                                           float* stash, ldsp_t lds, int tid, int wave, int lane, int r32, int hi, int Bx, int Gd) {
    const int G = Gd, vcu = vcu_of(Bx, G);
    f32x4* st = (f32x4*)(stash + ((size_t)(Bx * NWAVES + wave) * 64 + lane) * 64);
    float bmax = fmaxf(fabsf(t5raw[lane]), fabsf(t5raw[64 + lane]));
#pragma unroll
    for (int o = 1; o < 64; o <<= 1) bmax = fmaxf(bmax, shx(bmax, o));
    const float sref = score_bound<64>(gqk, gqk + 64, lane) + bmax * LOG2E;
    const float lam = __expf(wave_sum(lamv[lane] * lamv[64 + lane])) - __expf(wave_sum(lamv[128 + lane] * lamv[192 + lane])) + lam_init;
    for (int u = vcu; u < BATCH * 4 * 32; u += G) {
        const int qt = u & 31, h = (u >> 5) & 3, b = u >> 7;
        const int q0w = qt * 256 + wave * 32; const size_t row0 = (size_t)b * SEQ + q0w;
        const float cneg = t5raw[15 * 4 + h] * LOG2E, cpos = t5raw[31 * 4 + h] * LOG2E; const float* tb = t5tab + h * 16384 + 8192;
        const bf16_t* Kb = QKV + (size_t)b * SEQ * QKVP + 2048 + h * 128; const bf16_t* Vt = VdT + (size_t)((b * 4 + h) * 128) * SEQ;
        float m, l; f32x16 o1[4];
        { f32x16 o2[4];
          m = sref;
          if (sref < 40.f) attn_pass<64, 128, 1, false, true>(QKV + row0 * QKVP + 1536 + h * 128 + 64, QKVP, Kb + 64, QKVP, Vt, SEQ, SEQ / 64, q0w, tb, cneg, cpos, lds, m, l, o2, tid, r32, hi, gqk, 0.125f * LOG2E);
          else attn_pass<64, 128, 1, false, false>(QKV + row0 * QKVP + 1536 + h * 128 + 64, QKVP, Kb + 64, QKVP, Vt, SEQ, SEQ / 64, q0w, tb, cneg, cpos, lds, m, l, o2, tid, r32, hi, gqk, 0.125f * LOG2E);
          l += shx(l, 32);
          const float inv = lam / l;
#pragma unroll
          for (int d0 = 0; d0 < 4; ++d0)
#pragma unroll
              for (int g = 0; g < 4; ++g) st[d0 * 4 + g] = (f32x4){o2[d0][4 * g] * inv, o2[d0][4 * g + 1] * inv, o2[d0][4 * g + 2] * inv, o2[d0][4 * g + 3] * inv}; }
        asm volatile("" ::: "memory");
        m = sref;
        if (sref < 40.f) attn_pass<64, 128, 1, false, true>(QKV + row0 * QKVP + 1536 + h * 128, QKVP, Kb, QKVP, Vt, SEQ, SEQ / 64, q0w, tb, cneg, cpos, lds, m, l, o1, tid, r32, hi, gqk, 0.125f * LOG2E);
        else attn_pass<64, 128, 1, false, false>(QKV + row0 * QKVP + 1536 + h * 128, QKVP, Kb, QKVP, Vt, SEQ, SEQ / 64, q0w, tb, cneg, cpos, lds, m, l, o1, tid, r32, hi, gqk, 0.125f * LOG2E);
        l += shx(l, 32);
        float ss = 0.f;
        { const float inv = 1.f / l;
#pragma unroll
          for (int d0 = 0; d0 < 4; ++d0)
#pragma unroll
              for (int g = 0; g < 4; ++g) { const f32x4 sv = st[d0 * 4 + g];
#pragma unroll
                  for (int e = 0; e < 4; ++e) { const float v = o1[d0][4 * g + e] * inv - sv[e]; o1[d0][4 * g + e] = v; ss += v * v; } } }
        asm volatile("" ::: "memory");
        ss += shx(ss, 32);
        const float rstd = rsqrtf(ss * (1.f / 128.f) + EPS) * (1.f - lam_init);
        bf16_t* Ow = Y + row0 * DM + 512 + h * 128;
#pragma unroll
        for (int d0 = 0; d0 < 4; ++d0)
#pragma unroll
            for (int j = 0; j < 2; ++j) {
                const int d = 32 * d0 + 16 * j + 8 * hi; const f32x4 g0 = *(const f32x4*)(dgain + h * 128 + d), g1 = *(const f32x4*)(dgain + h * 128 + d + 4);
                u32x4 w; w.x = pk2(o1[d0][8 * j] * rstd * g0.x, o1[d0][8 * j + 1] * rstd * g0.y); w.y = pk2(o1[d0][8 * j + 2] * rstd * g0.z, o1[d0][8 * j + 3] * rstd * g0.w);
                w.z = pk2(o1[d0][8 * j + 4] * rstd * g1.x, o1[d0][8 * j + 5] * rstd * g1.y); w.w = pk2(o1[d0][8 * j + 6] * rstd * g1.z, o1[d0][8 * j + 7] * rstd * g1.w);
                *(GAS u32x4*)(Ow + (size_t)r32 * DM + d) = w;
            }
    }
}
__device__ __forceinline__ void na_phase(const bf16_t* QKV, const bf16_t* VcT, bf16_t* Y, const float* rpb, const float* gq, const float* gk, ldsp_t lds, int tid, int wave, int r32, int hi, int Bx, int Gd) {
    const int G = Gd, vcu = vcu_of(Bx, G);
    LAS unsigned char* Ks = lds; LAS unsigned char* Vts = lds + ATT_VOFF; LAS float* rpl = (LAS float*)(lds + 3 * ATT_BUF);
    float bmax = 0.f;
    for (int i = (tid & 63); i < 8 * 465; i += 64) bmax = fmaxf(bmax, fabsf(rpb[i]));
#pragma unroll
    for (int o_ = 1; o_ < 64; o_ <<= 1) bmax = fmaxf(bmax, shx(bmax, o_));
    const float sref = score_bound<64>(gq, gk, tid & 63) + bmax * LOG2E;
    const bool fast = sref < 40.f;
    for (int u = vcu; u < BATCH * 8 * 32; u += G) {
        const int rg = u & 31, h = (u >> 5) & 7, b = u >> 8;
        const int R0 = 4 * rg, Rw = R0 + (wave >> 1), qc = 32 * (wave & 1) + r32;
        const int r0w = clampi(Rw - 4, 0, 120), ulo = clampi(R0 - 4, 0, 120), uhi = clampi(R0 - 1, 0, 120) + 7, nt = uhi - ulo + 1;
        const int c0 = clampi(qc - 8, 0, 48);
        __syncthreads();
        if (tid < 465) rpl[tid] = rpb[h * 465 + tid] * LOG2E;
        const size_t row0 = (size_t)b * SEQ + Rw * 64 + 32 * (wave & 1);
        const bf16_t* Qw = QKV + row0 * QKVP + h * 64;
        const bf16_t* Kb = QKV + ((size_t)b * SEQ + ulo * 64) * QKVP + 512 + h * 64;
        const bf16_t* Vtb = VcT + (size_t)((b * 8 + h) * 64) * SEQ + ulo * 64;
        bf16x8 qf[4];
#pragma unroll
        for (int d0 = 0; d0 < 4; ++d0) qf[d0] = *(const GAS bf16x8*)(Qw + (size_t)r32 * QKVP + d0 * 16 + hi * 8);
        qf_norm<64, false>(qf, gq, 0.125f * LOG2E, hi, nullptr, nullptr, 0, 0);
        float m = -1e30f, l = 0.f; f32x16 o[2], oe;
#pragma unroll
        for (int r = 0; r < 16; ++r) oe[r] = 0.f;
#pragma unroll
        for (int d0 = 0; d0 < 2; ++d0)
#pragma unroll
            for (int r = 0; r < 16; ++r) o[d0][r] = 0.f;
        KVRegs<64, 64> R; kv_load<64, 64>(R, Kb, QKVP, Vtb, SEQ, tid);
        for (int t = 0; t < nt; ++t) {
            __syncthreads();
            kv_store<64, 64>(R, Ks, Vts, tid);
            __syncthreads();
            if (t + 1 < nt) kv_load<64, 64>(R, Kb + (size_t)(t + 1) * 64 * QKVP, QKVP, Vtb + (t + 1) * 64, SEQ, tid);
            const int kr = ulo + t;
            if (kr >= r0w && kr < r0w + 8) {
                f32x16 p0, p1; tile_qk<64>(p0, p1, qf, Ks, r32, hi, fast ? -sref : 0.f);
                const LAS float* rp = rpl + (kr - Rw + 7) * 31 + 15 - qc;
#pragma unroll
                for (int r = 0; r < 16; ++r) {
                    const int kc = 16 * (r >> 3) + (r & 7) + 8 * hi, kc2 = kc + 32;
                    p0[r] = (kc >= c0 && kc < c0 + 16) ? p0[r] + rp[kc] : -1e30f;
                    p1[r] = (kc2 >= c0 && kc2 < c0 + 16) ? p1[r] + rp[kc2] : -1e30f;
                }
                if (fast) tile_exp_pv<64>(p0, p1, oe, o, Vts, r32, hi); else tile_softmax_pv<64>(p0, p1, m, l, o, Vts, r32, hi);
            }
        }
        l += shx(l, 32); if (fast) l = oe[0];
        store_o<64>(o, 1.f / l, Y + row0 * DM + h * 64, DM, r32, hi);
    }
}

constexpr float KSCALE = 0.08838834764831845f;
__device__ __forceinline__ void mlstm_a_phase(const float* Gt, const bf16_t* KmT, const bf16_t* VmT, bf16_t* CST, float* NST, float* SC, ldsp_t lds, int tid, int wave, int r32, int hi, int Bx, int Gd) {
    LAS float* fl = (LAS float*)lds; LAS float* ab = fl + 128; LAS float* wv = fl + 256;
    for (int u = Bx; u < BATCH * 4 * 64 * 2; u += Gd) {
        const int dir = u & 1, c = (u >> 1) & 63, h = (u >> 7) & 3, b = u >> 9, chain = (b * 4 + h) * 2 + dir;
        const size_t tok0 = (size_t)b * SEQ + c * 128;
        __syncthreads();
        float gi = 0.f;
        if (tid < 128) { const float* gp = Gt + (tok0 + tid) * 16 + dir * 8 + h; gi = gp[0]; fl[tid] = logsig(gp[4]); }
        __syncthreads();
        if (tid < 128) {
            float cum = 0.f, tot = 0.f;
            for (int s = 0; s < 128; ++s) { const float f = fl[s]; tot += f; if (dir == 0 ? s <= tid : s >= tid) cum += f; }
            ab[tid] = tot - cum + gi;
            if (tid == 0) SC[(chain * 64 + c) * 2] = tot;
        }
        __syncthreads();
        if (tid < 128) {
            float mx = -1e30f;
            for (int s = 0; s < 128; ++s) mx = fmaxf(mx, ab[s]);
            wv[tid] = __expf(ab[tid] - mx) * KSCALE;
            if (tid == 0) SC[(chain * 64 + c) * 2 + 1] = mx;
        }
        __syncthreads();
        const int mi = wave >> 1, nh = wave & 1;
        const bf16_t* vp = VmT + ((size_t)((b * 4 + h) * 128 + 32 * mi + r32)) * SEQ + c * 128 + 8 * hi;
        const bf16_t* kp = KmT + ((size_t)((b * 4 + h) * 128 + 64 * nh + r32)) * SEQ + c * 128 + 8 * hi;
        f32x16 acc[2];
#pragma unroll
        for (int ni = 0; ni < 2; ++ni)
#pragma unroll
            for (int r = 0; r < 16; ++r) acc[ni][r] = 0.f;
#pragma unroll
        for (int ks = 0; ks < 8; ++ks) {
            const bf16x8 a = *(const GAS bf16x8*)(vp + 16 * ks);
            const LAS float* wp = wv + 16 * ks + 8 * hi;
#pragma unroll
            for (int ni = 0; ni < 2; ++ni) {
                const u32x4 kr = *(const GAS u32x4*)(kp + (size_t)(32 * ni) * SEQ + 16 * ks);
                u32x4 kw; kw.x = pk2(bflo(kr.x) * wp[0], bfhi(kr.x) * wp[1]); kw.y = pk2(bflo(kr.y) * wp[2], bfhi(kr.y) * wp[3]);
                kw.z = pk2(bflo(kr.z) * wp[4], bfhi(kr.z) * wp[5]); kw.w = pk2(bflo(kr.w) * wp[6], bfhi(kr.w) * wp[7]);
                acc[ni] = MFMA32(a, __builtin_bit_cast(bf16x8, kw), acc[ni]);
            }
        }
        bf16_t* cp = CST + (size_t)(chain * 64 + c) * 16384;
#pragma unroll
        for (int ni = 0; ni < 2; ++ni)
#pragma unroll
            for (int r = 0; r < 16; ++r) { const int dv = 32 * mi + crow(r, hi), dk = 64 * nh + 32 * ni + r32; cp[dv * 128 + dk] = (bf16_t)(pk2(acc[ni][r], 0.f) & 0xffffu); }
        if (tid < 128) {
            const bf16_t* kq = KmT + ((size_t)((b * 4 + h) * 128 + tid)) * SEQ + c * 128; float s = 0.f;
#pragma unroll 4
            for (int j = 0; j < 16; ++j) { const u32x4 kr = *(const GAS u32x4*)(kq + 8 * j); const LAS float* wp = wv + 8 * j;
                s += bflo(kr.x) * wp[0] + bfhi(kr.x) * wp[1] + bflo(kr.y) * wp[2] + bfhi(kr.y) * wp[3] + bflo(kr.z) * wp[4] + bfhi(kr.z) * wp[5] + bflo(kr.w) * wp[6] + bfhi(kr.w) * wp[7]; }
            NST[(size_t)(chain * 64 + c) * 128 + tid] = s;
        }
    }
}
__device__ __forceinline__ void mlstm_scan_phase(bf16_t* CST, float* NST, const float* SC, float* MST, int gtid, int nthreads) {
    for (int idx = gtid; idx < 64 * 2048; idx += nthreads) {
        const int chain = idx >> 11, e = idx & 2047, dir = chain & 1; const bool hasn = e < 16;
        float C[8], N[8]; float m = 0.f;
#pragma unroll
        for (int i = 0; i < 8; ++i) { C[i] = 0.f; N[i] = 0.f; }
        for (int step = 0; step < 64; ++step) {
            const int c = dir ? 63 - step : step; const int base = chain * 64 + c;
            const float g = SC[base * 2], ml = SC[base * 2 + 1];
            const float mn = fmaxf(g + m, ml), dec = __expf(g + m - mn), sc = __expf(ml - mn);
            GAS u32x4* p = (GAS u32x4*)(CST + (size_t)base * 16384 + e * 8);
            const u32x4 kl = *p;
            u32x4 st; st.x = pk2(C[0], C[1]); st.y = pk2(C[2], C[3]); st.z = pk2(C[4], C[5]); st.w = pk2(C[6], C[7]);
            *p = st;
            if (e == 0) MST[base] = m;
            C[0] = dec * C[0] + sc * bflo(kl.x); C[1] = dec * C[1] + sc * bfhi(kl.x); C[2] = dec * C[2] + sc * bflo(kl.y); C[3] = dec * C[3] + sc * bfhi(kl.y);
            C[4] = dec * C[4] + sc * bflo(kl.z); C[5] = dec * C[5] + sc * bfhi(kl.z); C[6] = dec * C[6] + sc * bflo(kl.w); C[7] = dec * C[7] + sc * bfhi(kl.w);
            if (hasn) {
                GAS f32x4* q = (GAS f32x4*)(NST + (size_t)base * 128 + e * 8);
                const f32x4 n0 = q[0], n1 = q[1];
                q[0] = (f32x4){N[0], N[1], N[2], N[3]}; q[1] = (f32x4){N[4], N[5], N[6], N[7]};
                N[0] = dec * N[0] + sc * n0.x; N[1] = dec * N[1] + sc * n0.y; N[2] = dec * N[2] + sc * n0.z; N[3] = dec * N[3] + sc * n0.w;
                N[4] = dec * N[4] + sc * n1.x; N[5] = dec * N[5] + sc * n1.y; N[6] = dec * N[6] + sc * n1.z; N[7] = dec * N[7] + sc * n1.w;
            }
            m = mn;
        }
    }
}
__device__ __forceinline__ void mlstm_c_phase(const bf16_t* QKV, const float* Gt, const bf16_t* VmT, const bf16_t* CST, const float* NST, const float* MST, const float* mgain, bf16_t* Y,
                                              ldsp_t lds, int tid, int wave, int r32, int hi, int Bx, int Gd) {
    LAS float* bc = (LAS float*)lds; LAS float* rbv = bc + 128; LAS float* aif = bc + 256; LAS float* aib = bc + 384; LAS float* nst = bc + 512; LAS float* hb = bc + 1024;
    const int dir = wave >> 2, tb = wave & 3, t = 32 * tb + r32;
    for (int u = Bx; u < BATCH * 4 * 64; u += Gd) {
        const int c = u & 63, h = (u >> 6) & 3, b = u >> 8;
        const size_t tok0 = (size_t)b * SEQ + c * 128;
        __syncthreads();
        float i_f = 0.f, i_b = 0.f;
        if (tid < 128) { const float* gp = Gt + (tok0 + tid) * 16 + h; i_f = gp[0]; hb[tid] = logsig(gp[4]); i_b = gp[8]; hb[128 + tid] = logsig(gp[12]); }
        else if (tid < 384) { const int d2 = (tid - 128) >> 7, dk = (tid - 128) & 127; nst[d2 * 128 + dk] = NST[(size_t)(((b * 4 + h) * 2 + d2) * 64 + c) * 128 + dk]; }
        __syncthreads();
        if (tid < 128) {
            float cf = 0.f, cb = 0.f;
            for (int s = 0; s < 128; ++s) { if (s <= tid) cf += hb[s]; if (s >= tid) cb += hb[128 + s]; }
            bc[tid] = cf; rbv[tid] = cb; aif[tid] = i_f - cf; aib[tid] = i_b - cb;
        }
        __syncthreads();
        const int chain = (b * 4 + h) * 2 + dir;
        const float mst = MST[chain * 64 + c];
        const float bct = dir ? rbv[t] : bc[t];
        const LAS float* ai = dir ? aib : aif;
        bf16x8 qf[8];
        { const bf16_t* qp = QKV + (tok0 + t) * QKVP + 768 + h * 128 + 8 * hi;
#pragma unroll
          for (int k0 = 0; k0 < 8; ++k0) qf[k0] = *(const GAS bf16x8*)(qp + 16 * k0); }
        float mmax = -1e30f;
        for (int s = hi; s < 128; s += 2) { const bool ok = dir == 0 ? s <= t : s >= t; const float v = bct + ai[s]; if (ok) mmax = fmaxf(mmax, v); }
        mmax = fmaxf(mmax, shx(mmax, 32));
        const float mt = fmaxf(mmax, bct + mst);
        const float inter = __expf(bct + mst - mt);
        f32x16 acc[4];
#pragma unroll
        for (int d0 = 0; d0 < 4; ++d0) {
#pragma unroll
            for (int r = 0; r < 16; ++r) acc[d0][r] = 0.f;
            const bf16_t* cp = CST + (size_t)(chain * 64 + c) * 16384 + (32 * d0 + r32) * 128 + 8 * hi;
#pragma unroll
            for (int k0 = 0; k0 < 8; ++k0) { const bf16x8 cf = *(const GAS bf16x8*)(cp + 16 * k0); acc[d0] = MFMA32(cf, qf[k0], acc[d0]); }
            acc[d0] = acc[d0] * inter;
        }
        float den = 0.f;
#pragma unroll 1
        for (int sb = 0; sb < 4; ++sb) {
            const bool actv = dir == 0 ? sb <= tb : sb >= tb;
            if (!actv) continue;
            f32x16 p;
#pragma unroll
            for (int r = 0; r < 16; ++r) p[r] = 0.f;
            const bf16_t* kp = QKV + (tok0 + 32 * sb + r32) * QKVP + 1280 + h * 128 + 8 * hi;
#pragma unroll
            for (int k0 = 0; k0 < 8; ++k0) { const bf16x8 kf = *(const GAS bf16x8*)(kp + 16 * k0); p = MFMA32(kf, qf[k0], p); }
#pragma unroll
            for (int r = 0; r < 16; ++r) { const int s = 32 * sb + crow(r, hi); const bool ok = dir == 0 ? s <= t : s >= t;
                const float v = ok ? p[r] * KSCALE * __expf(bct + ai[s] - mt) : 0.f; p[r] = v; den += v; }
#pragma unroll
            for (int j = 0; j < 2; ++j) {
                const u32x4 w = {pk2(p[8 * j], p[8 * j + 1]), pk2(p[8 * j + 2], p[8 * j + 3]), pk2(p[8 * j + 4], p[8 * j + 5]), pk2(p[8 * j + 6], p[8 * j + 7])};
                const bf16x8 pb = __builtin_bit_cast(bf16x8, w);
#pragma unroll
                for (int d0 = 0; d0 < 4; ++d0) {
                    const bf16_t* vp = VmT + ((size_t)((b * 4 + h) * 128 + 32 * d0 + r32)) * SEQ + c * 128 + 32 * sb + 16 * j + 4 * hi;
                    const s16x4 lo = *(const GAS s16x4*)vp, h4 = *(const GAS s16x4*)(vp + 8);
                    const bf16x8 a = {lo[0], lo[1], lo[2], lo[3], h4[0], h4[1], h4[2], h4[3]};
                    acc[d0] = MFMA32(a, pb, acc[d0]);
                }
            }
        }
        den += shx(den, 32);
        float qn = 0.f;
#pragma unroll
        for (int k0 = 0; k0 < 8; ++k0) { const u32x4 qw = __builtin_bit_cast(u32x4, qf[k0]); const LAS float* np = nst + dir * 128 + 16 * k0 + 8 * hi;
            qn += bflo(qw.x) * np[0] + bfhi(qw.x) * np[1] + bflo(qw.y) * np[2] + bfhi(qw.y) * np[3] + bflo(qw.z) * np[4] + bfhi(qw.z) * np[5] + bflo(qw.w) * np[6] + bfhi(qw.w) * np[7]; }
        qn += shx(qn, 32);
        den += inter * qn;
        const float rden = 1.f / fmaxf(fabsf(den), __expf(-mt));
        __syncthreads();
        if (dir == 1) {
#pragma unroll
            for (int d0 = 0; d0 < 4; ++d0)
#pragma unroll
                for (int r = 0; r < 16; ++r) hb[(32 * d0 + crow(r, hi)) * 129 + t] = acc[d0][r] * rden;
        }
        __syncthreads();
        if (dir == 0) {
            float ss = 0.f;
#pragma unroll
            for (int d0 = 0; d0 < 4; ++d0)
#pragma unroll
                for (int r = 0; r < 16; ++r) { const float v = acc[d0][r] * rden + hb[(32 * d0 + crow(r, hi)) * 129 + t]; acc[d0][r] = v; ss += v * v; }
            ss += shx(ss, 32);
            const float rstd = rsqrtf(ss * (1.f / 128.f) + EPS);
            const bf16_t* op = QKV + (tok0 + t) * QKVP + 2304 + h * 128; bf16_t* yp = Y + (tok0 + t) * DM + 512 + h * 128;
#pragma unroll
            for (int d0 = 0; d0 < 4; ++d0)
#pragma unroll
                for (int g = 0; g < 4; ++g) {
                    const int d = 32 * d0 + 8 * g + 4 * hi; const f32x4 gn = *(const f32x4*)(mgain + h * 128 + d); const u32x2 ow = *(const u32x2*)(op + d);
                    const float s0 = 1.f / (1.f + __expf(-bflo(ow.x))), s1 = 1.f / (1.f + __expf(-bfhi(ow.x))), s2 = 1.f / (1.f + __expf(-bflo(ow.y))), s3 = 1.f / (1.f + __expf(-bfhi(ow.y)));
                    u32x2 w; w.x = pk2(acc[d0][4 * g] * rstd * gn.x * s0, acc[d0][4 * g + 1] * rstd * gn.y * s1); w.y = pk2(acc[d0][4 * g + 2] * rstd * gn.z * s2, acc[d0][4 * g + 3] * rstd * gn.w * s3);
                    *(u32x2*)(yp + d) = w;
                }
        }
    }
}
constexpr size_t WS_GP = 1008 * MiB, WS_WC = 1016 * MiB;
__device__ __forceinline__ void mlstm_gates_phase(const float* Gt, float* GP, float* WC, float* SC, int gw, int NGW, int lane) {
    for (int u = gw; u < BATCH * 4 * 64; u += NGW) {
        const int c = u & 63, h = (u >> 6) & 3, b = u >> 8;
        const size_t tok0 = (size_t)b * SEQ + c * 128;
        const int t0 = 2 * lane;
        const float* g0 = Gt + (tok0 + t0) * 16 + h; const float* g1 = g0 + 16;
        const float if0 = g0[0], ff0 = logsig(g0[4]), ib0 = g0[8], fb0 = logsig(g0[12]);
        const float if1 = g1[0], ff1 = logsig(g1[4]), ib1 = g1[8], fb1 = logsig(g1[12]);
        const float sf = ff0 + ff1, sb = fb0 + fb1;
        float xf = sf, xb = sb;
#pragma unroll
        for (int o = 1; o < 64; o <<= 1) { const float yf = shup(xf, o), yb = shup(xb, o); if (lane >= o) { xf += yf; xb += yb; } }
        const float totf = shl_(xf, 63), totb = shl_(xb, 63);
        const float bc0 = (xf - sf) + ff0, bc1 = bc0 + ff1;
        const float cb0 = (xb - sb) + fb0, cb1 = cb0 + fb1;
        const float rb0 = totb - cb0 + fb0, rb1 = totb - cb1 + fb1;
        const float aif0 = if0 - bc0, aif1 = if1 - bc1, aib0 = ib0 - rb0, aib1 = ib1 - rb1;
        float px = fmaxf(aif0, aif1);
#pragma unroll
        for (int o = 1; o < 64; o <<= 1) { const float y = shup(px, o); if (lane >= o) px = fmaxf(px, y); }
        float pe = shup(px, 1); if (lane == 0) pe = -3.0e38f;
        const float pmf0 = fmaxf(pe, aif0), pmf1 = fmaxf(pmf0, aif1);
        float sx = fmaxf(aib0, aib1);
#pragma unroll
        for (int o = 1; o < 64; o <<= 1) { const float y = shdn(sx, o); if (lane + o < 64) sx = fmaxf(sx, y); }
        float se = shdn(sx, 1); if (lane == 63) se = -3.0e38f;
        const float pmb1 = fmaxf(se, aib1), pmb0 = fmaxf(pmb1, aib0);
        const float mxf = shl_(px, 63), mxb = shl_(sx, 0);
        const float wf0 = __expf(aif0 - mxf) * KSCALE, wf1 = __expf(aif1 - mxf) * KSCALE, wb0 = __expf(aib0 - mxb) * KSCALE, wb1 = __expf(aib1 - mxb) * KSCALE;
        GAS f32x4* gp = (GAS f32x4*)(GP + ((size_t)(b * 4 + h) * SEQ + c * 128 + t0) * 8);
        gp[0] = (f32x4){bc0, rb0, aif0, aib0}; gp[1] = (f32x4){wf0, wb0, pmf0, pmb0}; gp[2] = (f32x4){bc1, rb1, aif1, aib1}; gp[3] = (f32x4){wf1, wb1, pmf1, pmb1};
        const int chf = (b * 4 + h) * 2;
        *(GAS f32x2*)(WC + (size_t)(chf * 64 + c) * 128 + t0) = (f32x2){wf0, wf1};
        *(GAS f32x2*)(WC + (size_t)((chf + 1) * 64 + c) * 128 + t0) = (f32x2){wb0, wb1};
        if (lane == 0) { SC[(chf * 64 + c) * 2] = totf; SC[(chf * 64 + c) * 2 + 1] = totf + mxf; SC[((chf + 1) * 64 + c) * 2] = totb; SC[((chf + 1) * 64 + c) * 2 + 1] = totb + mxb; }
    }
}
__device__ __forceinline__ void mlstm_a2_phase(const float* WC, const bf16_t* KmT, const bf16_t* VmT, bf16_t* CST, float* NST, int gw, int NGW, int r32, int hi) {
    for (int u = gw; u < BATCH * 4 * 64 * 2 * 4; u += NGW) {
        const int mi = u & 3, dir = (u >> 2) & 1, c = (u >> 3) & 63, h = (u >> 9) & 3, b = u >> 11, chain = (b * 4 + h) * 2 + dir;
        const float* wp0 = WC + (size_t)(chain * 64 + c) * 128 + 8 * hi;
        const bf16_t* vp = VmT + ((size_t)((b * 4 + h) * 128 + 32 * mi + r32)) * SEQ + c * 128 + 8 * hi;
        const bf16_t* kp = KmT + ((size_t)((b * 4 + h) * 128 + r32)) * SEQ + c * 128 + 8 * hi;
        f32x16 acc[4]; float nl[4];
#pragma unroll
        for (int ni = 0; ni < 4; ++ni) { nl[ni] = 0.f;
#pragma unroll
            for (int r = 0; r < 16; ++r) acc[ni][r] = 0.f; }
#pragma unroll 2
        for (int ks = 0; ks < 8; ++ks) {
            const bf16x8 a = *(const GAS bf16x8*)(vp + 16 * ks);
            const f32x4 w0 = *(const GAS f32x4*)(wp0 + 16 * ks), w1 = *(const GAS f32x4*)(wp0 + 16 * ks + 4);
#pragma unroll
            for (int ni = 0; ni < 4; ++ni) {
                const u32x4 kr = *(const GAS u32x4*)(kp + (size_t)(32 * ni) * SEQ + 16 * ks);
                const float p0 = bflo(kr.x) * w0.x, p1 = bfhi(kr.x) * w0.y, p2 = bflo(kr.y) * w0.z, p3 = bfhi(kr.y) * w0.w, p4 = bflo(kr.z) * w1.x, p5 = bfhi(kr.z) * w1.y, p6 = bflo(kr.w) * w1.z, p7 = bfhi(kr.w) * w1.w;
                nl[ni] += ((p0 + p1) + (p2 + p3)) + ((p4 + p5) + (p6 + p7));
                const u32x4 kw = {pk2(p0, p1), pk2(p2, p3), pk2(p4, p5), pk2(p6, p7)};
                acc[ni] = MFMA32(a, __builtin_bit_cast(bf16x8, kw), acc[ni]);
            }
        }
#pragma unroll
        for (int g = 0; g < 4; ++g) {
            GAS bf16_t* cp = (GAS bf16_t*)(CST + (size_t)(chain * 64 + c) * 16384 + (32 * mi + 8 * g + 4 * hi) * 128 + r32);
            asm volatile("" : "+v"(cp));
#pragma unroll
            for (int e = 0; e < 4; ++e)
#pragma unroll
                for (int ni = 0; ni < 4; ++ni) cp[e * 128 + 32 * ni] = (bf16_t)(pk2(acc[ni][4 * g + e], 0.f) & 0xffffu);
        }
#pragma unroll
        for (int ni = 0; ni < 4; ++ni) { const float v = nl[ni] + shx(nl[ni], 32); if (mi == 0 && hi == 0) NST[(size_t)(chain * 64 + c) * 128 + 32 * ni + r32] = v; }
    }
}
__device__ __forceinline__ void mlstm_c2_phase(const bf16_t* QKV, const float* GP, const bf16_t* VmT, const bf16_t* CST, const float* NST, const float* MST, const float* mgain, bf16_t* Y,
                                               LAS float* wl, int gw, int NGW, int lane_, int r32_, int hi_) {
    LAS float* hs = wl; LAS float* aiL = wl + 4096;
    for (int u = gw; u < BATCH * 4 * 64 * 4; u += NGW) {
        const int lane = lane_id(), r32 = lane & 31, hi = lane >> 5; (void)lane_; (void)r32_; (void)hi_;
        const int tb = u & 3, c = (u >> 2) & 63, h = (u >> 8) & 3, b = u >> 10, t = 32 * tb + r32;
        const size_t tok0 = (size_t)b * SEQ + c * 128;
        const GAS f32x4* gpc = (const GAS f32x4*)(GP + ((size_t)(b * 4 + h) * SEQ + c * 128) * 8);
        { const f32x4 e0 = gpc[(2 * lane) * 2], e1 = gpc[(2 * lane + 1) * 2]; aiL[2 * lane] = e0.z; aiL[128 + 2 * lane] = e0.w; aiL[2 * lane + 1] = e1.z; aiL[128 + 2 * lane + 1] = e1.w; }
        LDS_FENCE();
#pragma nounroll
        for (int dir_ = 0; dir_ < 2; ++dir_) {
            int dir = dir_; asm volatile("" : "+s"(dir));
            bf16x8 qf[8];
            { const bf16_t* qp = QKV + (tok0 + t) * QKVP + 768 + h * 128 + 8 * hi;
#pragma unroll
              for (int k0 = 0; k0 < 8; ++k0) qf[k0] = *(const GAS bf16x8*)(qp + 16 * k0); }
            const int chain = (b * 4 + h) * 2 + dir;
            const float mst = MST[chain * 64 + c];
            const GAS float* gpt = (const GAS float*)(gpc + t * 2) + dir;
            const float bct = gpt[0], pm = gpt[6];
            const LAS float* ai = aiL + dir * 128;
            const float mt = fmaxf(bct + pm, bct + mst), inter = __expf(bct + mst - mt);
            f32x16 acc[4];
#pragma unroll
            for (int d0 = 0; d0 < 4; ++d0) {
#pragma unroll
                for (int r = 0; r < 16; ++r) acc[d0][r] = 0.f;
                const bf16_t* cp = CST + (size_t)(chain * 64 + c) * 16384 + (32 * d0 + r32) * 128 + 8 * hi;
#pragma unroll
                for (int k0 = 0; k0 < 8; ++k0) { const bf16x8 cf = *(const GAS bf16x8*)(cp + 16 * k0); acc[d0] = MFMA32(cf, qf[k0], acc[d0]); }
                acc[d0] = acc[d0] * inter;
            }
            float den = 0.f;
#pragma unroll 1
            for (int sb = 0; sb < 4; ++sb) {
                const bool actv = dir == 0 ? sb <= tb : sb >= tb;
                if (!actv) continue;
                f32x16 p;
#pragma unroll
                for (int r = 0; r < 16; ++r) p[r] = 0.f;
                const int pr = (r32 & 0x13) | ((r32 & 4) << 1) | ((r32 & 8) >> 1);
                const bf16_t* kp = QKV + (tok0 + 32 * sb + pr) * QKVP + 1280 + h * 128 + 8 * hi;
#pragma unroll
                for (int k0 = 0; k0 < 8; ++k0) { const bf16x8 kf = *(const GAS bf16x8*)(kp + 16 * k0); p = MFMA32(kf, qf[k0], p); }
#pragma unroll
                for (int r = 0; r < 16; ++r) { const int s = 32 * sb + 16 * (r >> 3) + 8 * hi + (r & 7); const bool ok = dir == 0 ? s <= t : s >= t;
                    const float v = ok ? p[r] * KSCALE * __expf(bct + ai[s] - mt) : 0.f; p[r] = v; den += v; }
#pragma unroll
                for (int j = 0; j < 2; ++j) {
                    const u32x4 w = {pk2(p[8 * j], p[8 * j + 1]), pk2(p[8 * j + 2], p[8 * j + 3]), pk2(p[8 * j + 4], p[8 * j + 5]), pk2(p[8 * j + 6], p[8 * j + 7])};
                    const bf16x8 pb = __builtin_bit_cast(bf16x8, w);
#pragma unroll
                    for (int d0 = 0; d0 < 4; ++d0) {
                        const bf16_t* vp = VmT + ((size_t)((b * 4 + h) * 128 + 32 * d0 + r32)) * SEQ + c * 128 + 32 * sb + 16 * j + 8 * hi;
                        const bf16x8 a = *(const GAS bf16x8*)vp;
                        acc[d0] = MFMA32(a, pb, acc[d0]);
                    }
                }
            }
            den += shx(den, 32);
            float qn = 0.f;
            { const float* np0 = NST + (size_t)(chain * 64 + c) * 128 + 8 * hi;
#pragma unroll
              for (int k0 = 0; k0 < 8; ++k0) { const u32x4 qw = __builtin_bit_cast(u32x4, qf[k0]); const f32x4 n0 = *(const GAS f32x4*)(np0 + 16 * k0), n1 = *(const GAS f32x4*)(np0 + 16 * k0 + 4);
                  qn += bflo(qw.x) * n0.x + bfhi(qw.x) * n0.y + bflo(qw.y) * n0.z + bfhi(qw.y) * n0.w + bflo(qw.z) * n1.x + bfhi(qw.z) * n1.y + bflo(qw.w) * n1.z + bfhi(qw.w) * n1.w; } }
            qn += shx(qn, 32);
            den += inter * qn;
            const float rden = 1.f / fmaxf(fabsf(den), __expf(-mt));
            if (dir == 0) {
#pragma unroll
                for (int d0 = 0; d0 < 4; ++d0)
#pragma unroll
                    for (int r = 0; r < 16; ++r) hs[(32 * d0 + crow(r, hi)) * 32 + r32] = acc[d0][r] * rden;
                LDS_FENCE();
            } else {
                float ss = 0.f;
#pragma unroll
                for (int d0 = 0; d0 < 4; ++d0)
#pragma unroll
                    for (int r = 0; r < 16; ++r) { const float v = acc[d0][r] * rden + hs[(32 * d0 + crow(r, hi)) * 32 + r32]; acc[d0][r] = v; ss += v * v; }
                ss += shx(ss, 32);
                const float rstd = rsqrtf(ss * (1.f / 128.f) + EPS);
                const bf16_t* op = QKV + (tok0 + t) * QKVP + 2304 + h * 128; bf16_t* yp = Y + (tok0 + t) * DM + 512 + h * 128;
#pragma unroll
                for (int d0 = 0; d0 < 4; ++d0)
#pragma unroll
                    for (int g = 0; g < 4; ++g) {
                        const int d = 32 * d0 + 8 * g + 4 * hi; const f32x4 gn = *(const GAS f32x4*)(mgain + h * 128 + d); const u32x2 ow = *(const GAS u32x2*)(op + d);
                        const float s0 = 1.f / (1.f + __expf(-bflo(ow.x))), s1 = 1.f / (1.f + __expf(-bfhi(ow.x))), s2 = 1.f / (1.f + __expf(-bflo(ow.y))), s3 = 1.f / (1.f + __expf(-bfhi(ow.y)));
                        u32x2 w; w.x = pk2(acc[d0][4 * g] * rstd * gn.x * s0, acc[d0][4 * g + 1] * rstd * gn.y * s1); w.y = pk2(acc[d0][4 * g + 2] * rstd * gn.z * s2, acc[d0][4 * g + 3] * rstd * gn.w * s3);
                        *(GAS u32x2*)(yp + d) = w;
                    }
            }
        }
        LDS_FENCE();
    }
}
#define PH_BEGIN { int tid = wave_s * 64 + lane_id(); asm volatile("" : "+v"(tid)); const int lane = tid & 63, wave = wave_s, r32 = lane & 31, hi = lane >> 5; \
    int Bx = blockIdx.x, Gd = gridDim.x; asm volatile("" : "+s"(Bx), "+s"(Gd)); \
    const int gw = Bx * NWAVES + wave, NGW = Gd * NWAVES, gtid = Bx * NTHR + tid, nthreads = Gd * NTHR; \
    LAS float* scrf = (LAS float*)(lds + wave * 16384); LAS bf16_t* scrh = (LAS bf16_t*)(lds + wave * 16384); \
    (void)Bx; (void)Gd; (void)lane; (void)r32; (void)hi; (void)gw; (void)NGW; (void)gtid; (void)nthreads; (void)scrf; (void)scrh;
#define PH_END }
__global__ void __launch_bounds__(NTHR) fwd_megakernel(Args args) {
    extern __shared__ __attribute__((aligned(16))) unsigned char lds_raw[];
    cg::grid_group grid = cg::this_grid();
    ldsp_t lds = (ldsp_t)lds_raw;
    const int wave_s = __builtin_amdgcn_readfirstlane(threadIdx.x >> 6);
    unsigned char* wsl = args.ws;
    if (threadIdx.x < 2) ((LAS unsigned*)(lds + (LDS_BYTES - 16)))[threadIdx.x] = 0u;
    __syncthreads();
    xb_post((unsigned*)wsl, wave_s);
    grid.sync();
#define GSYNC() do { gbar((unsigned*)wsl, (volatile LAS unsigned*)(lds + (LDS_BYTES - 16)), wave_s); asm volatile("" : "+s"(wsl)); } while (0)
#define WSP wsl
#define x_in (args.in[0])
#define mem (args.in[1])
#define t5raw (args.in[2])
#define out (args.out)
#define RSB(k) ((float*)(WSP + WS_RS) + (size_t)(k) * MTOK)
#define GPB ((float*)(WSP + WS_GP))
#define WCB ((float*)(WSP + WS_WC))
#define XB ((bf16_t*)out + (size_t)MTOK * DM)
#define XB2 ((bf16_t*)(WSP + WS_Y))
#define HN ((bf16_t*)(WSP + WS_HN))
#define QKV ((bf16_t*)(WSP + WS_QKV))
#define VT ((bf16_t*)(WSP + WS_VT))
#define Y ((bf16_t*)(WSP + WS_Y))
#define CST ((bf16_t*)(WSP + WS_CST))
#define Gt ((float*)(WSP + WS_G))
#define NST ((float*)(WSP + WS_NST))
#define SC ((float*)(WSP + WS_SC))
#define MST ((float*)(WSP + WS_MST))
#define QC ((bf16_t*)(WSP + WS_QC))
#define KVC(l_) ((bf16_t*)(WSP + WS_KVC + (size_t)(l_) * 4 * MiB))
#define VTC(l_) ((bf16_t*)(WSP + WS_VTC + (size_t)(l_) * 2 * MiB))
#define MEMN ((bf16_t*)(WSP + WS_MEMN))
#define OC ((bf16_t*)(WSP + WS_OC))
#define SIDEB ((float*)(WSP + WS_SIDE))
#define ACT ((bf16_t*)(WSP + WS_ACT))
#define T5T ((float*)(WSP + WS_T5))
#define ROPEC ((float*)(WSP + WS_ROPE))
#define ROPES (ROPEC + 2048)

    PH_BEGIN
#ifdef PROBE_P0
    for (int rep = 0; rep < 2; ++rep) {
#else
    {
#endif
    int goff = 0;
    wt_matrix(args.in[7], 1024, 2832, (bf16_t*)(WSP + WS_WIN0), false, scrf, gw, NGW, lane, goff);
    wt_matrix(args.in[11], 1024, 1024, (bf16_t*)(WSP + WS_WOUT0), false, scrf, gw, NGW, lane, goff);
    wt_matrix(args.in[12], 1024, 3072, (bf16_t*)(WSP + WS_WIN1), false, scrf, gw, NGW, lane, goff);
    wt_matrix(args.in[18], 1024, 1024, (bf16_t*)(WSP + WS_WOUT1), false, scrf, gw, NGW, lane, goff);
    for (int l = 0; l < 2; ++l) {
        wt_matrix(args.in[19] + (size_t)l * 1024 * 512, 1024, 512, (bf16_t*)(WSP + WS_WQ + l * MiB), false, scrf, gw, NGW, lane, goff);
        wt_matrix(args.in[20] + (size_t)l * 1024 * 1024, 1024, 1024, (bf16_t*)(WSP + WS_WKV + 2 * l * MiB), false, scrf, gw, NGW, lane, goff);
        wt_matrix(args.in[22] + (size_t)l * 512 * 1024, 512, 1024, (bf16_t*)(WSP + WS_WO + l * MiB), false, scrf, gw, NGW, lane, goff);
        wt_matrix(args.in[23] + (size_t)l * 1024 * 5632, 1024, 5632, (bf16_t*)(WSP + WS_WUP + 11 * l * MiB), true, scrf, gw, NGW, lane, goff);
        wt_matrix(args.in[26] + (size_t)l * 2816 * 1024, 2816, 1024, (bf16_t*)(WSP + WS_WDN + 6 * l * MiB), false, scrf, gw, NGW, lane, goff);
    }
    for (int i = gtid; i < 4 * 16384; i += nthreads) {
        const int h = i >> 14, rel = (i & 16383) - 8192, n = rel < 0 ? -rel : rel;
        int bk;
        if (n < 8) bk = n; else { const int lg = 8 + (int)(logf((float)n / 8.0f) / logf(16.0f) * 8.0f); bk = lg < 15 ? lg : 15; }
        bk += rel > 0 ? 16 : 0;
        T5T[i] = t5raw[bk * 4 + h] * LOG2E;
    }
    for (int i = gtid; i < 2048; i += nthreads) {
        const int pos = i >> 4, j = i & 15;
        const float inv = exp2f(-(float)j * (13.287712379549449f / 16.0f));
        const double rev = (double)((float)pos * inv) * 0.15915494309189535; const float fr = (float)(rev - floor(rev));
        ROPEC[i] = __builtin_amdgcn_cosf(fr); ROPES[i] = __builtin_amdgcn_sinf(fr);
    }
    }
    rms_rows(x_in, args.in[3], HN, MTOK, gw, NGW, lane);
#ifdef PROBE_RMS
    rms_rows(x_in, args.in[3], HN, MTOK, gw, NGW, lane);
#endif
    rms_rows(mem, args.in[5], MEMN, BATCH * MEMLEN, gw, NGW, lane);
    rms_rows(mem, args.in[5] + DM, MEMN + (size_t)BATCH * MEMLEN * DM, BATCH * MEMLEN, gw, NGW, lane);
    for (int i = gtid; i < 5 * MTOK / 4; i += nthreads) ((GAS f32x4*)RSB(0))[i] = (f32x4){0.f, 0.f, 0.f, 0.f};
    PH_END
    GSYNC();

#pragma nounroll
    for (int l = 0; l < 2; ++l) {
#ifndef NO_GEMM
        if (l == 0) { PH_BEGIN EpiBf16G E{QKV, QKVP, Gt, args.in[8], 2816, nullptr}; run_gemm(lds, HN, (const bf16_t*)(WSP + WS_WIN0), MTOK, 3072, 1024, E, tid, Bx, Gd); PH_END
            PH_BEGIN EpiBf16G E{KVC(0), 1024, nullptr, nullptr, 0, nullptr}; run_gemm(lds, MEMN, (const bf16_t*)(WSP + WS_WKV), BATCH * MEMLEN, 1024, 1024, E, tid, Bx, Gd); PH_END
            PH_BEGIN EpiBf16G E{KVC(1), 1024, nullptr, nullptr, 0, nullptr}; run_gemm(lds, MEMN + (size_t)BATCH * MEMLEN * DM, (const bf16_t*)(WSP + WS_WKV + 2 * MiB), BATCH * MEMLEN, 1024, 1024, E, tid, Bx, Gd); PH_END }
        else        PH_BEGIN EpiBf16G E{QKV, QKVP, nullptr, nullptr, 0, RSB(2)};  run_gemm(lds, HN, (const bf16_t*)(WSP + WS_WIN1), MTOK, 3072, 1024, E, tid, Bx, Gd); PH_END
#endif
        GSYNC();
        PH_BEGIN
        if (l == 0) {
            qknorm_rows<64, true>(QKV, QKVP, 512, 128, MTOK, 0, args.in[9], args.in[9] + 64, 1.f, 1.f, ROPEC, ROPES, gw, NGW, lane);
            transpose_cols(QKV, QKVP, 640, 128, SEQ, BATCH, VT, scrh, gw, NGW, lane);
#ifdef PROBE_TR
            transpose_cols(QKV, QKVP, 640, 128, SEQ, BATCH, VT, scrh, gw, NGW, lane);
#endif
            transpose_cols(QKV, QKVP, 1280, 512, SEQ, BATCH, VT + (size_t)8 * MiB, scrh, gw, NGW, lane);
#ifdef PROBE_TR
            transpose_cols(QKV, QKVP, 1280, 512, SEQ, BATCH, VT + (size_t)8 * MiB, scrh, gw, NGW, lane);
#endif
            transpose_cols(QKV, QKVP, 1792, 512, SEQ, BATCH, VT + (size_t)40 * MiB, scrh, gw, NGW, lane);
#ifdef PROBE_TR
            transpose_cols(QKV, QKVP, 1792, 512, SEQ, BATCH, VT + (size_t)40 * MiB, scrh, gw, NGW, lane);
#endif
            mlstm_gates_phase(Gt, GPB, WCB, SC, gw, NGW, lane);
            for (int lc = 0; lc < 2; ++lc) {
                qknorm_rows<128, false>(KVC(lc), 1024, 0, 512, BATCH * MEMLEN, 0, args.in[21] + lc * 256, args.in[21] + lc * 256 + 128, 1.f, 1.f, nullptr, nullptr, gw, NGW, lane);
                transpose_cols(KVC(lc), 1024, 512, 512, MEMLEN, BATCH, VTC(lc), scrh, gw, NGW, lane);
#ifdef PROBE_TR
                transpose_cols(KVC(lc), 1024, 512, 512, MEMLEN, BATCH, VTC(lc), scrh, gw, NGW, lane);
#endif
            }
        } else {
            qknorm_rows<64, false>(QKV, QKVP, 512, 512, MTOK, 0, args.in[13], args.in[13] + 64, 1.f, 1.f, nullptr, nullptr, gw, NGW, lane);
            qknorm_rows<64, false>(QKV, QKVP, 2048, 512, MTOK, 0, args.in[15], args.in[15] + 64, 1.f, 1.f, nullptr, nullptr, gw, NGW, lane);
            transpose_cols(QKV, QKVP, 1024, 512, SEQ, BATCH, VT, scrh, gw, NGW, lane);
#ifdef PROBE_TR
            transpose_cols(QKV, QKVP, 1024, 512, SEQ, BATCH, VT, scrh, gw, NGW, lane);
#endif
            transpose_cols(QKV, QKVP, 2560, 512, SEQ, BATCH, VT + (size_t)32 * MiB, scrh, gw, NGW, lane);
#ifdef PROBE_TR
            transpose_cols(QKV, QKVP, 2560, 512, SEQ, BATCH, VT + (size_t)32 * MiB, scrh, gw, NGW, lane);
#endif
        }
        PH_END
        GSYNC();
        if (l == 0) {
            const bf16_t* VaT = VT; const bf16_t* KmT = VT + (size_t)8 * MiB; const bf16_t* VmT = VT + (size_t)40 * MiB;
            (void)VaT; (void)KmT; (void)VmT;
#ifndef NO_MA
            PH_BEGIN mlstm_a2_phase(WCB, KmT, VmT, CST, NST, gw, NGW, r32, hi); PH_END
#ifdef PROBE_MA
            PH_BEGIN mlstm_a2_phase(WCB, KmT, VmT, CST, NST, gw, NGW, r32, hi); PH_END
#endif
#endif
            GSYNC();
            PH_BEGIN mlstm_scan_phase(CST, NST, SC, MST, gtid, nthreads); PH_END
            GSYNC();
#ifndef NO_MC
            PH_BEGIN mlstm_c2_phase(QKV, GPB, VmT, CST, NST, MST, args.in[10], Y, (LAS float*)(lds + wave * 20480), gw, NGW, lane, r32, hi); PH_END
#ifdef PROBE_MC
            PH_BEGIN mlstm_c2_phase(QKV, GPB, VmT, CST, NST, MST, args.in[10], Y, (LAS float*)(lds + wave * 20480), gw, NGW, lane, r32, hi); PH_END
#endif
#if defined(PROBE_B) || defined(PROBE_MLSTM)
            GSYNC();
            PH_BEGIN mlstm_a2_phase(WCB, KmT, VmT, CST, NST, gw, NGW, r32, hi); PH_END
            GSYNC();
            PH_BEGIN mlstm_scan_phase(CST, NST, SC, MST, gtid, nthreads); PH_END
            GSYNC();
            PH_BEGIN mlstm_c2_phase(QKV, GPB, VmT, CST, NST, MST, args.in[10], Y, (LAS float*)(lds + wave * 20480), gw, NGW, lane, r32, hi); PH_END
#endif
#endif
#ifndef NO_GQA
            PH_BEGIN gqa_phase(QKV, VaT, Y, args.in[9], ROPEC, ROPES, lds, tid, wave, r32, hi, Bx, Gd); PH_END
#ifdef PROBE_A
            __syncthreads();
            PH_BEGIN gqa_phase(QKV, VaT, Y, args.in[9], ROPEC, ROPES, lds, tid, wave, r32, hi, Bx, Gd); PH_END
#endif
#endif
        } else {
            const bf16_t* VcT = VT; const bf16_t* VdT = VT + (size_t)32 * MiB;
            (void)VcT; (void)VdT;
#ifndef NO_NA
            PH_BEGIN na_phase(QKV, VcT, Y, args.in[14], args.in[13], args.in[13] + 64, lds, tid, wave, r32, hi, Bx, Gd); PH_END
#if defined(PROBE_B) || defined(PROBE_NA)
            __syncthreads();
            PH_BEGIN na_phase(QKV, VcT, Y, args.in[14], args.in[13], args.in[13] + 64, lds, tid, wave, r32, hi, Bx, Gd); PH_END
#endif
#endif
#ifndef NO_DIFF
            const float lam_init = 0.8f - 0.6f * 0.7408182206817179f;
            PH_BEGIN diff_phase(QKV, VdT, Y, T5T, t5raw, args.in[16], args.in[17], args.in[15], lam_init, (float*)CST, lds, tid, wave, lane, r32, hi, Bx, Gd); PH_END
#ifdef PROBE_A
            __syncthreads();
            PH_BEGIN diff_phase(QKV, VdT, Y, T5T, t5raw, args.in[16], args.in[17], args.in[15], lam_init, (float*)CST, lds, tid, wave, lane, r32, hi, Bx, Gd); PH_END
#endif
#endif
        }
        GSYNC();
#ifndef NO_GEMM
        PH_BEGIN EpiResid E{l == 0 ? (const void*)x_in : (const void*)XB, l == 0 ? 0 : 1, XB, 1, DM, HN, args.in[4] + l * DM, RSB(l == 0 ? 0 : 3)}; run_gemm(lds, Y, (const bf16_t*)(WSP + (l == 0 ? WS_WOUT0 : WS_WOUT1)), MTOK, 1024, 1024, E, tid, Bx, Gd); PH_END
#endif
        GSYNC();
#ifndef NO_GEMM
        PH_BEGIN EpiBf16G E{QC, 512, nullptr, nullptr, 0, RSB(l == 0 ? 0 : 3)}; run_gemm(lds, HN, (const bf16_t*)(WSP + WS_WQ + l * MiB), MTOK, 512, 1024, E, tid, Bx, Gd); PH_END
#endif
        GSYNC();
#ifndef NO_CROSS
        PH_BEGIN cross_phase(QC, KVC(l), VTC(l), OC, args.in[21] + l * 256, lds, tid, wave, r32, hi, Bx, Gd); PH_END
#if defined(PROBE_B) || defined(PROBE_CROSS)
        __syncthreads();
        PH_BEGIN cross_phase(QC, KVC(l), VTC(l), OC, args.in[21] + l * 256, lds, tid, wave, r32, hi, Bx, Gd); PH_END
#endif
#endif
        GSYNC();
#ifndef NO_GEMM
        PH_BEGIN EpiResid E{XB, 1, l == 0 ? XB : XB2, 1, DM, HN, args.in[6] + l * DM, RSB(l == 0 ? 1 : 4)}; run_gemm(lds, OC, (const bf16_t*)(WSP + WS_WO + l * MiB), MTOK, 1024, 512, E, tid, Bx, Gd); PH_END
#endif
        GSYNC();
#ifndef NO_GEMM
        PH_BEGIN EpiConvAct E{ACT, SIDEB, args.in[24] + (size_t)l * 3 * 2 * DFF, args.in[25] + (size_t)l * 2 * DFF, RSB(l == 0 ? 1 : 4)};
                 run_gemm(lds, HN, (const bf16_t*)(WSP + WS_WUP + 11 * l * MiB), MTOK, 2 * DFF, 1024, E, tid, Bx, Gd); PH_END
#endif
        GSYNC();
#ifndef NO_GEMM
        PH_BEGIN EpiResid E{l == 0 ? XB : XB2, 1, l == 0 ? (void*)XB : (void*)out, l == 0 ? 1 : 0, DM, l == 0 ? HN : nullptr, args.in[3] + DM, RSB(2)};
                 run_gemm_fix(lds, ACT, (const bf16_t*)(WSP + WS_WDN + 6 * l * MiB), MTOK, 1024, DFF, E, tid, Bx, Gd, ACT, SIDEB, args.in[24] + (size_t)l * 3 * 2 * DFF, args.in[25] + (size_t)l * 2 * DFF); PH_END
#endif
        GSYNC();
    }
}

#undef WSP
#undef HN
#undef XB
#undef XB2
#undef GPB
#undef WCB
#undef RSB
#undef QKV
#undef VT
#undef Y
#undef CST
#undef Gt
#undef NST
#undef SC
#undef MST
#undef QC
#undef KVC
#undef VTC
#undef MEMN
#undef OC
#undef SIDEB
#undef ACT
#undef T5T
#undef ROPEC
#undef ROPES
#undef x_in
#undef mem
#undef t5raw
#undef out
extern "C" void kernel_launch(void* const* d_in, const int* in_sizes, int n_in, void* d_out, int out_size, void* d_ws, size_t ws_size, hipStream_t stream) {
    static int grid_blocks = 0;
    if (grid_blocks == 0) {
        int dev = 0, cus = 0, per_cu = 0;
        (void)hipGetDevice(&dev);
        (void)hipDeviceGetAttribute(&cus, hipDeviceAttributeMultiprocessorCount, dev);
        (void)hipFuncSetAttribute((const void*)fwd_megakernel, hipFuncAttributeMaxDynamicSharedMemorySize, LDS_BYTES);
        (void)hipOccupancyMaxActiveBlocksPerMultiprocessor(&per_cu, (const void*)fwd_megakernel, NTHR, LDS_BYTES);
        if (per_cu < 1) per_cu = 1;
        grid_blocks = cus * per_cu;
        if (n_in != 27 || ws_size < 1000 * MiB) fprintf(stderr, "kernel_launch: unexpected n_in %d / ws_size %zu\n", n_in, ws_size);
    }
    Args a{};
    for (int i = 0; i < 27; ++i) a.in[i] = (const float*)d_in[i];
    a.out = (float*)d_out; a.ws = (unsigned char*)d_ws;
    (void)hipMemsetAsync(d_ws, 0, 16384, stream);
    void* kargs[] = {&a};
    hipError_t e = hipLaunchCooperativeKernel((const void*)fwd_megakernel, dim3(grid_blocks), dim3(NTHR), kargs, LDS_BYTES, stream);
    if (e != hipSuccess) fprintf(stderr, "cooperative launch failed: %s (grid %d)\n", hipGetErrorString(e), grid_blocks);
}
```

```cpp
#include <hip/hip_runtime.h>
#include <hip/hip_cooperative_groups.h>
#include <cstdio>
#include <cstdint>
namespace cg = cooperative_groups;
namespace pg8 {
#define PG8_LAS __attribute__((address_space(3)))
typedef unsigned short bf16_t;
typedef short bf16x8 __attribute__((ext_vector_type(8)));
typedef float f32x4 __attribute__((ext_vector_type(4)));
typedef unsigned u32x4 __attribute__((ext_vector_type(4)));
constexpr int BM = 256, BK = 64, HALF = 128, HTB = HALF * BK * 2  , STAGE_BYTES = 8 * HTB, NXCD = 8, WGM = 8;

__host__ __device__ __forceinline__ int lds_byte(int r, int c) { const int st = (r >> 4) * 2 + (c >> 5), rr = r & 15, cc = c & 31, ob = rr * 64 + cc * 2; return st * 1024 + (ob ^ (((ob >> 9) & 1) << 5)); }
__host__ __device__ __forceinline__ void stage_rc(int b, int& R, int& C) { const int st = b / 1024, sb = b % 1024, swz = sb ^ (((sb >> 9) & 1) << 5); R = (st >> 1) * 16 + swz / 64; C = (st & 1) * 32 + (swz % 64) / 2; }
__host__ __device__ __forceinline__ int perm32(int rho) { const int n = rho >> 4, i = rho & 15; return 8 * (i >> 2) + 4 * n + (i & 3); }

struct Unit { int pm, pn; };
struct Gemm { const bf16_t* A; const bf16_t* Bt; int M, N, K; };

struct StaticOrder {
    int nM, nN, nwg, G, c;
    __host__ __device__ void init(int M, int N, int G_, int c_) { nM = M / BM; nN = N / BM; nwg = nM * nN; G = G_; c = c_; }
    __host__ __device__ bool next(int i, Unit& u) const {
        const long L = (long)i * G + c; if (L >= nwg) return false;
        int wgid = (int)L; { const int q = nwg / NXCD, r = nwg % NXCD, xcd = wgid % NXCD, off = wgid / NXCD; wgid = (xcd < r ? xcd * (q + 1) : r * (q + 1) + (xcd - r) * q) + off; }
        const int nig = WGM * nN, gid = wgid / nig, fm = gid * WGM, gsz = (nM - fm) < WGM ? (nM - fm) : WGM;
        u.pm = fm + ((wgid % nig) % gsz); u.pn = (wgid % nig) / gsz; return true;
    }
    __device__ __forceinline__ void a_ready(const Unit&) const {}
    __device__ __forceinline__ void done(const Unit&) const {}
};

__device__ __forceinline__ unsigned cvt_pk_bf16(float lo, float hi) { unsigned r; asm volatile("v_cvt_pk_bf16_f32 %0, %1, %2" : "=v"(r) : "v"(lo), "v"(hi)); return r; }
typedef float f32x2 __attribute__((ext_vector_type(2)));
template <class Epi, class Sched, bool ALIGN_EPI = false, bool SP2 = false>
__device__ __forceinline__ void gemm_phase(PG8_LAS unsigned char* lds, const Gemm g, const Sched& S, const Epi& E, int tid_in) {
    int tid_l = tid_in; asm volatile("" : "+v"(tid_l)); const int tid = tid_l, wid = __builtin_amdgcn_readfirstlane(tid >> 6), lane = tid & 63, wr = wid >> 2, wc = wid & 3, fr = lane & 15, fq = lane >> 4;
    const int K = g.K, nt = K / BK;
    unsigned voffA[2], voffB[2];
#pragma unroll
    for (int i = 0; i < 2; ++i) { int R, C; stage_rc(tid * 16 + i * 8192, R, C); const int Rb = Epi::PERM ? ((R & ~31) + perm32(R & 31)) : R;
        voffA[i] = (unsigned)(R * K + C) * 2u; voffB[i] = (unsigned)(Rb * K + C) * 2u; }
    const size_t kstep = (size_t)(BK * 2);
    const size_t hstep = (size_t)HALF * K * 2;
    const size_t tstep = 2 * hstep;
    const unsigned ldsw = (unsigned)wid * 1024u;
    const int aoff = lds_byte(wr * 64 + fr, fq * 8), boff = lds_byte(wc * 32 + fr, fq * 8);
#define PG8_SA(b, h) (((b) * 2 + (h)) * HTB)
#define PG8_SB(b, h) ((4 + (b) * 2 + (h)) * HTB)
#define PG8_STAGE(bufoff, gbase, voff) do { _Pragma("unroll") for (int _i = 0; _i < 2; ++_i) \
        __builtin_amdgcn_global_load_lds((const unsigned*)((const char*)(gbase) + (voff)[_i]), (PG8_LAS unsigned*)(lds + (bufoff) + ldsw + _i * 8192), 16, 0, 0); } while (0)
#define PG8_LDA(dst, b, h) do { _Pragma("unroll") for (int m = 0; m < 4; ++m) _Pragma("unroll") for (int k = 0; k < 2; ++k) dst[m][k] = *(const PG8_LAS bf16x8*)(lds + PG8_SA(b, h) + aoff + m * 2048 + k * 1024); } while (0)
#define PG8_LDB(dst, b, h) do { _Pragma("unroll") for (int n = 0; n < 2; ++n) _Pragma("unroll") for (int k = 0; k < 2; ++k) dst[n][k] = *(const PG8_LAS bf16x8*)(lds + PG8_SB(b, h) + boff + n * 2048 + k * 1024); } while (0)
#define PG8_MMA(ai, bj, At, Bt) do { __builtin_amdgcn_s_setprio(1); _Pragma("unroll") for (int m = 0; m < 4; ++m) _Pragma("unroll") for (int n = 0; n < 2; ++n) _Pragma("unroll") for (int k = 0; k < 2; ++k) \
        acc[ai][bj][m][n] = __builtin_amdgcn_mfma_f32_16x16x32_bf16(Bt[n][k], At[m][k], acc[ai][bj][m][n], 0, 0, 0); __builtin_amdgcn_s_setprio(0); } while (0)
#define PG8_WAIT_V(n) asm volatile("s_waitcnt vmcnt(" #n ")" ::: "memory")
#define PG8_WAIT_L(n) asm volatile("s_waitcnt lgkmcnt(" #n ")" ::: "memory")
#define PG8_BAR __builtin_amdgcn_s_barrier()
#define PG8_SCHED __builtin_amdgcn_sched_barrier(0)
    Unit cur, nxt; int ui = 0;
    if (!S.next(0, cur)) return;
    f32x4 acc[2][2][4][2];
#pragma unroll
    for (int a = 0; a < 2; ++a)
#pragma unroll
        for (int b = 0; b < 2; ++b)
#pragma unroll
            for (int m = 0; m < 4; ++m)
#pragma unroll
                for (int n = 0; n < 2; ++n) acc[a][b][m][n] = (f32x4){0.f, 0.f, 0.f, 0.f};
    bf16x8 At[4][2], B0[2][2], B1[2][2];
    const char* cA = (const char*)g.A + (size_t)cur.pm * tstep; const char* cB = (const char*)g.Bt + (size_t)cur.pn * tstep;
    S.a_ready(cur);
    if constexpr (SP2) {
        PG8_STAGE(PG8_SB(0, 0), cB, voffB); PG8_STAGE(PG8_SB(0, 1), cB + hstep, voffB); PG8_STAGE(PG8_SA(0, 0), cA, voffA); PG8_STAGE(PG8_SA(0, 1), cA + hstep, voffA);
        if (wr == 1) PG8_BAR;
        PG8_WAIT_V(2); PG8_BAR;
        PG8_STAGE(PG8_SB(1, 0), cB + kstep, voffB); PG8_STAGE(PG8_SA(1, 0), cA + kstep, voffA); PG8_STAGE(PG8_SB(1, 1), cB + hstep + kstep, voffB);
        PG8_WAIT_V(6); PG8_BAR;
    } else {
        PG8_STAGE(PG8_SB(0, 0), cB, voffB); PG8_STAGE(PG8_SA(0, 0), cA, voffA); PG8_STAGE(PG8_SB(0, 1), cB + hstep, voffB); PG8_STAGE(PG8_SA(0, 1), cA + hstep, voffA);
        if (wr == 1) PG8_BAR;
        PG8_WAIT_V(4); PG8_BAR;
        PG8_STAGE(PG8_SB(1, 0), cB + kstep, voffB); PG8_STAGE(PG8_SA(1, 0), cA + kstep, voffA); PG8_STAGE(PG8_SB(1, 1), cB + hstep + kstep, voffB);
        PG8_WAIT_V(6); PG8_BAR;
    }
    for (;;) {
        const bool has_next = S.next(ui + 1, nxt);
        const char* nA = has_next ? (const char*)g.A + (size_t)nxt.pm * tstep : cA; const char* nB = has_next ? (const char*)g.Bt + (size_t)nxt.pn * tstep : cB;
        for (int t = 0; t < nt; t += 2) {
            const bool last = (t == nt - 2);
            const char* a1 = cA + (size_t)(t + 1) * kstep;
            const char* a2 = last ? nA : cA + (size_t)(t + 2) * kstep; const char* b2 = last ? nB : cB + (size_t)(t + 2) * kstep;
            const char* a3 = a2 + kstep; const char* b3 = b2 + kstep;
            if (last && has_next) S.a_ready(nxt);
            if constexpr (SP2) {
            PG8_LDB(B0, 0, 0); PG8_LDB(B1, 0, 1); PG8_SCHED; PG8_LDA(At, 0, 0); PG8_STAGE(PG8_SA(1, 1), a1 + hstep, voffA);
            PG8_WAIT_V(8); PG8_WAIT_L(0); PG8_BAR; PG8_MMA(0, 0, At, B0); PG8_MMA(0, 1, At, B1); PG8_BAR; PG8_SCHED;
            PG8_LDA(At, 0, 1); PG8_STAGE(PG8_SB(0, 0), b2, voffB); PG8_STAGE(PG8_SB(0, 1), b2 + hstep, voffB); PG8_STAGE(PG8_SA(0, 0), a2, voffA);
            PG8_WAIT_V(8); PG8_WAIT_L(0); PG8_BAR; PG8_MMA(1, 0, At, B0); PG8_MMA(1, 1, At, B1); PG8_BAR; PG8_SCHED;
            PG8_LDB(B0, 1, 0); PG8_LDB(B1, 1, 1); PG8_SCHED; PG8_LDA(At, 1, 0); PG8_STAGE(PG8_SA(0, 1), a2 + hstep, voffA);
            PG8_WAIT_V(8); PG8_WAIT_L(0); PG8_BAR; PG8_MMA(0, 0, At, B0); PG8_MMA(0, 1, At, B1); PG8_BAR; PG8_SCHED;
            PG8_LDA(At, 1, 1); PG8_STAGE(PG8_SB(1, 0), b3, voffB); PG8_STAGE(PG8_SB(1, 1), b3 + hstep, voffB); PG8_STAGE(PG8_SA(1, 0), a3, voffA);
            PG8_WAIT_V(8); PG8_WAIT_L(0); PG8_BAR; PG8_MMA(1, 0, At, B0); PG8_MMA(1, 1, At, B1); PG8_BAR; PG8_SCHED;
            } else {
            PG8_LDB(B0, 0, 0); PG8_SCHED; PG8_LDA(At, 0, 0); PG8_STAGE(PG8_SA(1, 1), a1 + hstep, voffA);
            PG8_WAIT_L(8); PG8_BAR; PG8_WAIT_L(0); PG8_MMA(0, 0, At, B0); PG8_BAR; PG8_SCHED;
            PG8_LDB(B1, 0, 1); PG8_STAGE(PG8_SB(0, 0), b2, voffB);
            PG8_BAR; PG8_WAIT_L(0); PG8_MMA(0, 1, At, B1); PG8_BAR;
            PG8_LDA(At, 0, 1); PG8_STAGE(PG8_SA(0, 0), a2, voffA);
            PG8_BAR; PG8_WAIT_L(0); PG8_MMA(1, 0, At, B0); PG8_BAR; PG8_SCHED;
            PG8_STAGE(PG8_SB(0, 1), b2 + hstep, voffB);
            PG8_WAIT_V(6); PG8_BAR; PG8_MMA(1, 1, At, B1); PG8_BAR;
            PG8_LDB(B0, 1, 0); PG8_SCHED; PG8_LDA(At, 1, 0); PG8_STAGE(PG8_SA(0, 1), a2 + hstep, voffA);
            PG8_WAIT_L(8); PG8_BAR; PG8_WAIT_L(0); PG8_MMA(0, 0, At, B0); PG8_BAR; PG8_SCHED;
            PG8_LDB(B1, 1, 1); PG8_STAGE(PG8_SB(1, 0), b3, voffB);
            PG8_BAR; PG8_WAIT_L(0); PG8_MMA(0, 1, At, B1); PG8_BAR;
            PG8_LDA(At, 1, 1); PG8_STAGE(PG8_SA(1, 0), a3, voffA);
            PG8_BAR; PG8_WAIT_L(0); PG8_MMA(1, 0, At, B0); PG8_BAR; PG8_SCHED;
            PG8_STAGE(PG8_SB(1, 1), b3 + hstep, voffB);
            PG8_WAIT_V(6); PG8_BAR; PG8_MMA(1, 1, At, B1); PG8_BAR;
            }
        }
        if constexpr (ALIGN_EPI) { if (wr == 0) PG8_BAR; }
        if constexpr (!Epi::AFTER_DRAIN) { E(acc, cur, wr, wc, fr, fq); S.done(cur); }
        if (!has_next) break;
#pragma unroll
        for (int a = 0; a < 2; ++a)
#pragma unroll
            for (int b = 0; b < 2; ++b)
#pragma unroll
                for (int m = 0; m < 4; ++m)
#pragma unroll
                    for (int n = 0; n < 2; ++n) acc[a][b][m][n] = (f32x4){0.f, 0.f, 0.f, 0.f};
        cur = nxt; cA = nA; cB = nB; ++ui;
        if constexpr (ALIGN_EPI) { if (wr == 1) PG8_BAR; }
    }
    PG8_WAIT_V(0);
    if constexpr (!ALIGN_EPI) { if (wr == 0) PG8_BAR; }
    PG8_BAR;
    if constexpr (Epi::AFTER_DRAIN) { E.fused(acc, cur, wr, wc, fr, fq, lds, wid, lane); S.done(cur); }
#undef PG8_SA
#undef PG8_SB
#undef PG8_STAGE
#undef PG8_LDA
#undef PG8_LDB
#undef PG8_MMA
#undef PG8_WAIT_V
#undef PG8_WAIT_L
#undef PG8_BAR
#undef PG8_SCHED
}
}
#define LAS __attribute__((address_space(3)))
typedef unsigned short bf16_t;
typedef short bf16x8 __attribute__((ext_vector_type(8)));
typedef short s16x4 __attribute__((ext_vector_type(4)));
typedef float f32x16 __attribute__((ext_vector_type(16)));
typedef float f32x4 __attribute__((ext_vector_type(4)));
typedef float f32x2 __attribute__((ext_vector_type(2)));
typedef unsigned u32x4 __attribute__((ext_vector_type(4)));
typedef unsigned u32x2 __attribute__((ext_vector_type(2)));
typedef LAS unsigned char* ldsp_t;

constexpr int BATCH = 8, SEQ = 8192, DM = 1024, MTOK = BATCH * SEQ, MEMLEN = 256, DFF = 2816;
constexpr float EPS = 1e-6f, LOG2E = 1.4426950408889634f;
constexpr size_t MiB = 1ull << 20;
constexpr int NWAVES = 8, NTHR = 512;
constexpr int LDS_BYTES = 163840;
constexpr int QKVP = 3072;
constexpr size_t WS_WIN0 = 1 * MiB, WS_WOUT0 = 7 * MiB, WS_WIN1 = 9 * MiB, WS_WOUT1 = 15 * MiB, WS_WQ = 17 * MiB, WS_WKV = 19 * MiB, WS_WO = 23 * MiB,
                 WS_WUP = 25 * MiB, WS_WDN = 47 * MiB, WS_T5 = 59 * MiB, WS_ROPE = 59 * MiB + 512 * 1024;
constexpr size_t WS_HN = 64 * MiB;
constexpr size_t WS_QKV = 192 * MiB;
constexpr size_t WS_VT = 576 * MiB;
constexpr size_t WS_Y = 720 * MiB;
constexpr size_t WS_CST = 848 * MiB;
constexpr size_t WS_G = 976 * MiB, WS_NST = 980 * MiB, WS_SC = 982 * MiB, WS_MST = 983 * MiB;
constexpr size_t WS_QC = 192 * MiB, WS_OC = 272 * MiB, WS_KVC = 994 * MiB, WS_VTC = 1002 * MiB;
constexpr size_t WS_RS = 984 * MiB, WS_MEMN = 986 * MiB;
constexpr size_t WS_ACT = 192 * MiB, WS_SIDE = 544 * MiB;

struct Args { const float* in[27]; float* out; unsigned char* ws; };

#define GAS __attribute__((address_space(1)))
#define LDS_FENCE() asm volatile("s_waitcnt lgkmcnt(0)" ::: "memory")
__device__ __forceinline__ unsigned pk2(float lo, float hi) { typedef __bf16 b2 __attribute__((ext_vector_type(2))); f32x2 v = {lo, hi}; b2 b = __builtin_convertvector(v, b2); return __builtin_bit_cast(unsigned, b); }
__device__ __forceinline__ float bflo(unsigned w) { return __uint_as_float(w << 16); }
__device__ __forceinline__ float bfhi(unsigned w) { return __uint_as_float(w & 0xffff0000u); }
__device__ __forceinline__ float bf1(bf16_t v) { return __uint_as_float(((unsigned)v) << 16); }
__device__ __forceinline__ int lane_id() { int l; asm volatile("v_mbcnt_lo_u32_b32 %0, -1, 0\n\tv_mbcnt_hi_u32_b32 %0, -1, %0" : "=v"(l)); return l; }
__device__ __forceinline__ float bperm(float v, int src) { return __builtin_bit_cast(float, __builtin_amdgcn_ds_bpermute(src << 2, __builtin_bit_cast(int, v))); }
__device__ __forceinline__ float shx(float v, int o) { return bperm(v, lane_id() ^ o); }
__device__ __forceinline__ float shup(float v, int o) { const int l = lane_id(); return bperm(v, l >= o ? l - o : l); }
__device__ __forceinline__ float shdn(float v, int o) { const int l = lane_id(); return bperm(v, l + o < 64 ? l + o : l); }
__device__ __forceinline__ float shl_(float v, int k) { return bperm(v, k); }
__device__ __forceinline__ float wave_sum(float v) {
#pragma unroll
    for (int o = 1; o < 64; o <<= 1) v += shx(v, o);
    return v;
}
__device__ __forceinline__ float ex2(float x) { return __builtin_amdgcn_exp2f(x); }
__device__ __forceinline__ float logsig(float x) { return fminf(x, 0.f) - __logf(1.f + __expf(-fabsf(x))); }
__device__ __forceinline__ int crow(int r, int hi) { return (r & 3) + 8 * (r >> 2) + 4 * hi; }
__device__ __forceinline__ int clampi(int v, int lo, int hi) { return v < lo ? lo : (v > hi ? hi : v); }

struct EpiBf16G {
    static constexpr bool PERM = true, AFTER_DRAIN = false;
    bf16_t* O; int ldc; float* G; const float* gbias; int gcol0; const float* RS;
    __device__ __forceinline__ void operator()(const pg8::f32x4 (&acc)[2][2][4][2], const pg8::Unit& u, int wr, int wc, int fr, int fq) const {
        const int row0 = u.pm * 256 + wr * 64 + fr, col0 = u.pn * 256 + wc * 32 + 8 * fq;
#pragma unroll
        for (int ai = 0; ai < 2; ++ai)
#pragma unroll
            for (int m = 0; m < 4; ++m) {
                const size_t row = (size_t)(row0 + ai * 128 + m * 16);
                const float rstd = RS ? rsqrtf(RS[row] * (1.f / DM) + EPS) : 1.f;
#pragma unroll
                for (int bj = 0; bj < 2; ++bj) {
                    const int col = col0 + bj * 128;
                    const pg8::f32x4 v0 = acc[ai][bj][m][0] * rstd, v1 = acc[ai][bj][m][1] * rstd;
                    if (G != nullptr && col >= gcol0) {
                        if (col < gcol0 + 16) {
                            float* gp = G + row * 16 + (col - gcol0); const float* bp = gbias + (col - gcol0);
                            gp[0] = v0[0] + bp[0]; gp[1] = v0[1] + bp[1]; gp[2] = v0[2] + bp[2]; gp[3] = v0[3] + bp[3];
                            gp[4] = v1[0] + bp[4]; gp[5] = v1[1] + bp[5]; gp[6] = v1[2] + bp[6]; gp[7] = v1[3] + bp[7];
                        }
                    } else {
                        u32x4 w; w.x = pk2(v0[0], v0[1]); w.y = pk2(v0[2], v0[3]); w.z = pk2(v1[0], v1[1]); w.w = pk2(v1[2], v1[3]);
                        *(GAS u32x4*)(O + row * ldc + col) = w;
                    }
                }
            }
    }
};
struct EpiResid {
    static constexpr bool PERM = true, AFTER_DRAIN = false;
    const void* R; int r_bf; void* Out; int o_bf; int ldc; bf16_t* XG; const float* gain; float* RS;
    __device__ __forceinline__ void operator()(const pg8::f32x4 (&acc)[2][2][4][2], const pg8::Unit& u, int wr, int wc, int fr, int fq) const {
        const int row0 = u.pm * 256 + wr * 64 + fr, col0 = u.pn * 256 + wc * 32 + 8 * fq;
        pg8::f32x4 gv[2][2];
        if (XG) {
#pragma unroll
            for (int bj = 0; bj < 2; ++bj)
#pragma unroll
                for (int n = 0; n < 2; ++n) gv[bj][n] = *(const GAS pg8::f32x4*)(gain + col0 + bj * 128 + n * 4);
        }
#pragma unroll
        for (int ai = 0; ai < 2; ++ai)
#pragma unroll
            for (int m = 0; m < 4; ++m) {
                const int row = row0 + ai * 128 + m * 16;
                const size_t off = (size_t)row * ldc + col0;
                float ss = 0.f;
#pragma unroll
                for (int bj = 0; bj < 2; ++bj) {
                    const size_t o2 = off + bj * 128;
                    pg8::f32x4 r0, r1;
                    if (r_bf) { const u32x4 rw = *(const GAS u32x4*)((const bf16_t*)R + o2); r0 = (pg8::f32x4){bflo(rw.x), bfhi(rw.x), bflo(rw.y), bfhi(rw.y)}; r1 = (pg8::f32x4){bflo(rw.z), bfhi(rw.z), bflo(rw.w), bfhi(rw.w)}; }
                    else { r0 = *(const GAS pg8::f32x4*)((const float*)R + o2); r1 = *(const GAS pg8::f32x4*)((const float*)R + o2 + 4); }
                    const pg8::f32x4 v0 = r0 + acc[ai][bj][m][0], v1 = r1 + acc[ai][bj][m][1];
                    if (o_bf) { u32x4 w; w.x = pk2(v0[0], v0[1]); w.y = pk2(v0[2], v0[3]); w.z = pk2(v1[0], v1[1]); w.w = pk2(v1[2], v1[3]); *(GAS u32x4*)((bf16_t*)Out + o2) = w; }
                    else { *(GAS pg8::f32x4*)((float*)Out + o2) = v0; *(GAS pg8::f32x4*)((float*)Out + o2 + 4) = v1; }
                    if (XG) {
                        ss += ((v0[0] * v0[0] + v0[1] * v0[1]) + (v0[2] * v0[2] + v0[3] * v0[3])) + ((v1[0] * v1[0] + v1[1] * v1[1]) + (v1[2] * v1[2] + v1[3] * v1[3]));
                        const pg8::f32x4 g0 = gv[bj][0], g1 = gv[bj][1];
                        u32x4 w; w.x = pk2(v0[0] * g0[0], v0[1] * g0[1]); w.y = pk2(v0[2] * g0[2], v0[3] * g0[3]); w.z = pk2(v1[0] * g1[0], v1[1] * g1[1]); w.w = pk2(v1[2] * g1[2], v1[3] * g1[3]);
                        *(GAS u32x4*)(XG + o2) = w;
                    }
                }
                if (XG) {
                    ss += shx(ss, 16); ss += shx(ss, 32);
                    if (fq == 0) __hip_atomic_fetch_add(RS + row, ss, __ATOMIC_RELAXED, __HIP_MEMORY_SCOPE_AGENT);
                }
            }
    }
};
#ifndef RESID_ALIGN
#define RESID_ALIGN true
#endif
template <class Epi> struct EpiAlign { static constexpr bool value = true; };
template <> struct EpiAlign<EpiResid> { static constexpr bool value = RESID_ALIGN; };
template <class Epi> __device__ __forceinline__ void run_gemm(ldsp_t lds, const bf16_t* A, const bf16_t* Bt, int M, int N, int K, const Epi& E, int tid, int Bx, int Gd) {
    pg8::Gemm g{A, Bt, M, N, K}; pg8::StaticOrder S; S.init(M, N, Gd, Bx);
    pg8::gemm_phase<Epi, pg8::StaticOrder, EpiAlign<Epi>::value, true>(lds, g, S, E, tid);
}
template <int CTRL> __device__ __forceinline__ float dppf(float x) { return __builtin_bit_cast(float, __builtin_amdgcn_update_dpp(0, __builtin_bit_cast(int, x), CTRL, 0xf, 0xf, true)); }
struct EpiConvAct {
    static constexpr bool PERM = true, AFTER_DRAIN = false;
    bf16_t* ACT; float* SIDE; const float* cw; const float* cb; const float* RS;
    __device__ __forceinline__ void operator()(const pg8::f32x4 (&acc)[2][2][4][2], const pg8::Unit& u, int wr_, int wc_, int fr_, int fq_) const {
        int wr = wr_, wc = wc_, fr = fr_, fq = fq_; asm volatile("" : "+s"(wr), "+s"(wc), "+v"(fr), "+v"(fq));
        const int ch0 = u.pn * 128 + wc * 32 + 8 * fq;
#pragma unroll
        for (int ai = 0; ai < 2; ++ai) {
            const int rowb = u.pm * 256 + ai * 128 + wr * 64, slab = rowb >> 6;
            float rs[4], rsp[4], rsn[4];
#pragma unroll
            for (int m = 0; m < 4; ++m) rs[m] = rsqrtf(RS[rowb + 16 * m + fr] * (1.f / DM) + EPS);
            { float mir[4];
#pragma unroll
              for (int m = 0; m < 4; ++m) mir[m] = dppf<0x140>(rs[m]);
#pragma unroll
              for (int m = 0; m < 4; ++m) { const float a = dppf<0x111>(rs[m]), b = dppf<0x101>(rs[m]); rsp[m] = fr > 0 ? a : mir[m > 0 ? m - 1 : 0]; rsn[m] = fr < 15 ? b : mir[m < 3 ? m + 1 : 3]; } }
#pragma unroll
            for (int mm = 0; mm < 2; ++mm) {
                const int m = mm ? 3 : 0; const int k = mm ? (fr == 14 ? 2 : fr == 15 ? 3 : -1) : (fr == 0 ? 0 : fr == 1 ? 1 : -1);
                if (k >= 0) {
                    float* sp = SIDE + ((size_t)(slab * 4 + k) * 2) * DFF + ch0;
                    *(GAS pg8::f32x4*)sp = acc[ai][0][m][0] * rs[m]; *(GAS pg8::f32x4*)(sp + 4) = acc[ai][0][m][1] * rs[m];
                    *(GAS pg8::f32x4*)(sp + DFF) = acc[ai][1][m][0] * rs[m]; *(GAS pg8::f32x4*)(sp + DFF + 4) = acc[ai][1][m][1] * rs[m];
                }
            }
#pragma unroll
            for (int eh = 0; eh < 2; ++eh) {
                const int chh = ch0 + 4 * eh;
                const pg8::f32x4 W0g = *(const GAS pg8::f32x4*)(cw + chh), W1g = *(const GAS pg8::f32x4*)(cw + 2 * DFF + chh), W2g = *(const GAS pg8::f32x4*)(cw + 4 * DFF + chh), Bg = *(const GAS pg8::f32x4*)(cb + chh);
                const pg8::f32x4 W0v = *(const GAS pg8::f32x4*)(cw + DFF + chh), W1v = *(const GAS pg8::f32x4*)(cw + 3 * DFF + chh), W2v = *(const GAS pg8::f32x4*)(cw + 5 * DFF + chh), Bv = *(const GAS pg8::f32x4*)(cb + DFF + chh);
#pragma unroll
                for (int m = 0; m < 4; ++m) {
                    float r4[4];
#pragma unroll
                    for (int ei = 0; ei < 4; ++ei) {
                        const float xg = acc[ai][0][m][eh][ei], xv = acc[ai][1][m][eh][ei];
                        const float mgp = dppf<0x140>(acc[ai][0][m > 0 ? m - 1 : 0][eh][ei]), mgn = dppf<0x140>(acc[ai][0][m < 3 ? m + 1 : 3][eh][ei]);
                        const float mvp = dppf<0x140>(acc[ai][1][m > 0 ? m - 1 : 0][eh][ei]), mvn = dppf<0x140>(acc[ai][1][m < 3 ? m + 1 : 3][eh][ei]);
                        const float sg = dppf<0x111>(xg), lg = dppf<0x101>(xg), sv = dppf<0x111>(xv), lv = dppf<0x101>(xv);
                        const float pg_ = fr > 0 ? sg : mgp, ng_ = fr < 15 ? lg : mgn, pv_ = fr > 0 ? sv : mvp, nv_ = fr < 15 ? lv : mvn;
                        const float gte = Bg[ei] + W0g[ei] * (pg_ * rsp[m]) + W1g[ei] * (xg * rs[m]) + W2g[ei] * (ng_ * rsn[m]);
                        const float val = Bv[ei] + W0v[ei] * (pv_ * rsp[m]) + W1v[ei] * (xv * rs[m]) + W2v[ei] * (nv_ * rsn[m]);
                        r4[ei] = gte * __builtin_amdgcn_rcpf(1.f + ex2(-gte * LOG2E)) * val;
                    }
                    const int s_ = 16 * m + fr;
                    if (s_ != 0 && s_ != 63) { u32x2 o; o.x = pk2(r4[0], r4[1]); o.y = pk2(r4[2], r4[3]); *(GAS u32x2*)(ACT + (size_t)(rowb + s_) * DFF + chh) = o; }
                }
                asm volatile("" ::: "memory");
            }
        }
    }
};
__device__ __forceinline__ void ffn_fixup(int pm, bf16_t* ACT, const float* SIDE, const float* cw, const float* cb, int tid) {
    for (int idx = tid; idx < 8 * (DFF / 8); idx += NTHR) {
        const int ri = idx / (DFF / 8), ch = (idx % (DFF / 8)) * 8, slab = pm * 4 + (ri >> 1), last = ri & 1, row = slab * 64 + (last ? 63 : 0), t = row % SEQ;
        const float* sc = SIDE + ((size_t)(slab * 4 + (last ? 3 : 0)) * 2) * DFF + ch;
        const float* sp = last ? SIDE + ((size_t)(slab * 4 + 2) * 2) * DFF + ch : SIDE + ((size_t)((slab - 1) * 4 + 3) * 2) * DFF + ch;
        const float* sn = last ? SIDE + ((size_t)((slab + 1) * 4 + 0) * 2) * DFF + ch : SIDE + ((size_t)(slab * 4 + 1) * 2) * DFF + ch;
        const bool hp = last || t > 0, hn = !last || t < SEQ - 1;
        float r[8];
#pragma unroll
        for (int hlf = 0; hlf < 2; ++hlf) {
            const f32x4 z = {0.f, 0.f, 0.f, 0.f};
            const f32x4 cg = *(const GAS f32x4*)(sc + 4 * hlf), cv = *(const GAS f32x4*)(sc + DFF + 4 * hlf);
            const f32x4 pg_ = hp ? *(const GAS f32x4*)(sp + 4 * hlf) : z, pv_ = hp ? *(const GAS f32x4*)(sp + DFF + 4 * hlf) : z;
            const f32x4 ng_ = hn ? *(const GAS f32x4*)(sn + 4 * hlf) : z, nv_ = hn ? *(const GAS f32x4*)(sn + DFF + 4 * hlf) : z;
#pragma unroll
            for (int i = 0; i < 4; ++i) {
                const int c = ch + 4 * hlf + i;
                const float gte = cb[c] + cw[c] * pg_[i] + cw[2 * DFF + c] * cg[i] + cw[4 * DFF + c] * ng_[i];
                const float val = cb[DFF + c] + cw[DFF + c] * pv_[i] + cw[3 * DFF + c] * cv[i] + cw[5 * DFF + c] * nv_[i];
                r[4 * hlf + i] = gte / (1.f + __expf(-gte)) * val;
            }
        }
        u32x4 o; o.x = pk2(r[0], r[1]); o.y = pk2(r[2], r[3]); o.z = pk2(r[4], r[5]); o.w = pk2(r[6], r[7]);
        *(GAS u32x4*)(ACT + (size_t)row * DFF + ch) = o;
    }
}
template <class Epi> __device__ __forceinline__ void run_gemm_fix(ldsp_t lds, const bf16_t* A, const bf16_t* Bt, int M, int N, int K, const Epi& E, int tid, int Bx, int Gd,
                                                                  bf16_t* ACT, const float* SIDE, const float* cw, const float* cb) {
    pg8::Gemm g{A, Bt, M, N, K}; pg8::StaticOrder S; S.init(M, N, Gd, Bx);
    { pg8::Unit u; int last_pm = -1; for (int i = 0; S.next(i, u); ++i) { if (u.pm != last_pm) ffn_fixup(u.pm, ACT, SIDE, cw, cb, tid); last_pm = u.pm; } }
    asm volatile("s_waitcnt vmcnt(0)" ::: "memory"); __syncthreads();
    pg8::gemm_phase<Epi, pg8::StaticOrder, EpiAlign<Epi>::value, true>(lds, g, S, E, tid);
}
#define XB_TMO      128
#define XB_XCNT(j)  (256  + 64 * (j))
#define XB_XSUB(j)  (1280 + 64 * (j))
#define XB_XGEN(j)  (2304 + 64 * (j))
#define XB_TOP      3328
#define XB_TOPGEN   3392
#define XB_SPIN_CAP (1u << 20)
__device__ __forceinline__ unsigned xb_ld(unsigned* p)              { return __hip_atomic_load(p, __ATOMIC_RELAXED, __HIP_MEMORY_SCOPE_AGENT); }
__device__ __forceinline__ unsigned xb_add(unsigned* p, unsigned v) { return __hip_atomic_fetch_add(p, v, __ATOMIC_RELAXED, __HIP_MEMORY_SCOPE_AGENT); }
__device__ __forceinline__ unsigned xb_xcc_id() { return (unsigned)__builtin_amdgcn_s_getreg((3 << 11) | 20) & 0xFu; }
#define XB_SPIN(cond, bar) do { unsigned _sp = 0; while (cond) { __builtin_amdgcn_s_sleep(1); \
    if ((++_sp & 255u) == 0u) { if (xb_ld(&(bar)[XB_TMO])) break; if (_sp > XB_SPIN_CAP) { atomicAdd(&(bar)[XB_TMO], 1u); break; } } } } while (0)
__device__ __forceinline__ void xb_post(unsigned* bar, int wave_s) {
    if (wave_s == 0 && lane_id() == 0) (void)xb_add(&bar[XB_XCNT(xb_xcc_id())], 1u);
}
__device__ __forceinline__ void xb_complete(unsigned* bar, unsigned x, unsigned& nloc, unsigned& nx) {
    const unsigned G = gridDim.x;
    unsigned sum, cnt, mine, sp = 0u;
    for (;;) {
        sum = 0u; cnt = 0u; mine = 0u;
#pragma unroll
        for (unsigned j = 0; j < 16; ++j) { const unsigned c = xb_ld(&bar[XB_XCNT(j)]); sum += c; cnt += (c > 0u) ? 1u : 0u; mine = (j == x) ? c : mine; }
        if (sum == G) break;
        __builtin_amdgcn_s_sleep(1);
        if ((++sp & 255u) == 0u) { if (xb_ld(&bar[XB_TMO])) break; if (sp > XB_SPIN_CAP) { atomicAdd(&bar[XB_TMO], 1u); break; } }
    }
    nloc = mine > 0u ? mine : 1u; nx = cnt > 0u ? cnt : 1u;
}
__device__ __forceinline__ void gbar(unsigned* bar, volatile LAS unsigned* st, int wave_s) {
    asm volatile("s_waitcnt vmcnt(0) lgkmcnt(0)" ::: "memory");
    __syncthreads();
    if (wave_s == 0 && lane_id() == 0) {
        const unsigned x = xb_xcc_id();
        unsigned nloc = st[0], nx = st[1];
        if (nloc == 0u) { xb_complete(bar, x, nloc, nx); st[0] = nloc; st[1] = nx; }
        const unsigned old = xb_add(&bar[XB_XSUB(x)], 1u);
        const unsigned gen = old / nloc;
        if (old + 1u == (gen + 1u) * nloc) {
            __builtin_amdgcn_fence(__ATOMIC_RELEASE, "agent");
            asm volatile("s_waitcnt vmcnt(0)" ::: "memory");
            const unsigned og = xb_add(&bar[XB_TOP], 1u);
            const unsigned tg = og / nx;
            if (og + 1u == (tg + 1u) * nx) xb_add(&bar[XB_TOPGEN], 1u);
            else XB_SPIN(xb_ld(&bar[XB_TOPGEN]) == tg, bar);
            __builtin_amdgcn_fence(__ATOMIC_ACQUIRE, "agent");
            xb_add(&bar[XB_XGEN(x)], 1u);
            asm volatile("s_waitcnt vmcnt(0)" ::: "memory");
        } else {
            XB_SPIN(xb_ld(&bar[XB_XGEN(x)]) == gen, bar);
            __builtin_amdgcn_fence(__ATOMIC_ACQUIRE, "agent");
            asm volatile("s_waitcnt vmcnt(0)" ::: "memory");
        }
    }
    __syncthreads();
}

__device__ __forceinline__ int rowmap_up(int n) { const int ch = n < DFF ? n : n - DFF; return ((ch >> 7) << 8) + (n < DFF ? 0 : 128) + (ch & 127); }
__device__ __forceinline__ void wt_matrix(const float* W, int K, int N, bf16_t* WT, bool upmap, LAS float* scrf, int gw, int NGW, int lane, int& goff) {
    LAS bf16_t* scr = (LAS bf16_t*)scrf;
    const int nblk = (N + 63) / 64, nitems = (K / 64) * nblk;
    const int first = ((gw - goff) % NGW + NGW) % NGW; goff = (goff + nitems) % NGW;
    for (int item = first; item < nitems; item += NGW) {
        const int kb = item / nblk, nb = item % nblk, k0 = 64 * kb, n0 = 64 * nb;
        const int n4 = (lane & 15) * 4, kq = lane >> 4;
        f32x4 v[16];
#pragma unroll
        for (int i = 0; i < 16; ++i) { v[i] = (f32x4){0.f, 0.f, 0.f, 0.f}; if (n0 + n4 < N) v[i] = *(const GAS f32x4*)(W + (size_t)(k0 + 4 * i + kq) * N + n0 + n4); }
#pragma unroll
        for (int i = 0; i < 16; ++i) { LAS unsigned* d = (LAS unsigned*)(scr + (4 * i + kq) * 66 + n4); d[0] = pk2(v[i].x, v[i].y); d[1] = pk2(v[i].z, v[i].w); }
        LDS_FENCE();
        const int c = lane & 7;
#pragma unroll
        for (int j = 0; j < 8; ++j) {
            const int nl = (lane >> 3) + 8 * j, n = n0 + nl;
            const LAS bf16_t* s = scr + (8 * c) * 66 + nl;
            u32x4 o; o.x = (unsigned)s[0] | ((unsigned)s[66] << 16); o.y = (unsigned)s[132] | ((unsigned)s[198] << 16); o.z = (unsigned)s[264] | ((unsigned)s[330] << 16); o.w = (unsigned)s[396] | ((unsigned)s[462] << 16);
            if (n < N) { const int rr = upmap ? rowmap_up(n) : n; *(GAS u32x4*)(WT + (size_t)rr * K + k0 + 8 * c) = o; }
        }
        LDS_FENCE();
    }
}

__device__ __forceinline__ void rms_rows(const float* X, const float* gain, bf16_t* O, int nrows, int gw, int NGW, int lane) {
    for (int m = gw; m < nrows; m += NGW) {
        const GAS f32x4* xr = (const GAS f32x4*)(X + (size_t)m * DM) + lane;
        f32x4 v[4]; float s = 0.f;
#pragma unroll
        for (int j = 0; j < 4; ++j) { v[j] = xr[64 * j]; s += (v[j].x * v[j].x + v[j].y * v[j].y) + (v[j].z * v[j].z + v[j].w * v[j].w); }
        const float rstd = rsqrtf(wave_sum(s) * (1.f / DM) + EPS);
        GAS u32x2* o8 = (GAS u32x2*)(O + (size_t)m * DM) + lane;
#pragma unroll
        for (int j = 0; j < 4; ++j) { const f32x4 g = ((const f32x4*)gain)[lane + 64 * j]; u32x2 w; w.x = pk2(v[j].x * rstd * g.x, v[j].y * rstd * g.y); w.y = pk2(v[j].z * rstd * g.z, v[j].w * rstd * g.w); o8[64 * j] = w; }
    }
}

template <int GD, bool ROPE>
__device__ __forceinline__ void qknorm_rows(bf16_t* X, int pitch, int c0, int ncols, int nrows, int nq_cols, const float* gq, const float* gk, float sq, float sk,
                                            const float* ropeC, const float* ropeS, int gw, int NGW, int lane) {
    constexpr int LPG = GD / 8;
    const int nchunks = (ncols + 511) / 512;
    const int total = nrows * nchunks;
    for (int it0 = gw; it0 < total; it0 += 4 * NGW) {
      u32x4 raws[4];
#pragma unroll
      for (int j = 0; j < 4; ++j) {
          const int it = it0 + j * NGW; raws[j] = (u32x4){0u, 0u, 0u, 0u};
          if (it < total) { const int row = it / nchunks, ch = it % nchunks, c = ch * 512 + lane * 8; if (c < ncols) raws[j] = *(const GAS u32x4*)(X + (size_t)row * pitch + c0 + c); }
      }
#pragma unroll
      for (int j = 0; j < 4; ++j) {
        const int it = it0 + j * NGW; if (it >= total) break;
        const int row = it / nchunks, ch = it % nchunks;
        const int c = ch * 512 + lane * 8; const bool act = c < ncols;
        bf16_t* p = X + (size_t)row * pitch + c0 + c;
        const u32x4 raw = raws[j];
        float v[8]; v[0] = bflo(raw.x); v[1] = bfhi(raw.x); v[2] = bflo(raw.y); v[3] = bfhi(raw.y); v[4] = bflo(raw.z); v[5] = bfhi(raw.z); v[6] = bflo(raw.w); v[7] = bfhi(raw.w);
        float ss = 0.f;
#pragma unroll
        for (int i = 0; i < 8; ++i) ss += v[i] * v[i];
#pragma unroll
        for (int o = 1; o < LPG; o <<= 1) ss += shx(ss, o);
        const float rstd = rsqrtf(ss * (1.f / GD) + EPS);
        const bool isq = c < nq_cols; const float* g = (isq ? gq : gk) + (c % GD); const float sc = isq ? sq : sk;
        const f32x4 g0 = *(const f32x4*)g, g1 = *(const f32x4*)(g + 4);
        v[0] *= rstd * g0.x; v[1] *= rstd * g0.y; v[2] *= rstd * g0.z; v[3] *= rstd * g0.w; v[4] *= rstd * g1.x; v[5] *= rstd * g1.y; v[6] *= rstd * g1.z; v[7] *= rstd * g1.w;
        if (ROPE) {
            const int d = c & 63, half = d >> 5, dd = d & 31, t = row % SEQ, pos = half ? (t & 63) : (t >> 6), j0 = dd & 15; const bool second = dd >= 16;
#pragma unroll
            for (int i = 0; i < 8; ++i) {
                const float xp = shx(v[i], 2); const float cs = ropeC[pos * 16 + j0 + i], sn = ropeS[pos * 16 + j0 + i];
                v[i] = second ? (xp * sn + v[i] * cs) : (v[i] * cs - xp * sn);
            }
        }
        u32x4 o; o.x = pk2(v[0] * sc, v[1] * sc); o.y = pk2(v[2] * sc, v[3] * sc); o.z = pk2(v[4] * sc, v[5] * sc); o.w = pk2(v[6] * sc, v[7] * sc);
        if (act) *(GAS u32x4*)p = o;
      }
    }
}

__device__ __forceinline__ void transpose_cols(const bf16_t* X, int pitch, int c0, int C, int Sx, int nb, bf16_t* T, LAS bf16_t* scr, int gw, int NGW, int lane) {
    const int tt = Sx / 64, ct = C / 64, nitems = nb * tt * ct;
    for (int it = gw; it < nitems; it += NGW) {
        const int cti = it % ct, r = it / ct, tti = r % tt, b = r / tt;
        const bf16_t* src = X + (size_t)(b * Sx + tti * 64) * pitch + c0 + cti * 64;
#pragma unroll
        for (int i = 0; i < 8; ++i) {
            const int tok = 8 * i + (lane >> 3), chn = lane & 7;
            const u32x4 v = *(const GAS u32x4*)(src + (size_t)tok * pitch + chn * 8);
            LAS unsigned* d = (LAS unsigned*)(scr + tok * 66 + chn * 8);
            d[0] = v.x; d[1] = v.y; d[2] = v.z; d[3] = v.w;
        }
        LDS_FENCE();
#pragma unroll
        for (int i = 0; i < 8; ++i) {
            const int col = 8 * i + (lane >> 3), chn = lane & 7;
            const LAS bf16_t* s = scr + (chn * 8) * 66 + col;
            u32x4 o; o.x = (unsigned)s[0] | ((unsigned)s[66] << 16); o.y = (unsigned)s[132] | ((unsigned)s[198] << 16); o.z = (unsigned)s[264] | ((unsigned)s[330] << 16); o.w = (unsigned)s[396] | ((unsigned)s[462] << 16);
            *(GAS u32x4*)(T + (size_t)(b * C + cti * 64 + col) * Sx + tti * 64 + chn * 8) = o;
        }
        LDS_FENCE();
    }
}

__device__ __forceinline__ float bfsel(const u32x4& v, int i) { const unsigned w = i < 2 ? v.x : i < 4 ? v.y : i < 6 ? v.z : v.w; return (i & 1) ? bfhi(w) : bflo(w); }
__device__ __forceinline__ void conv_gate(const bf16_t* U, bf16_t* ACT, int nrows, const float* cw, const float* cb, int gtid, int nthreads) {
    constexpr int nchunk = DFF / 8, RB = 16;
    const int nitems = (nrows / RB) * nchunk;
    for (int idx = gtid; idx < nitems; idx += nthreads) {
        const int rb = idx / nchunk, chk = idx % nchunk, ch = chk * 8, row0 = rb * RB, t0 = row0 % SEQ;
        const int ucol = ((ch >> 7) << 8) + (ch & 127);
        float wg[3][8], wv[3][8], bg[8], bv[8];
#pragma unroll
        for (int j = 0; j < 3; ++j) {
            const f32x4 a0 = *(const GAS f32x4*)(cw + j * 2 * DFF + ch), a1 = *(const GAS f32x4*)(cw + j * 2 * DFF + ch + 4);
            const f32x4 c0 = *(const GAS f32x4*)(cw + j * 2 * DFF + DFF + ch), c1 = *(const GAS f32x4*)(cw + j * 2 * DFF + DFF + ch + 4);
#pragma unroll
            for (int i = 0; i < 4; ++i) { wg[j][i] = a0[i]; wg[j][4 + i] = a1[i]; wv[j][i] = c0[i]; wv[j][4 + i] = c1[i]; }
        }
        { const f32x4 a0 = *(const GAS f32x4*)(cb + ch), a1 = *(const GAS f32x4*)(cb + ch + 4), c0 = *(const GAS f32x4*)(cb + DFF + ch), c1 = *(const GAS f32x4*)(cb + DFF + ch + 4);
#pragma unroll
          for (int i = 0; i < 4; ++i) { bg[i] = a0[i]; bg[4 + i] = a1[i]; bv[i] = c0[i]; bv[4 + i] = c1[i]; } }
        const bf16_t* up = U + (size_t)row0 * (2 * DFF) + ucol;
        const u32x4 z = {0u, 0u, 0u, 0u};
        u32x4 gp = z, vp = z;
        if (t0 > 0) { gp = *(const GAS u32x4*)(up - 2 * DFF); vp = *(const GAS u32x4*)(up - 2 * DFF + 128); }
        u32x4 gc = *(const GAS u32x4*)up, vc = *(const GAS u32x4*)(up + 128);
#pragma unroll 4
        for (int rr = 0; rr < RB; ++rr) {
            u32x4 gn = z, vn = z;
            if (rr < RB - 1 || t0 + RB < SEQ) { gn = *(const GAS u32x4*)(up + (size_t)(rr + 1) * (2 * DFF)); vn = *(const GAS u32x4*)(up + (size_t)(rr + 1) * (2 * DFF) + 128); }
            float r[8];
#pragma unroll
            for (int i = 0; i < 8; ++i) {
                const float gte = bg[i] + bfsel(gp, i) * wg[0][i] + bfsel(gc, i) * wg[1][i] + bfsel(gn, i) * wg[2][i];
                const float val = bv[i] + bfsel(vp, i) * wv[0][i] + bfsel(vc, i) * wv[1][i] + bfsel(vn, i) * wv[2][i];
                r[i] = gte / (1.f + __expf(-gte)) * val;
            }
            u32x4 o; o.x = pk2(r[0], r[1]); o.y = pk2(r[2], r[3]); o.z = pk2(r[4], r[5]); o.w = pk2(r[6], r[7]);
            *(GAS u32x4*)(ACT + (size_t)(row0 + rr) * DFF + ch) = o;
            gp = gc; vp = vc; gc = gn; vc = vn;
        }
    }
}

#define MFMA32(a, b, c) __builtin_amdgcn_mfma_f32_32x32x16_bf16((a), (b), (c), 0, 0, 0)
constexpr int VSTR = 144, ATT_VOFF = 17408;
template <int DQK> __device__ __forceinline__ void tile_qk(f32x16& p0, f32x16& p1, const bf16x8* qf, const LAS unsigned char* Ks, int r32, int hi, float cinit) {
    constexpr int KSTR = (DQK + 8) * 2;
#pragma unroll
    for (int r = 0; r < 16; ++r) { p0[r] = cinit; p1[r] = cinit; }
    const int pr = (r32 & 0x13) | ((r32 & 4) << 1) | ((r32 & 8) >> 1);
    const LAS unsigned char* kb = Ks + pr * KSTR + hi * 16;
#pragma unroll
    for (int d0 = 0; d0 < DQK / 16; ++d0) {
        const bf16x8 a0 = *(const LAS bf16x8*)(kb + d0 * 32), a1 = *(const LAS bf16x8*)(kb + 32 * KSTR + d0 * 32);
        p0 = MFMA32(a0, qf[d0], p0); p1 = MFMA32(a1, qf[d0], p1);
    }
}
template <int DV> __device__ __forceinline__ void tile_softmax_pv(f32x16& p0, f32x16& p1, float& m, float& l, f32x16* o, const LAS unsigned char* Vts, int r32, int hi) {
    float mx = fmaxf(p0[0], p1[0]);
#pragma unroll
    for (int r = 1; r < 16; ++r) mx = fmaxf(mx, fmaxf(p0[r], p1[r]));
    mx = fmaxf(mx, shx(mx, 32));
    const float mn = fmaxf(m, mx), alpha = ex2(m - mn); m = mn;
    float s = 0.f;
#pragma unroll
    for (int r = 0; r < 16; ++r) { p0[r] = ex2(p0[r] - mn); p1[r] = ex2(p1[r] - mn); s += p0[r] + p1[r]; }
    l = l * alpha + s;
    if (__any(alpha != 1.0f)) {
#pragma unroll
        for (int d0 = 0; d0 < DV / 32; ++d0) o[d0] = o[d0] * alpha;
    }
    u32x4 w[4];
    w[0] = (u32x4){pk2(p0[0], p0[1]), pk2(p0[2], p0[3]), pk2(p0[4], p0[5]), pk2(p0[6], p0[7])};
    w[1] = (u32x4){pk2(p0[8], p0[9]), pk2(p0[10], p0[11]), pk2(p0[12], p0[13]), pk2(p0[14], p0[15])};
    w[2] = (u32x4){pk2(p1[0], p1[1]), pk2(p1[2], p1[3]), pk2(p1[4], p1[5]), pk2(p1[6], p1[7])};
    w[3] = (u32x4){pk2(p1[8], p1[9]), pk2(p1[10], p1[11]), pk2(p1[12], p1[13]), pk2(p1[14], p1[15])};
    const LAS unsigned char* vb = Vts + ((r32 & 0x13) | ((r32 & 4) << 1) | ((r32 & 8) >> 1)) * VSTR + hi * 16;
#pragma unroll
    for (int j = 0; j < 4; ++j) {
        const bf16x8 pb = __builtin_bit_cast(bf16x8, w[j]);
#pragma unroll
        for (int d0 = 0; d0 < DV / 32; ++d0) {
            const bf16x8 a = *(const LAS bf16x8*)(vb + d0 * 32 * VSTR + j * 32);
            o[d0] = MFMA32(a, pb, o[d0]);
        }
    }
}
template <int DV> __device__ __forceinline__ void tile_exp_pv(f32x16& p0, f32x16& p1, f32x16& oe, f32x16* o, const LAS unsigned char* Vts, int r32, int hi) {
#pragma unroll
    for (int r = 0; r < 16; ++r) { p0[r] = ex2(p0[r]); p1[r] = ex2(p1[r]); }
    u32x4 w[4];
    w[0] = (u32x4){pk2(p0[0], p0[1]), pk2(p0[2], p0[3]), pk2(p0[4], p0[5]), pk2(p0[6], p0[7])};
    w[1] = (u32x4){pk2(p0[8], p0[9]), pk2(p0[10], p0[11]), pk2(p0[12], p0[13]), pk2(p0[14], p0[15])};
    w[2] = (u32x4){pk2(p1[0], p1[1]), pk2(p1[2], p1[3]), pk2(p1[4], p1[5]), pk2(p1[6], p1[7])};
    w[3] = (u32x4){pk2(p1[8], p1[9]), pk2(p1[10], p1[11]), pk2(p1[12], p1[13]), pk2(p1[14], p1[15])};
    const u32x4 onesw = {0x3f803f80u, 0x3f803f80u, 0x3f803f80u, 0x3f803f80u};
    const bf16x8 ones = __builtin_bit_cast(bf16x8, onesw);
    const LAS unsigned char* vb = Vts + ((r32 & 0x13) | ((r32 & 4) << 1) | ((r32 & 8) >> 1)) * VSTR + hi * 16;
#pragma unroll
    for (int j = 0; j < 4; ++j) {
        const bf16x8 pb = __builtin_bit_cast(bf16x8, w[j]);
        oe = MFMA32(ones, pb, oe);
#pragma unroll
        for (int d0 = 0; d0 < DV / 32; ++d0) {
            const bf16x8 a = *(const LAS bf16x8*)(vb + d0 * 32 * VSTR + j * 32);
            o[d0] = MFMA32(a, pb, o[d0]);
        }
    }
}
template <int D> __device__ __forceinline__ float score_bound(const float* gq, const float* gk, int lane) {
    float a = fabsf(gq[lane & (D - 1)]), b = fabsf(gk[lane & (D - 1)]);
    if (D == 128) { a = fmaxf(a, fabsf(gq[64 + lane])); b = fmaxf(b, fabsf(gk[64 + lane])); }
#pragma unroll
    for (int o = 1; o < 64; o <<= 1) { a = fmaxf(a, shx(a, o)); b = fmaxf(b, shx(b, o)); }
    return (D == 64 ? 8.0f : 11.3137085f) * a * b * LOG2E * 1.02f;
}
template <int DQK, int DV> struct KVRegs { u32x4 k[DQK / 64]; u32x4 v[DV / 64]; };
template <int DQK, int DV> __device__ __forceinline__ void kv_load(KVRegs<DQK, DV>& R, const bf16_t* Kt, int kpitch, const bf16_t* Vt, int vtpitch, int tid) {
#pragma unroll
    for (int i = 0; i < DQK / 64; ++i) { const int ci = tid + 512 * i, row = ci / (DQK / 8), cc = ci % (DQK / 8); R.k[i] = *(const GAS u32x4*)(Kt + (size_t)row * kpitch + cc * 8); }
#pragma unroll
    for (int i = 0; i < DV / 64; ++i) { const int ci = tid + 512 * i, d = ci >> 3, cc = ci & 7; R.v[i] = *(const GAS u32x4*)(Vt + (size_t)d * vtpitch + cc * 8); }
}
template <int DQK, int DV> __device__ __forceinline__ void kv_store(const KVRegs<DQK, DV>& R, LAS unsigned char* Ks, LAS unsigned char* Vts, int tid) {
    constexpr int KSTR = (DQK + 8) * 2;
#pragma unroll
    for (int i = 0; i < DQK / 64; ++i) { const int ci = tid + 512 * i, row = ci / (DQK / 8), cc = ci % (DQK / 8); *(LAS u32x4*)(Ks + row * KSTR + cc * 16) = R.k[i]; }
#pragma unroll
    for (int i = 0; i < DV / 64; ++i) { const int ci = tid + 512 * i, d = ci >> 3, cc = ci & 7; *(LAS u32x4*)(Vts + d * VSTR + cc * 16) = R.v[i]; }
}
constexpr int ATT_BUF = 35840;
template <int DQK, int BIAS>
__device__ __forceinline__ void qk_biased(f32x16& p0, f32x16& p1, const bf16x8* qf, const LAS unsigned char* Ks, int t, int q0w, const float* tb, float cneg, float cpos, float sref, int r32, int hi) {
    float cinit = -sref; bool near = false;
    if (BIAS == 1) { const int lo = t * 64 - (q0w + 31), hh = t * 64 + 63 - q0w; if (hh <= -91) cinit = cneg; else if (lo >= 91) cinit = cpos; else near = true; }
    tile_qk<DQK>(p0, p1, qf, Ks, r32, hi, cinit);
    if (BIAS == 1 && near) {
        const GAS float* tq = (const GAS float*)(tb + (t * 64 + 8 * hi - (q0w + r32)));
#pragma unroll
        for (int r = 0; r < 16; ++r) { const int kk = 16 * (r >> 3) + (r & 7); p0[r] += tq[kk]; p1[r] += tq[kk + 32]; }
    }
}
template <int DQK, bool ROPE> __device__ __forceinline__ void qf_norm(bf16x8* qf, const float* qgain, float qscale, int hi, const float* ropeC, const float* ropeS, int prow, int pcol) {
    float v[DQK / 16][8]; float ss = 0.f;
#pragma unroll
    for (int d0 = 0; d0 < DQK / 16; ++d0) { const u32x4 w = __builtin_bit_cast(u32x4, qf[d0]);
        v[d0][0] = bflo(w.x); v[d0][1] = bfhi(w.x); v[d0][2] = bflo(w.y); v[d0][3] = bfhi(w.y); v[d0][4] = bflo(w.z); v[d0][5] = bfhi(w.z); v[d0][6] = bflo(w.w); v[d0][7] = bfhi(w.w);
#pragma unroll
        for (int i = 0; i < 8; ++i) ss += v[d0][i] * v[d0][i]; }
    ss += shx(ss, 32);
    const float rs = rsqrtf(ss * (1.f / DQK) + EPS);
#pragma unroll
    for (int d0 = 0; d0 < DQK / 16; ++d0) { const f32x4 g0 = *(const f32x4*)(qgain + d0 * 16 + hi * 8), g1 = *(const f32x4*)(qgain + d0 * 16 + hi * 8 + 4);
        v[d0][0] *= rs * g0.x; v[d0][1] *= rs * g0.y; v[d0][2] *= rs * g0.z; v[d0][3] *= rs * g0.w; v[d0][4] *= rs * g1.x; v[d0][5] *= rs * g1.y; v[d0][6] *= rs * g1.z; v[d0][7] *= rs * g1.w; }
    if constexpr (ROPE && DQK == 64) {
#pragma unroll
        for (int hf = 0; hf < 2; ++hf) {
            const float* cp = ropeC + (hf ? pcol : prow) * 16 + 8 * hi; const float* sp = ropeS + (hf ? pcol : prow) * 16 + 8 * hi;
            const f32x4 c0 = *(const f32x4*)cp, c1 = *(const f32x4*)(cp + 4), s0 = *(const f32x4*)sp, s1 = *(const f32x4*)(sp + 4);
#pragma unroll
            for (int i = 0; i < 8; ++i) { const float cs = i < 4 ? c0[i & 3] : c1[i & 3], sn = i < 4 ? s0[i & 3] : s1[i & 3]; const float t1 = v[2 * hf][i], t2 = v[2 * hf + 1][i];
                v[2 * hf][i] = t1 * cs - t2 * sn; v[2 * hf + 1][i] = t1 * sn + t2 * cs; }
        }
    }
#pragma unroll
    for (int d0 = 0; d0 < DQK / 16; ++d0) { u32x4 r; r.x = pk2(v[d0][0] * qscale, v[d0][1] * qscale); r.y = pk2(v[d0][2] * qscale, v[d0][3] * qscale); r.z = pk2(v[d0][4] * qscale, v[d0][5] * qscale); r.w = pk2(v[d0][6] * qscale, v[d0][7] * qscale);
        qf[d0] = __builtin_bit_cast(bf16x8, r); }
}
template <int DQK, int DV, int BIAS, bool PIPE, bool FIXED>
__device__ __forceinline__ void attn_pass(const bf16_t* Qw, int qpitch, const bf16_t* Kb, int kpitch, const bf16_t* Vtb, int vtpitch, int ntiles,
                                          int q0w, const float* tb, float cneg, float cpos, ldsp_t lds, float& m, float& l, f32x16* o, int tid, int r32, int hi,
                                          const float* qgain = nullptr, float qscale = 1.f, const float* ropeC = nullptr, const float* ropeS = nullptr, int qprow = 0, int qpcol = 0) {
    bf16x8 qf[DQK / 16];
#pragma unroll
    for (int d0 = 0; d0 < DQK / 16; ++d0) qf[d0] = *(const GAS bf16x8*)(Qw + (size_t)r32 * qpitch + d0 * 16 + hi * 8);
    if (qgain) { if (ropeC) qf_norm<DQK, true>(qf, qgain, qscale, hi, ropeC, ropeS, qprow, qpcol); else qf_norm<DQK, false>(qf, qgain, qscale, hi, nullptr, nullptr, 0, 0); }
    const float sref = FIXED ? m : 0.f;
    if (FIXED) { cneg -= sref; cpos -= sref; }
    m = -1e30f; l = 0.f;
#pragma unroll
    for (int d0 = 0; d0 < DV / 32; ++d0)
#pragma unroll
        for (int r = 0; r < 16; ++r) o[d0][r] = 0.f;
    f32x16 oe;
#pragma unroll
    for (int r = 0; r < 16; ++r) oe[r] = 0.f;
    KVRegs<DQK, DV> R; kv_load<DQK, DV>(R, Kb, kpitch, Vtb, vtpitch, tid);
    __syncthreads();
    kv_store<DQK, DV>(R, lds, lds + ATT_VOFF, tid);
    if (ntiles > 1) kv_load<DQK, DV>(R, Kb + (size_t)64 * kpitch, kpitch, Vtb + 64, vtpitch, tid);
    __syncthreads();
    int cur = 0;
    if constexpr (PIPE) {
    f32x16 pa0, pa1, pb0, pb1;
    qk_biased<DQK, BIAS>(pa0, pa1, qf, lds, 0, q0w, tb, cneg, cpos, sref, r32, hi);
#define ATT_STEP(P0, P1, N0, N1, T) do { \
        const int t_ = (T); const int nxt = cur == 2 * ATT_BUF ? 0 : cur + ATT_BUF; \
        if (t_ + 1 < ntiles) kv_store<DQK, DV>(R, lds + nxt, lds + nxt + ATT_VOFF, tid); \
        __syncthreads(); \
        if (t_ + 2 < ntiles) kv_load<DQK, DV>(R, Kb + (size_t)(t_ + 2) * 64 * kpitch, kpitch, Vtb + (t_ + 2) * 64, vtpitch, tid); \
        if (t_ + 1 < ntiles) qk_biased<DQK, BIAS>(N0, N1, qf, lds + nxt, t_ + 1, q0w, tb, cneg, cpos, sref, r32, hi); \
        if constexpr (FIXED) tile_exp_pv<DV>(P0, P1, oe, o, lds + cur + ATT_VOFF, r32, hi); else tile_softmax_pv<DV>(P0, P1, m, l, o, lds + cur + ATT_VOFF, r32, hi); \
        cur = nxt; } while (0)
#pragma nounroll
    for (int t = 0; t < ntiles; t += 2) {
        ATT_STEP(pa0, pa1, pb0, pb1, t);
        ATT_STEP(pb0, pb1, pa0, pa1, t + 1);
    }
#undef ATT_STEP
    } else {
#pragma nounroll
    for (int t = 0; t < ntiles; ++t) {
        const int nxt = cur == 2 * ATT_BUF ? 0 : cur + ATT_BUF;
        if (t + 1 < ntiles) kv_store<DQK, DV>(R, lds + nxt, lds + nxt + ATT_VOFF, tid);
        __syncthreads();
        if (t + 2 < ntiles) kv_load<DQK, DV>(R, Kb + (size_t)(t + 2) * 64 * kpitch, kpitch, Vtb + (t + 2) * 64, vtpitch, tid);
        f32x16 p0, p1;
        qk_biased<DQK, BIAS>(p0, p1, qf, lds + cur, t, q0w, tb, cneg, cpos, sref, r32, hi);
        if constexpr (FIXED) tile_exp_pv<DV>(p0, p1, oe, o, lds + cur + ATT_VOFF, r32, hi); else tile_softmax_pv<DV>(p0, p1, m, l, o, lds + cur + ATT_VOFF, r32, hi);
        cur = nxt;
    }
    }
    if constexpr (FIXED) l = 0.5f * oe[0];
}
template <int DV> __device__ __forceinline__ void store_o(const f32x16* o, float inv, bf16_t* Ow, int opitch, int r32, int hi) {
#pragma unroll
    for (int d0 = 0; d0 < DV / 32; ++d0)
#pragma unroll
        for (int j = 0; j < 2; ++j) {
            u32x4 w; w.x = pk2(o[d0][8 * j] * inv, o[d0][8 * j + 1] * inv); w.y = pk2(o[d0][8 * j + 2] * inv, o[d0][8 * j + 3] * inv);
            w.z = pk2(o[d0][8 * j + 4] * inv, o[d0][8 * j + 5] * inv); w.w = pk2(o[d0][8 * j + 6] * inv, o[d0][8 * j + 7] * inv);
            *(GAS u32x4*)(Ow + (size_t)r32 * opitch + 32 * d0 + 16 * j + 8 * hi) = w;
        }
}
__device__ __forceinline__ int vcu_of(int bx, int G) { return (G % 8 == 0) ? (bx % 8) * (G / 8) + bx / 8 : bx; }

__device__ __forceinline__ void gqa_phase(const bf16_t* QKV, const bf16_t* VaT, bf16_t* Y, const float* gqk, const float* ropeC, const float* ropeS, ldsp_t lds, int tid, int wave, int r32, int hi, int Bx, int Gd) {
    const int G = Gd, vcu = vcu_of(Bx, G);
    const float sref = score_bound<64>(gqk, gqk + 64, tid & 63);
    for (int u = vcu; u < BATCH * 8 * 32; u += G) {
        const int qt = u & 31, hq = (u >> 5) & 3, kvh = (u >> 7) & 1, b = u >> 8, hqf = kvh * 4 + hq;
        const size_t row0 = (size_t)b * SEQ + qt * 256 + wave * 32;
        float m = sref, l; f32x16 o[2];
        if (sref < 40.f) attn_pass<64, 64, 0, true, true>(QKV + row0 * QKVP + hqf * 64, QKVP, QKV + (size_t)b * SEQ * QKVP + 512 + kvh * 64, QKVP, VaT + (size_t)((b * 2 + kvh) * 64) * SEQ, SEQ, SEQ / 64,
                             0, nullptr, 0.f, 0.f, lds, m, l, o, tid, r32, hi, gqk, 0.125f * LOG2E, ropeC, ropeS, (qt * 256 + wave * 32 + r32) >> 6, (wave * 32 + r32) & 63);
        else attn_pass<64, 64, 0, false, false>(QKV + row0 * QKVP + hqf * 64, QKVP, QKV + (size_t)b * SEQ * QKVP + 512 + kvh * 64, QKVP, VaT + (size_t)((b * 2 + kvh) * 64) * SEQ, SEQ, SEQ / 64,
                             0, nullptr, 0.f, 0.f, lds, m, l, o, tid, r32, hi, gqk, 0.125f * LOG2E, ropeC, ropeS, (qt * 256 + wave * 32 + r32) >> 6, (wave * 32 + r32) & 63);
        l += shx(l, 32);
        store_o<64>(o, 1.f / l, Y + row0 * DM + hqf * 64, DM, r32, hi);
    }
}
__device__ __forceinline__ void cross_phase(const bf16_t* QC, const bf16_t* KVC, const bf16_t* VTC, bf16_t* OC, const float* gqk, ldsp_t lds, int tid, int wave, int r32, int hi, int Bx, int Gd) {
    const int G = Gd, vcu = vcu_of(Bx, G);
    const float sref = score_bound<128>(gqk, gqk + 128, tid & 63);
    for (int u = vcu; u < BATCH * 4 * 32; u += G) {
        const int qt = u & 31, h = (u >> 5) & 3, b = u >> 7;
        const size_t row0 = (size_t)b * SEQ + qt * 256 + wave * 32;
        float m = sref, l; f32x16 o[4];
        if (sref < 40.f) attn_pass<128, 128, 0, false, true>(QC + row0 * 512 + h * 128, 512, KVC + (size_t)b * MEMLEN * 1024 + h * 128, 1024, VTC + (size_t)((b * 4 + h) * 128) * MEMLEN, MEMLEN, MEMLEN / 64,
                               0, nullptr, 0.f, 0.f, lds, m, l, o, tid, r32, hi, gqk, 0.08838834764831845f * LOG2E);
        else attn_pass<128, 128, 0, false, false>(QC + row0 * 512 + h * 128, 512, KVC + (size_t)b * MEMLEN * 1024 + h * 128, 1024, VTC + (size_t)((b * 4 + h) * 128) * MEMLEN, MEMLEN, MEMLEN / 64,
                               0, nullptr, 0.f, 0.f, lds, m, l, o, tid, r32, hi, gqk, 0.08838834764831845f * LOG2E);
        l += shx(l, 32);
        store_o<128>(o, 1.f / l, OC + row0 * 512 + h * 128, 512, r32, hi);
    }
}
__device__ __forceinline__ void diff_phase(const bf16_t* QKV, const bf16_t* VdT, bf16_t* Y, const float* t5tab, const float* t5raw, const float* lamv, const float* dgain, const float* gqk, float lam_init,
                                           float* stash, ldsp_t lds, int tid, int wave, int lane, int r32, int hi, int Bx, int Gd) {
    const int G = Gd, vcu = vcu_of(Bx, G);
    f32x4* st = (f32x4*)(stash + ((size_t)(Bx * NWAVES + wave) * 64 + lane) * 64);
    float bmax = fmaxf(fabsf(t5raw[lane]), fabsf(t5raw[64 + lane]));
#pragma unroll
    for (int o = 1; o < 64; o <<= 1) bmax = fmaxf(bmax, shx(bmax, o));
    const float sref = score_bound<64>(gqk, gqk + 64, lane) + bmax * LOG2E;
    const float lam = __expf(wave_sum(lamv[lane] * lamv[64 + lane])) - __expf(wave_sum(lamv[128 + lane] * lamv[192 + lane])) + lam_init;
    for (int u = vcu; u < BATCH * 4 * 32; u += G) {
        const int qt = u & 31, h = (u >> 5) & 3, b = u >> 7;
        const int q0w = qt * 256 + wave * 32; const size_t row0 = (size_t)b * SEQ + q0w;
        const float cneg = t5raw[15 * 4 + h] * LOG2E, cpos = t5raw[31 * 4 + h] * LOG2E; const float* tb = t5tab + h * 16384 + 8192;
        const bf16_t* Kb = QKV + (size_t)b * SEQ * QKVP + 2048 + h * 128; const bf16_t* Vt = VdT + (size_t)((b * 4 + h) * 128) * SEQ;
        float m, l; f32x16 o1[4];
        { f32x16 o2[4];
          m = sref;
          if (sref < 40.f) attn_pass<64, 128, 1, false, true>(QKV + row0 * QKVP + 1536 + h * 128 + 64, QKVP, Kb + 64, QKVP, Vt, SEQ, SEQ / 64, q0w, tb, cneg, cpos, lds, m, l, o2, tid, r32, hi, gqk, 0.125f * LOG2E);
          else attn_pass<64, 128, 1, false, false>(QKV + row0 * QKVP + 1536 + h * 128 + 64, QKVP, Kb + 64, QKVP, Vt, SEQ, SEQ / 64, q0w, tb, cneg, cpos, lds, m, l, o2, tid, r32, hi, gqk, 0.125f * LOG2E);
          l += shx(l, 32);
          const float inv = lam / l;
#pragma unroll
          for (int d0 = 0; d0 < 4; ++d0)
#pragma unroll
              for (int g = 0; g < 4; ++g) st[d0 * 4 + g] = (f32x4){o2[d0][4 * g] * inv, o2[d0][4 * g + 1] * inv, o2[d0][4 * g + 2] * inv, o2[d0][4 * g + 3] * inv}; }
        asm volatile("" ::: "memory");
        m = sref;
        if (sref < 40.f) attn_pass<64, 128, 1, false, true>(QKV + row0 * QKVP + 1536 + h * 128, QKVP, Kb, QKVP, Vt, SEQ, SEQ / 64, q0w, tb, cneg, cpos, lds, m, l, o1, tid, r32, hi, gqk, 0.125f * LOG2E);
        else attn_pass<64, 128, 1, false, false>(QKV + row0 * QKVP + 1536 + h * 128, QKVP, Kb, QKVP, Vt, SEQ, SEQ / 64, q0w, tb, cneg, cpos, lds, m, l, o1, tid, r32, hi, gqk, 0.125f * LOG2E);
        l += shx(l, 32);
        float ss = 0.f;
        { const float inv = 1.f / l;
#pragma unroll
          for (int d0 = 0; d0 < 4; ++d0)
#pragma unroll
              for (int g = 0; g < 4; ++g) { const f32x4 sv = st[d0 * 4 + g];
#pragma unroll
                  for (int e = 0; e < 4; ++e) { const float v = o1[d0][4 * g + e] * inv - sv[e]; o1[d0][4 * g + e] = v; ss += v * v; } } }
        asm volatile("" ::: "memory");
        ss += shx(ss, 32);
        const float rstd = rsqrtf(ss * (1.f / 128.f) + EPS) * (1.f - lam_init);
        bf16_t* Ow = Y + row0 * DM + 512 + h * 128;
#pragma unroll
        for (int d0 = 0; d0 < 4; ++d0)
#pragma unroll
            for (int j = 0; j < 2; ++j) {
                const int d = 32 * d0 + 16 * j + 8 * hi; const f32x4 g0 = *(const f32x4*)(dgain + h * 128 + d), g1 = *(const f32x4*)(dgain + h * 128 + d + 4);
                u32x4 w; w.x = pk2(o1[d0][8 * j] * rstd * g0.x, o1[d0][8 * j + 1] * rstd * g0.y); w.y = pk2(o1[d0][8 * j + 2] * rstd * g0.z, o1[d0][8 * j + 3] * rstd * g0.w);
                w.z = pk2(o1[d0][8 * j + 4] * rstd * g1.x, o1[d0][8 * j + 5] * rstd * g1.y); w.w = pk2(o1[d0][8 * j + 6] * rstd * g1.z, o1[d0][8 * j + 7] * rstd * g1.w);
                *(GAS u32x4*)(Ow + (size_t)r32 * DM + d) = w;
            }
    }
}
__device__ __forceinline__ void na_phase(const bf16_t* QKV, const bf16_t* VcT, bf16_t* Y, const float* rpb, const float* gq, const float* gk, ldsp_t lds, int tid, int wave, int r32, int hi, int Bx, int Gd) {
    const int G = Gd, vcu = vcu_of(Bx, G);
    LAS unsigned char* Ks = lds; LAS unsigned char* Vts = lds + ATT_VOFF; LAS float* rpl = (LAS float*)(lds + 3 * ATT_BUF);
    float bmax = 0.f;
    for (int i = (tid & 63); i < 8 * 465; i += 64) bmax = fmaxf(bmax, fabsf(rpb[i]));
#pragma unroll
    for (int o_ = 1; o_ < 64; o_ <<= 1) bmax = fmaxf(bmax, shx(bmax, o_));
    const float sref = score_bound<64>(gq, gk, tid & 63) + bmax * LOG2E;
    const bool fast = sref < 40.f;
    for (int u = vcu; u < BATCH * 8 * 32; u += G) {
        const int rg = u & 31, h = (u >> 5) & 7, b = u >> 8;
        const int R0 = 4 * rg, Rw = R0 + (wave >> 1), qc = 32 * (wave & 1) + r32;
        const int r0w = clampi(Rw - 4, 0, 120), ulo = clampi(R0 - 4, 0, 120), uhi = clampi(R0 - 1, 0, 120) + 7, nt = uhi - ulo + 1;
        const int c0 = clampi(qc - 8, 0, 48);
        __syncthreads();
        if (tid < 465) rpl[tid] = rpb[h * 465 + tid] * LOG2E;
        const size_t row0 = (size_t)b * SEQ + Rw * 64 + 32 * (wave & 1);
        const bf16_t* Qw = QKV + row0 * QKVP + h * 64;
        const bf16_t* Kb = QKV + ((size_t)b * SEQ + ulo * 64) * QKVP + 512 + h * 64;
        const bf16_t* Vtb = VcT + (size_t)((b * 8 + h) * 64) * SEQ + ulo * 64;
        bf16x8 qf[4];
#pragma unroll
        for (int d0 = 0; d0 < 4; ++d0) qf[d0] = *(const GAS bf16x8*)(Qw + (size_t)r32 * QKVP + d0 * 16 + hi * 8);
        qf_norm<64, false>(qf, gq, 0.125f * LOG2E, hi, nullptr, nullptr, 0, 0);
        float m = -1e30f, l = 0.f; f32x16 o[2], oe;
#pragma unroll
        for (int r = 0; r < 16; ++r) oe[r] = 0.f;
#pragma unroll
        for (int d0 = 0; d0 < 2; ++d0)
#pragma unroll
            for (int r = 0; r < 16; ++r) o[d0][r] = 0.f;
        KVRegs<64, 64> R; kv_load<64, 64>(R, Kb, QKVP, Vtb, SEQ, tid);
        for (int t = 0; t < nt; ++t) {
            __syncthreads();
            kv_store<64, 64>(R, Ks, Vts, tid);
            __syncthreads();
            if (t + 1 < nt) kv_load<64, 64>(R, Kb + (size_t)(t + 1) * 64 * QKVP, QKVP, Vtb + (t + 1) * 64, SEQ, tid);
            const int kr = ulo + t;
            if (kr >= r0w && kr < r0w + 8) {
                f32x16 p0, p1; tile_qk<64>(p0, p1, qf, Ks, r32, hi, fast ? -sref : 0.f);
                const LAS float* rp = rpl + (kr - Rw + 7) * 31 + 15 - qc;
#pragma unroll
                for (int r = 0; r < 16; ++r) {
                    const int kc = 16 * (r >> 3) + (r & 7) + 8 * hi, kc2 = kc + 32;
                    p0[r] = (kc >= c0 && kc < c0 + 16) ? p0[r] + rp[kc] : -1e30f;
                    p1[r] = (kc2 >= c0 && kc2 < c0 + 16) ? p1[r] + rp[kc2] : -1e30f;
                }
                if (fast) tile_exp_pv<64>(p0, p1, oe, o, Vts, r32, hi); else tile_softmax_pv<64>(p0, p1, m, l, o, Vts, r32, hi);
            }
        }
        l += shx(l, 32); if (fast) l = oe[0];
        store_o<64>(o, 1.f / l, Y + row0 * DM + h * 64, DM, r32, hi);
    }
}

constexpr float KSCALE = 0.08838834764831845f;
__device__ __forceinline__ void mlstm_a_phase(const float* Gt, const bf16_t* KmT, const bf16_t* VmT, bf16_t* CST, float* NST, float* SC, ldsp_t lds, int tid, int wave, int r32, int hi, int Bx, int Gd) {
    LAS float* fl = (LAS float*)lds; LAS float* ab = fl + 128; LAS float* wv = fl + 256;
    for (int u = Bx; u < BATCH * 4 * 64 * 2; u += Gd) {
        const int dir = u & 1, c = (u >> 1) & 63, h = (u >> 7) & 3, b = u >> 9, chain = (b * 4 + h) * 2 + dir;
        const size_t tok0 = (size_t)b * SEQ + c * 128;
        __syncthreads();
        float gi = 0.f;
        if (tid < 128) { const float* gp = Gt + (tok0 + tid) * 16 + dir * 8 + h; gi = gp[0]; fl[tid] = logsig(gp[4]); }
        __syncthreads();
        if (tid < 128) {
            float cum = 0.f, tot = 0.f;
            for (int s = 0; s < 128; ++s) { const float f = fl[s]; tot += f; if (dir == 0 ? s <= tid : s >= tid) cum += f; }
            ab[tid] = tot - cum + gi;
            if (tid == 0) SC[(chain * 64 + c) * 2] = tot;
        }
        __syncthreads();
        if (tid < 128) {
            float mx = -1e30f;
            for (int s = 0; s < 128; ++s) mx = fmaxf(mx, ab[s]);
            wv[tid] = __expf(ab[tid] - mx) * KSCALE;
            if (tid == 0) SC[(chain * 64 + c) * 2 + 1] = mx;
        }
        __syncthreads();
        const int mi = wave >> 1, nh = wave & 1;
        const bf16_t* vp = VmT + ((size_t)((b * 4 + h) * 128 + 32 * mi + r32)) * SEQ + c * 128 + 8 * hi;
        const bf16_t* kp = KmT + ((size_t)((b * 4 + h) * 128 + 64 * nh + r32)) * SEQ + c * 128 + 8 * hi;
        f32x16 acc[2];
#pragma unroll
        for (int ni = 0; ni < 2; ++ni)
#pragma unroll
            for (int r = 0; r < 16; ++r) acc[ni][r] = 0.f;
#pragma unroll
        for (int ks = 0; ks < 8; ++ks) {
            const bf16x8 a = *(const GAS bf16x8*)(vp + 16 * ks);
            const LAS float* wp = wv + 16 * ks + 8 * hi;
#pragma unroll
            for (int ni = 0; ni < 2; ++ni) {
                const u32x4 kr = *(const GAS u32x4*)(kp + (size_t)(32 * ni) * SEQ + 16 * ks);
                u32x4 kw; kw.x = pk2(bflo(kr.x) * wp[0], bfhi(kr.x) * wp[1]); kw.y = pk2(bflo(kr.y) * wp[2], bfhi(kr.y) * wp[3]);
                kw.z = pk2(bflo(kr.z) * wp[4], bfhi(kr.z) * wp[5]); kw.w = pk2(bflo(kr.w) * wp[6], bfhi(kr.w) * wp[7]);
                acc[ni] = MFMA32(a, __builtin_bit_cast(bf16x8, kw), acc[ni]);
            }
        }
        bf16_t* cp = CST + (size_t)(chain * 64 + c) * 16384;
#pragma unroll
        for (int ni = 0; ni < 2; ++ni)
#pragma unroll
            for (int r = 0; r < 16; ++r) { const int dv = 32 * mi + crow(r, hi), dk = 64 * nh + 32 * ni + r32; cp[dv * 128 + dk] = (bf16_t)(pk2(acc[ni][r], 0.f) & 0xffffu); }
        if (tid < 128) {
            const bf16_t* kq = KmT + ((size_t)((b * 4 + h) * 128 + tid)) * SEQ + c * 128; float s = 0.f;
#pragma unroll 4
            for (int j = 0; j < 16; ++j) { const u32x4 kr = *(const GAS u32x4*)(kq + 8 * j); const LAS float* wp = wv + 8 * j;
                s += bflo(kr.x) * wp[0] + bfhi(kr.x) * wp[1] + bflo(kr.y) * wp[2] + bfhi(kr.y) * wp[3] + bflo(kr.z) * wp[4] + bfhi(kr.z) * wp[5] + bflo(kr.w) * wp[6] + bfhi(kr.w) * wp[7]; }
            NST[(size_t)(chain * 64 + c) * 128 + tid] = s;
        }
    }
}
__device__ __forceinline__ void mlstm_scan_phase(bf16_t* CST, float* NST, const float* SC, float* MST, int gtid, int nthreads) {
    for (int idx = gtid; idx < 64 * 2048; idx += nthreads) {
        const int chain = idx >> 11, e = idx & 2047, dir = chain & 1; const bool hasn = e < 16;
        float C[8], N[8]; float m = 0.f;
#pragma unroll
        for (int i = 0; i < 8; ++i) { C[i] = 0.f; N[i] = 0.f; }
        for (int step = 0; step < 64; ++step) {
            const int c = dir ? 63 - step : step; const int base = chain * 64 + c;
            const float g = SC[base * 2], ml = SC[base * 2 + 1];
            const float mn = fmaxf(g + m, ml), dec = __expf(g + m - mn), sc = __expf(ml - mn);
            GAS u32x4* p = (GAS u32x4*)(CST + (size_t)base * 16384 + e * 8);
            const u32x4 kl = *p;
            u32x4 st; st.x = pk2(C[0], C[1]); st.y = pk2(C[2], C[3]); st.z = pk2(C[4], C[5]); st.w = pk2(C[6], C[7]);
            *p = st;
            if (e == 0) MST[base] = m;
            C[0] = dec * C[0] + sc * bflo(kl.x); C[1] = dec * C[1] + sc * bfhi(kl.x); C[2] = dec * C[2] + sc * bflo(kl.y); C[3] = dec * C[3] + sc * bfhi(kl.y);
            C[4] = dec * C[4] + sc * bflo(kl.z); C[5] = dec * C[5] + sc * bfhi(kl.z); C[6] = dec * C[6] + sc * bflo(kl.w); C[7] = dec * C[7] + sc * bfhi(kl.w);
            if (hasn) {
                GAS f32x4* q = (GAS f32x4*)(NST + (size_t)base * 128 + e * 8);
                const f32x4 n0 = q[0], n1 = q[1];
                q[0] = (f32x4){N[0], N[1], N[2], N[3]}; q[1] = (f32x4){N[4], N[5], N[6], N[7]};
                N[0] = dec * N[0] + sc * n0.x; N[1] = dec * N[1] + sc * n0.y; N[2] = dec * N[2] + sc * n0.z; N[3] = dec * N[3] + sc * n0.w;
                N[4] = dec * N[4] + sc * n1.x; N[5] = dec * N[5] + sc * n1.y; N[6] = dec * N[6] + sc * n1.z; N[7] = dec * N[7] + sc * n1.w;
            }
            m = mn;
        }
    }
}
__device__ __forceinline__ void mlstm_c_phase(const bf16_t* QKV, const float* Gt, const bf16_t* VmT, const bf16_t* CST, const float* NST, const float* MST, const float* mgain, bf16_t* Y,
                                              ldsp_t lds, int tid, int wave, int r32, int hi, int Bx, int Gd) {
    LAS float* bc = (LAS float*)lds; LAS float* rbv = bc + 128; LAS float* aif = bc + 256; LAS float* aib = bc + 384; LAS float* nst = bc + 512; LAS float* hb = bc + 1024;
    const int dir = wave >> 2, tb = wave & 3, t = 32 * tb + r32;
    for (int u = Bx; u < BATCH * 4 * 64; u += Gd) {
        const int c = u & 63, h = (u >> 6) & 3, b = u >> 8;
        const size_t tok0 = (size_t)b * SEQ + c * 128;
        __syncthreads();
        float i_f = 0.f, i_b = 0.f;
        if (tid < 128) { const float* gp = Gt + (tok0 + tid) * 16 + h; i_f = gp[0]; hb[tid] = logsig(gp[4]); i_b = gp[8]; hb[128 + tid] = logsig(gp[12]); }
        else if (tid < 384) { const int d2 = (tid - 128) >> 7, dk = (tid - 128) & 127; nst[d2 * 128 + dk] = NST[(size_t)(((b * 4 + h) * 2 + d2) * 64 + c) * 128 + dk]; }
        __syncthreads();
        if (tid < 128) {
            float cf = 0.f, cb = 0.f;
            for (int s = 0; s < 128; ++s) { if (s <= tid) cf += hb[s]; if (s >= tid) cb += hb[128 + s]; }
            bc[tid] = cf; rbv[tid] = cb; aif[tid] = i_f - cf; aib[tid] = i_b - cb;
        }
        __syncthreads();
        const int chain = (b * 4 + h) * 2 + dir;
        const float mst = MST[chain * 64 + c];
        const float bct = dir ? rbv[t] : bc[t];
        const LAS float* ai = dir ? aib : aif;
        bf16x8 qf[8];
        { const bf16_t* qp = QKV + (tok0 + t) * QKVP + 768 + h * 128 + 8 * hi;
#pragma unroll
          for (int k0 = 0; k0 < 8; ++k0) qf[k0] = *(const GAS bf16x8*)(qp + 16 * k0); }
        float mmax = -1e30f;
        for (int s = hi; s < 128; s += 2) { const bool ok = dir == 0 ? s <= t : s >= t; const float v = bct + ai[s]; if (ok) mmax = fmaxf(mmax, v); }
        mmax = fmaxf(mmax, shx(mmax, 32));
        const float mt = fmaxf(mmax, bct + mst);
        const float inter = __expf(bct + mst - mt);
        f32x16 acc[4];
#pragma unroll
        for (int d0 = 0; d0 < 4; ++d0) {
#pragma unroll
            for (int r = 0; r < 16; ++r) acc[d0][r] = 0.f;
            const bf16_t* cp = CST + (size_t)(chain * 64 + c) * 16384 + (32 * d0 + r32) * 128 + 8 * hi;
#pragma unroll
            for (int k0 = 0; k0 < 8; ++k0) { const bf16x8 cf = *(const GAS bf16x8*)(cp + 16 * k0); acc[d0] = MFMA32(cf, qf[k0], acc[d0]); }
            acc[d0] = acc[d0] * inter;
        }
        float den = 0.f;
#pragma unroll 1
        for (int sb = 0; sb < 4; ++sb) {
            const bool actv = dir == 0 ? sb <= tb : sb >= tb;
            if (!actv) continue;
            f32x16 p;
#pragma unroll
            for (int r = 0; r < 16; ++r) p[r] = 0.f;
            const bf16_t* kp = QKV + (tok0 + 32 * sb + r32) * QKVP + 1280 + h * 128 + 8 * hi;
#pragma unroll
            for (int k0 = 0; k0 < 8; ++k0) { const bf16x8 kf = *(const GAS bf16x8*)(kp + 16 * k0); p = MFMA32(kf, qf[k0], p); }
#pragma unroll
            for (int r = 0; r < 16; ++r) { const int s = 32 * sb + crow(r, hi); const bool ok = dir == 0 ? s <= t : s >= t;
                const float v = ok ? p[r] * KSCALE * __expf(bct + ai[s] - mt) : 0.f; p[r] = v; den += v; }
#pragma unroll
            for (int j = 0; j < 2; ++j) {
                const u32x4 w = {pk2(p[8 * j], p[8 * j + 1]), pk2(p[8 * j + 2], p[8 * j + 3]), pk2(p[8 * j + 4], p[8 * j + 5]), pk2(p[8 * j + 6], p[8 * j + 7])};
                const bf16x8 pb = __builtin_bit_cast(bf16x8, w);
#pragma unroll
                for (int d0 = 0; d0 < 4; ++d0) {
                    const bf16_t* vp = VmT + ((size_t)((b * 4 + h) * 128 + 32 * d0 + r32)) * SEQ + c * 128 + 32 * sb + 16 * j + 4 * hi;
                    const s16x4 lo = *(const GAS s16x4*)vp, h4 = *(const GAS s16x4*)(vp + 8);
                    const bf16x8 a = {lo[0], lo[1], lo[2], lo[3], h4[0], h4[1], h4[2], h4[3]};
                    acc[d0] = MFMA32(a, pb, acc[d0]);
                }
            }
        }
        den += shx(den, 32);
        float qn = 0.f;
#pragma unroll
        for (int k0 = 0; k0 < 8; ++k0) { const u32x4 qw = __builtin_bit_cast(u32x4, qf[k0]); const LAS float* np = nst + dir * 128 + 16 * k0 + 8 * hi;
            qn += bflo(qw.x) * np[0] + bfhi(qw.x) * np[1] + bflo(qw.y) * np[2] + bfhi(qw.y) * np[3] + bflo(qw.z) * np[4] + bfhi(qw.z) * np[5] + bflo(qw.w) * np[6] + bfhi(qw.w) * np[7]; }
        qn += shx(qn, 32);
        den += inter * qn;
        const float rden = 1.f / fmaxf(fabsf(den), __expf(-mt));
        __syncthreads();
        if (dir == 1) {
#pragma unroll
            for (int d0 = 0; d0 < 4; ++d0)
#pragma unroll
                for (int r = 0; r < 16; ++r) hb[(32 * d0 + crow(r, hi)) * 129 + t] = acc[d0][r] * rden;
        }
        __syncthreads();
        if (dir == 0) {
            float ss = 0.f;
#pragma unroll
            for (int d0 = 0; d0 < 4; ++d0)
#pragma unroll
                for (int r = 0; r < 16; ++r) { const float v = acc[d0][r] * rden + hb[(32 * d0 + crow(r, hi)) * 129 + t]; acc[d0][r] = v; ss += v * v; }
            ss += shx(ss, 32);
            const float rstd = rsqrtf(ss * (1.f / 128.f) + EPS);
            const bf16_t* op = QKV + (tok0 + t) * QKVP + 2304 + h * 128; bf16_t* yp = Y + (tok0 + t) * DM + 512 + h * 128;
#pragma unroll
            for (int d0 = 0; d0 < 4; ++d0)
#pragma unroll
                for (int g = 0; g < 4; ++g) {
                    const int d = 32 * d0 + 8 * g + 4 * hi; const f32x4 gn = *(const f32x4*)(mgain + h * 128 + d); const u32x2 ow = *(const u32x2*)(op + d);
                    const float s0 = 1.f / (1.f + __expf(-bflo(ow.x))), s1 = 1.f / (1.f + __expf(-bfhi(ow.x))), s2 = 1.f / (1.f + __expf(-bflo(ow.y))), s3 = 1.f / (1.f + __expf(-bfhi(ow.y)));
                    u32x2 w; w.x = pk2(acc[d0][4 * g] * rstd * gn.x * s0, acc[d0][4 * g + 1] * rstd * gn.y * s1); w.y = pk2(acc[d0][4 * g + 2] * rstd * gn.z * s2, acc[d0][4 * g + 3] * rstd * gn.w * s3);
                    *(u32x2*)(yp + d) = w;
                }
        }
    }
}
constexpr size_t WS_GP = 1008 * MiB, WS_WC = 1016 * MiB;
__device__ __forceinline__ void mlstm_gates_phase(const float* Gt, float* GP, float* WC, float* SC, int gw, int NGW, int lane) {
    for (int u = gw; u < BATCH * 4 * 64; u += NGW) {
        const int c = u & 63, h = (u >> 6) & 3, b = u >> 8;
        const size_t tok0 = (size_t)b * SEQ + c * 128;
        const int t0 = 2 * lane;
        const float* g0 = Gt + (tok0 + t0) * 16 + h; const float* g1 = g0 + 16;
        const float if0 = g0[0], ff0 = logsig(g0[4]), ib0 = g0[8], fb0 = logsig(g0[12]);
        const float if1 = g1[0], ff1 = logsig(g1[4]), ib1 = g1[8], fb1 = logsig(g1[12]);
        const float sf = ff0 + ff1, sb = fb0 + fb1;
        float xf = sf, xb = sb;
#pragma unroll
        for (int o = 1; o < 64; o <<= 1) { const float yf = shup(xf, o), yb = shup(xb, o); if (lane >= o) { xf += yf; xb += yb; } }
        const float totf = shl_(xf, 63), totb = shl_(xb, 63);
        const float bc0 = (xf - sf) + ff0, bc1 = bc0 + ff1;
        const float cb0 = (xb - sb) + fb0, cb1 = cb0 + fb1;
        const float rb0 = totb - cb0 + fb0, rb1 = totb - cb1 + fb1;
        const float aif0 = if0 - bc0, aif1 = if1 - bc1, aib0 = ib0 - rb0, aib1 = ib1 - rb1;
        float px = fmaxf(aif0, aif1);
#pragma unroll
        for (int o = 1; o < 64; o <<= 1) { const float y = shup(px, o); if (lane >= o) px = fmaxf(px, y); }
        float pe = shup(px, 1); if (lane == 0) pe = -3.0e38f;
        const float pmf0 = fmaxf(pe, aif0), pmf1 = fmaxf(pmf0, aif1);
        float sx = fmaxf(aib0, aib1);
#pragma unroll
        for (int o = 1; o < 64; o <<= 1) { const float y = shdn(sx, o); if (lane + o < 64) sx = fmaxf(sx, y); }
        float se = shdn(sx, 1); if (lane == 63) se = -3.0e38f;
        const float pmb1 = fmaxf(se, aib1), pmb0 = fmaxf(pmb1, aib0);
        const float mxf = shl_(px, 63), mxb = shl_(sx, 0);
        const float wf0 = __expf(aif0 - mxf) * KSCALE, wf1 = __expf(aif1 - mxf) * KSCALE, wb0 = __expf(aib0 - mxb) * KSCALE, wb1 = __expf(aib1 - mxb) * KSCALE;
        GAS f32x4* gp = (GAS f32x4*)(GP + ((size_t)(b * 4 + h) * SEQ + c * 128 + t0) * 8);
        gp[0] = (f32x4){bc0, rb0, aif0, aib0}; gp[1] = (f32x4){wf0, wb0, pmf0, pmb0}; gp[2] = (f32x4){bc1, rb1, aif1, aib1}; gp[3] = (f32x4){wf1, wb1, pmf1, pmb1};
        const int chf = (b * 4 + h) * 2;
        *(GAS f32x2*)(WC + (size_t)(chf * 64 + c) * 128 + t0) = (f32x2){wf0, wf1};
        *(GAS f32x2*)(WC + (size_t)((chf + 1) * 64 + c) * 128 + t0) = (f32x2){wb0, wb1};
        if (lane == 0) { SC[(chf * 64 + c) * 2] = totf; SC[(chf * 64 + c) * 2 + 1] = totf + mxf; SC[((chf + 1) * 64 + c) * 2] = totb; SC[((chf + 1) * 64 + c) * 2 + 1] = totb + mxb; }
    }
}
__device__ __forceinline__ void mlstm_a2_phase(const float* WC, const bf16_t* KmT, const bf16_t* VmT, bf16_t* CST, float* NST, int gw, int NGW, int r32, int hi) {
    for (int u = gw; u < BATCH * 4 * 64 * 2 * 4; u += NGW) {
        const int mi = u & 3, dir = (u >> 2) & 1, c = (u >> 3) & 63, h = (u >> 9) & 3, b = u >> 11, chain = (b * 4 + h) * 2 + dir;
        const float* wp0 = WC + (size_t)(chain * 64 + c) * 128 + 8 * hi;
        const bf16_t* vp = VmT + ((size_t)((b * 4 + h) * 128 + 32 * mi + r32)) * SEQ + c * 128 + 8 * hi;
        const bf16_t* kp = KmT + ((size_t)((b * 4 + h) * 128 + r32)) * SEQ + c * 128 + 8 * hi;
        f32x16 acc[4]; float nl[4];
#pragma unroll
        for (int ni = 0; ni < 4; ++ni) { nl[ni] = 0.f;
#pragma unroll
            for (int r = 0; r < 16; ++r) acc[ni][r] = 0.f; }
#pragma unroll 2
        for (int ks = 0; ks < 8; ++ks) {
            const bf16x8 a = *(const GAS bf16x8*)(vp + 16 * ks);
            const f32x4 w0 = *(const GAS f32x4*)(wp0 + 16 * ks), w1 = *(const GAS f32x4*)(wp0 + 16 * ks + 4);
#pragma unroll
            for (int ni = 0; ni < 4; ++ni) {
                const u32x4 kr = *(const GAS u32x4*)(kp + (size_t)(32 * ni) * SEQ + 16 * ks);
                const float p0 = bflo(kr.x) * w0.x, p1 = bfhi(kr.x) * w0.y, p2 = bflo(kr.y) * w0.z, p3 = bfhi(kr.y) * w0.w, p4 = bflo(kr.z) * w1.x, p5 = bfhi(kr.z) * w1.y, p6 = bflo(kr.w) * w1.z, p7 = bfhi(kr.w) * w1.w;
                nl[ni] += ((p0 + p1) + (p2 + p3)) + ((p4 + p5) + (p6 + p7));
                const u32x4 kw = {pk2(p0, p1), pk2(p2, p3), pk2(p4, p5), pk2(p6, p7)};
                acc[ni] = MFMA32(a, __builtin_bit_cast(bf16x8, kw), acc[ni]);
            }
        }
#pragma unroll
        for (int g = 0; g < 4; ++g) {
            GAS bf16_t* cp = (GAS bf16_t*)(CST + (size_t)(chain * 64 + c) * 16384 + (32 * mi + 8 * g + 4 * hi) * 128 + r32);
            asm volatile("" : "+v"(cp));
#pragma unroll
            for (int e = 0; e < 4; ++e)
#pragma unroll
                for (int ni = 0; ni < 4; ++ni) cp[e * 128 + 32 * ni] = (bf16_t)(pk2(acc[ni][4 * g + e], 0.f) & 0xffffu);
        }
#pragma unroll
        for (int ni = 0; ni < 4; ++ni) { const float v = nl[ni] + shx(nl[ni], 32); if (mi == 0 && hi == 0) NST[(size_t)(chain * 64 + c) * 128 + 32 * ni + r32] = v; }
    }
}
__device__ __forceinline__ void mlstm_c2_phase(const bf16_t* QKV, const float* GP, const bf16_t* VmT, const bf16_t* CST, const float* NST, const float* MST, const float* mgain, bf16_t* Y,
                                               LAS float* wl, int gw, int NGW, int lane_, int r32_, int hi_) {
    LAS float* hs = wl; LAS float* aiL = wl + 4096;
    for (int u = gw; u < BATCH * 4 * 64 * 4; u += NGW) {
        const int lane = lane_id(), r32 = lane & 31, hi = lane >> 5; (void)lane_; (void)r32_; (void)hi_;
        const int tb = u & 3, c = (u >> 2) & 63, h = (u >> 8) & 3, b = u >> 10, t = 32 * tb + r32;
        const size_t tok0 = (size_t)b * SEQ + c * 128;
        const GAS f32x4* gpc = (const GAS f32x4*)(GP + ((size_t)(b * 4 + h) * SEQ + c * 128) * 8);
        { const f32x4 e0 = gpc[(2 * lane) * 2], e1 = gpc[(2 * lane + 1) * 2]; aiL[2 * lane] = e0.z; aiL[128 + 2 * lane] = e0.w; aiL[2 * lane + 1] = e1.z; aiL[128 + 2 * lane + 1] = e1.w; }
        LDS_FENCE();
#pragma nounroll
        for (int dir_ = 0; dir_ < 2; ++dir_) {
            int dir = dir_; asm volatile("" : "+s"(dir));
            bf16x8 qf[8];
            { const bf16_t* qp = QKV + (tok0 + t) * QKVP + 768 + h * 128 + 8 * hi;
#pragma unroll
              for (int k0 = 0; k0 < 8; ++k0) qf[k0] = *(const GAS bf16x8*)(qp + 16 * k0); }
            const int chain = (b * 4 + h) * 2 + dir;
            const float mst = MST[chain * 64 + c];
            const GAS float* gpt = (const GAS float*)(gpc + t * 2) + dir;
            const float bct = gpt[0], pm = gpt[6];
            const LAS float* ai = aiL + dir * 128;
            const float mt = fmaxf(bct + pm, bct + mst), inter = __expf(bct + mst - mt);
            f32x16 acc[4];
#pragma unroll
            for (int d0 = 0; d0 < 4; ++d0) {
#pragma unroll
                for (int r = 0; r < 16; ++r) acc[d0][r] = 0.f;
                const bf16_t* cp = CST + (size_t)(chain * 64 + c) * 16384 + (32 * d0 + r32) * 128 + 8 * hi;
#pragma unroll
                for (int k0 = 0; k0 < 8; ++k0) { const bf16x8 cf = *(const GAS bf16x8*)(cp + 16 * k0); acc[d0] = MFMA32(cf, qf[k0], acc[d0]); }
                acc[d0] = acc[d0] * inter;
            }
            float den = 0.f;
#pragma unroll 1
            for (int sb = 0; sb < 4; ++sb) {
                const bool actv = dir == 0 ? sb <= tb : sb >= tb;
                if (!actv) continue;
                f32x16 p;
#pragma unroll
                for (int r = 0; r < 16; ++r) p[r] = 0.f;
                const int pr = (r32 & 0x13) | ((r32 & 4) << 1) | ((r32 & 8) >> 1);
                const bf16_t* kp = QKV + (tok0 + 32 * sb + pr) * QKVP + 1280 + h * 128 + 8 * hi;
#pragma unroll
                for (int k0 = 0; k0 < 8; ++k0) { const bf16x8 kf = *(const GAS bf16x8*)(kp + 16 * k0); p = MFMA32(kf, qf[k0], p); }
#pragma unroll
                for (int r = 0; r < 16; ++r) { const int s = 32 * sb + 16 * (r >> 3) + 8 * hi + (r & 7); const bool ok = dir == 0 ? s <= t : s >= t;
                    const float v = ok ? p[r] * KSCALE * __expf(bct + ai[s] - mt) : 0.f; p[r] = v; den += v; }
#pragma unroll
                for (int j = 0; j < 2; ++j) {
                    const u32x4 w = {pk2(p[8 * j], p[8 * j + 1]), pk2(p[8 * j + 2], p[8 * j + 3]), pk2(p[8 * j + 4], p[8 * j + 5]), pk2(p[8 * j + 6], p[8 * j + 7])};
                    const bf16x8 pb = __builtin_bit_cast(bf16x8, w);
#pragma unroll
                    for (int d0 = 0; d0 < 4; ++d0) {
                        const bf16_t* vp = VmT + ((size_t)((b * 4 + h) * 128 + 32 * d0 + r32)) * SEQ + c * 128 + 32 * sb + 16 * j + 8 * hi;
                        const bf16x8 a = *(const GAS bf16x8*)vp;
                        acc[d0] = MFMA32(a, pb, acc[d0]);
                    }
                }
            }
            den += shx(den, 32);
            float qn = 0.f;
            { const float* np0 = NST + (size_t)(chain * 64 + c) * 128 + 8 * hi;
#pragma unroll
              for (int k0 = 0; k0 < 8; ++k0) { const u32x4 qw = __builtin_bit_cast(u32x4, qf[k0]); const f32x4 n0 = *(const GAS f32x4*)(np0 + 16 * k0), n1 = *(const GAS f32x4*)(np0 + 16 * k0 + 4);
                  qn += bflo(qw.x) * n0.x + bfhi(qw.x) * n0.y + bflo(qw.y) * n0.z + bfhi(qw.y) * n0.w + bflo(qw.z) * n1.x + bfhi(qw.z) * n1.y + bflo(qw.w) * n1.z + bfhi(qw.w) * n1.w; } }
            qn += shx(qn, 32);
            den += inter * qn;
            const float rden = 1.f / fmaxf(fabsf(den), __expf(-mt));
            if (dir == 0) {
#pragma unroll
                for (int d0 = 0; d0 < 4; ++d0)
#pragma unroll
                    for (int r = 0; r < 16; ++r) hs[(32 * d0 + crow(r, hi)) * 32 + r32] = acc[d0][r] * rden;
                LDS_FENCE();
            } else {
                float ss = 0.f;
#pragma unroll
                for (int d0 = 0; d0 < 4; ++d0)
#pragma unroll
                    for (int r = 0; r < 16; ++r) { const float v = acc[d0][r] * rden + hs[(32 * d0 + crow(r, hi)) * 32 + r32]; acc[d0][r] = v; ss += v * v; }
                ss += shx(ss, 32);
                const float rstd = rsqrtf(ss * (1.f / 128.f) + EPS);
                const bf16_t* op = QKV + (tok0 + t) * QKVP + 2304 + h * 128; bf16_t* yp = Y + (tok0 + t) * DM + 512 + h * 128;
#pragma unroll
                for (int d0 = 0; d0 < 4; ++d0)
#pragma unroll
                    for (int g = 0; g < 4; ++g) {
                        const int d = 32 * d0 + 8 * g + 4 * hi; const f32x4 gn = *(const GAS f32x4*)(mgain + h * 128 + d); const u32x2 ow = *(const GAS u32x2*)(op + d);
                        const float s0 = 1.f / (1.f + __expf(-bflo(ow.x))), s1 = 1.f / (1.f + __expf(-bfhi(ow.x))), s2 = 1.f / (1.f + __expf(-bflo(ow.y))), s3 = 1.f / (1.f + __expf(-bfhi(ow.y)));
                        u32x2 w; w.x = pk2(acc[d0][4 * g] * rstd * gn.x * s0, acc[d0][4 * g + 1] * rstd * gn.y * s1); w.y = pk2(acc[d0][4 * g + 2] * rstd * gn.z * s2, acc[d0][4 * g + 3] * rstd * gn.w * s3);
                        *(GAS u32x2*)(yp + d) = w;
                    }
            }
        }
        LDS_FENCE();
    }
}
#define PH_BEGIN { int tid = wave_s * 64 + lane_id(); asm volatile("" : "+v"(tid)); const int lane = tid & 63, wave = wave_s, r32 = lane & 31, hi = lane >> 5; \
    int Bx = blockIdx.x, Gd = gridDim.x; asm volatile("" : "+s"(Bx), "+s"(Gd)); \
    const int gw = Bx * NWAVES + wave, NGW = Gd * NWAVES, gtid = Bx * NTHR + tid, nthreads = Gd * NTHR; \
    LAS float* scrf = (LAS float*)(lds + wave * 16384); LAS bf16_t* scrh = (LAS bf16_t*)(lds + wave * 16384); \
    (void)Bx; (void)Gd; (void)lane; (void)r32; (void)hi; (void)gw; (void)NGW; (void)gtid; (void)nthreads; (void)scrf; (void)scrh;
#define PH_END }
__global__ void __launch_bounds__(NTHR) fwd_megakernel(Args args) {
    extern __shared__ __attribute__((aligned(16))) unsigned char lds_raw[];
    cg::grid_group grid = cg::this_grid();
    ldsp_t lds = (ldsp_t)lds_raw;
    const int wave_s = __builtin_amdgcn_readfirstlane(threadIdx.x >> 6);
    unsigned char* wsl = args.ws;
    if (threadIdx.x < 2) ((LAS unsigned*)(lds + (LDS_BYTES - 16)))[threadIdx.x] = 0u;
    __syncthreads();
    xb_post((unsigned*)wsl, wave_s);
    grid.sync();
#define GSYNC() do { gbar((unsigned*)wsl, (volatile LAS unsigned*)(lds + (LDS_BYTES - 16)), wave_s); asm volatile("" : "+s"(wsl)); } while (0)
#define WSP wsl
#define x_in (args.in[0])
#define mem (args.in[1])
#define t5raw (args.in[2])
#define out (args.out)
#define RSB(k) ((float*)(WSP + WS_RS) + (size_t)(k) * MTOK)
#define GPB ((float*)(WSP + WS_GP))
#define WCB ((float*)(WSP + WS_WC))
#define XB ((bf16_t*)out + (size_t)MTOK * DM)
#define XB2 ((bf16_t*)(WSP + WS_Y))
#define HN ((bf16_t*)(WSP + WS_HN))
#define QKV ((bf16_t*)(WSP + WS_QKV))
#define VT ((bf16_t*)(WSP + WS_VT))
#define Y ((bf16_t*)(WSP + WS_Y))
#define CST ((bf16_t*)(WSP + WS_CST))
#define Gt ((float*)(WSP + WS_G))
#define NST ((float*)(WSP + WS_NST))
#define SC ((float*)(WSP + WS_SC))
#define MST ((float*)(WSP + WS_MST))
#define QC ((bf16_t*)(WSP + WS_QC))
#define KVC(l_) ((bf16_t*)(WSP + WS_KVC + (size_t)(l_) * 4 * MiB))
#define VTC(l_) ((bf16_t*)(WSP + WS_VTC + (size_t)(l_) * 2 * MiB))
#define MEMN ((bf16_t*)(WSP + WS_MEMN))
#define OC ((bf16_t*)(WSP + WS_OC))
#define SIDEB ((float*)(WSP + WS_SIDE))
#define ACT ((bf16_t*)(WSP + WS_ACT))
#define T5T ((float*)(WSP + WS_T5))
#define ROPEC ((float*)(WSP + WS_ROPE))
#define ROPES (ROPEC + 2048)

    PH_BEGIN
#ifdef PROBE_P0
    for (int rep = 0; rep < 2; ++rep) {
#else
    {
#endif
    int goff = 0;
    wt_matrix(args.in[7], 1024, 2832, (bf16_t*)(WSP + WS_WIN0), false, scrf, gw, NGW, lane, goff);
    wt_matrix(args.in[11], 1024, 1024, (bf16_t*)(WSP + WS_WOUT0), false, scrf, gw, NGW, lane, goff);
    wt_matrix(args.in[12], 1024, 3072, (bf16_t*)(WSP + WS_WIN1), false, scrf, gw, NGW, lane, goff);
    wt_matrix(args.in[18], 1024, 1024, (bf16_t*)(WSP + WS_WOUT1), false, scrf, gw, NGW, lane, goff);
    for (int l = 0; l < 2; ++l) {
        wt_matrix(args.in[19] + (size_t)l * 1024 * 512, 1024, 512, (bf16_t*)(WSP + WS_WQ + l * MiB), false, scrf, gw, NGW, lane, goff);
        wt_matrix(args.in[20] + (size_t)l * 1024 * 1024, 1024, 1024, (bf16_t*)(WSP + WS_WKV + 2 * l * MiB), false, scrf, gw, NGW, lane, goff);
        wt_matrix(args.in[22] + (size_t)l * 512 * 1024, 512, 1024, (bf16_t*)(WSP + WS_WO + l * MiB), false, scrf, gw, NGW, lane, goff);
        wt_matrix(args.in[23] + (size_t)l * 1024 * 5632, 1024, 5632, (bf16_t*)(WSP + WS_WUP + 11 * l * MiB), true, scrf, gw, NGW, lane, goff);
        wt_matrix(args.in[26] + (size_t)l * 2816 * 1024, 2816, 1024, (bf16_t*)(WSP + WS_WDN + 6 * l * MiB), false, scrf, gw, NGW, lane, goff);
    }
    for (int i = gtid; i < 4 * 16384; i += nthreads) {
        const int h = i >> 14, rel = (i & 16383) - 8192, n = rel < 0 ? -rel : rel;
        int bk;
        if (n < 8) bk = n; else { const int lg = 8 + (int)(logf((float)n / 8.0f) / logf(16.0f) * 8.0f); bk = lg < 15 ? lg : 15; }
        bk += rel > 0 ? 16 : 0;
        T5T[i] = t5raw[bk * 4 + h] * LOG2E;
    }
    for (int i = gtid; i < 2048; i += nthreads) {
        const int pos = i >> 4, j = i & 15;
        const float inv = exp2f(-(float)j * (13.287712379549449f / 16.0f));
        const double rev = (double)((float)pos * inv) * 0.15915494309189535; const float fr = (float)(rev - floor(rev));
        ROPEC[i] = __builtin_amdgcn_cosf(fr); ROPES[i] = __builtin_amdgcn_sinf(fr);
    }
    }
    rms_rows(x_in, args.in[3], HN, MTOK, gw, NGW, lane);
#ifdef PROBE_RMS
    rms_rows(x_in, args.in[3], HN, MTOK, gw, NGW, lane);
#endif
    rms_rows(mem, args.in[5], MEMN, BATCH * MEMLEN, gw, NGW, lane);
    rms_rows(mem, args.in[5] + DM, MEMN + (size_t)BATCH * MEMLEN * DM, BATCH * MEMLEN, gw, NGW, lane);
    for (int i = gtid; i < 5 * MTOK / 4; i += nthreads) ((GAS f32x4*)RSB(0))[i] = (f32x4){0.f, 0.f, 0.f, 0.f};
    PH_END
    GSYNC();

#pragma nounroll
    for (int l = 0; l < 2; ++l) {
#ifndef NO_GEMM
        if (l == 0) { PH_BEGIN EpiBf16G E{QKV, QKVP, Gt, args.in[8], 2816, nullptr}; run_gemm(lds, HN, (const bf16_t*)(WSP + WS_WIN0), MTOK, 3072, 1024, E, tid, Bx, Gd); PH_END
            PH_BEGIN EpiBf16G E{KVC(0), 1024, nullptr, nullptr, 0, nullptr}; run_gemm(lds, MEMN, (const bf16_t*)(WSP + WS_WKV), BATCH * MEMLEN, 1024, 1024, E, tid, (Bx + Gd / 4) % Gd, Gd); PH_END
            PH_BEGIN EpiBf16G E{KVC(1), 1024, nullptr, nullptr, 0, nullptr}; run_gemm(lds, MEMN + (size_t)BATCH * MEMLEN * DM, (const bf16_t*)(WSP + WS_WKV + 2 * MiB), BATCH * MEMLEN, 1024, 1024, E, tid, (Bx + Gd / 2) % Gd, Gd); PH_END }
        else        PH_BEGIN EpiBf16G E{QKV, QKVP, nullptr, nullptr, 0, RSB(2)};  run_gemm(lds, HN, (const bf16_t*)(WSP + WS_WIN1), MTOK, 3072, 1024, E, tid, Bx, Gd); PH_END
#endif
        GSYNC();
        PH_BEGIN
        if (l == 0) {
            qknorm_rows<64, true>(QKV, QKVP, 512, 128, MTOK, 0, args.in[9], args.in[9] + 64, 1.f, 1.f, ROPEC, ROPES, gw, NGW, lane);
            transpose_cols(QKV, QKVP, 640, 128, SEQ, BATCH, VT, scrh, gw, NGW, lane);
#ifdef PROBE_TR
            transpose_cols(QKV, QKVP, 640, 128, SEQ, BATCH, VT, scrh, gw, NGW, lane);
#endif
            transpose_cols(QKV, QKVP, 1280, 512, SEQ, BATCH, VT + (size_t)8 * MiB, scrh, gw, NGW, lane);
#ifdef PROBE_TR
            transpose_cols(QKV, QKVP, 1280, 512, SEQ, BATCH, VT + (size_t)8 * MiB, scrh, gw, NGW, lane);
#endif
            transpose_cols(QKV, QKVP, 1792, 512, SEQ, BATCH, VT + (size_t)40 * MiB, scrh, gw, NGW, lane);
#ifdef PROBE_TR
            transpose_cols(QKV, QKVP, 1792, 512, SEQ, BATCH, VT + (size_t)40 * MiB, scrh, gw, NGW, lane);
#endif
            mlstm_gates_phase(Gt, GPB, WCB, SC, gw, NGW, lane);
            for (int lc = 0; lc < 2; ++lc) {
                qknorm_rows<128, false>(KVC(lc), 1024, 0, 512, BATCH * MEMLEN, 0, args.in[21] + lc * 256, args.in[21] + lc * 256 + 128, 1.f, 1.f, nullptr, nullptr, gw, NGW, lane);
                transpose_cols(KVC(lc), 1024, 512, 512, MEMLEN, BATCH, VTC(lc), scrh, gw, NGW, lane);
#ifdef PROBE_TR
                transpose_cols(KVC(lc), 1024, 512, 512, MEMLEN, BATCH, VTC(lc), scrh, gw, NGW, lane);
#endif
            }
        } else {
            qknorm_rows<64, false>(QKV, QKVP, 512, 512, MTOK, 0, args.in[13], args.in[13] + 64, 1.f, 1.f, nullptr, nullptr, gw, NGW, lane);
            qknorm_rows<64, false>(QKV, QKVP, 2048, 512, MTOK, 0, args.in[15], args.in[15] + 64, 1.f, 1.f, nullptr, nullptr, gw, NGW, lane);
            transpose_cols(QKV, QKVP, 1024, 512, SEQ, BATCH, VT, scrh, gw, NGW, lane);
#ifdef PROBE_TR
            transpose_cols(QKV, QKVP, 1024, 512, SEQ, BATCH, VT, scrh, gw, NGW, lane);
#endif
            transpose_cols(QKV, QKVP, 2560, 512, SEQ, BATCH, VT + (size_t)32 * MiB, scrh, gw, NGW, lane);
#ifdef PROBE_TR
            transpose_cols(QKV, QKVP, 2560, 512, SEQ, BATCH, VT + (size_t)32 * MiB, scrh, gw, NGW, lane);
#endif
        }
        PH_END
        GSYNC();
        if (l == 0) {
            const bf16_t* VaT = VT; const bf16_t* KmT = VT + (size_t)8 * MiB; const bf16_t* VmT = VT + (size_t)40 * MiB;
            (void)VaT; (void)KmT; (void)VmT;
#ifndef NO_MA
            PH_BEGIN mlstm_a2_phase(WCB, KmT, VmT, CST, NST, gw, NGW, r32, hi); PH_END
#ifdef PROBE_MA
            PH_BEGIN mlstm_a2_phase(WCB, KmT, VmT, CST, NST, gw, NGW, r32, hi); PH_END
#endif
#endif
            GSYNC();
            PH_BEGIN mlstm_scan_phase(CST, NST, SC, MST, gtid, nthreads); PH_END
            GSYNC();
#ifndef NO_MC
            PH_BEGIN mlstm_c2_phase(QKV, GPB, VmT, CST, NST, MST, args.in[10], Y, (LAS float*)(lds + wave * 20480), gw, NGW, lane, r32, hi); PH_END
#ifdef PROBE_MC
            PH_BEGIN mlstm_c2_phase(QKV, GPB, VmT, CST, NST, MST, args.in[10], Y, (LAS float*)(lds + wave * 20480), gw, NGW, lane, r32, hi); PH_END
#endif
#if defined(PROBE_B) || defined(PROBE_MLSTM)
            GSYNC();
            PH_BEGIN mlstm_a2_phase(WCB, KmT, VmT, CST, NST, gw, NGW, r32, hi); PH_END
            GSYNC();
            PH_BEGIN mlstm_scan_phase(CST, NST, SC, MST, gtid, nthreads); PH_END
            GSYNC();
            PH_BEGIN mlstm_c2_phase(QKV, GPB, VmT, CST, NST, MST, args.in[10], Y, (LAS float*)(lds + wave * 20480), gw, NGW, lane, r32, hi); PH_END
#endif
#endif
#ifndef NO_GQA
            PH_BEGIN gqa_phase(QKV, VaT, Y, args.in[9], ROPEC, ROPES, lds, tid, wave, r32, hi, Bx, Gd); PH_END
#ifdef PROBE_A
            __syncthreads();
            PH_BEGIN gqa_phase(QKV, VaT, Y, args.in[9], ROPEC, ROPES, lds, tid, wave, r32, hi, Bx, Gd); PH_END
#endif
#endif
        } else {
            const bf16_t* VcT = VT; const bf16_t* VdT = VT + (size_t)32 * MiB;
            (void)VcT; (void)VdT;
#ifndef NO_NA
            PH_BEGIN na_phase(QKV, VcT, Y, args.in[14], args.in[13], args.in[13] + 64, lds, tid, wave, r32, hi, Bx, Gd); PH_END
#if defined(PROBE_B) || defined(PROBE_NA)
            __syncthreads();
            PH_BEGIN na_phase(QKV, VcT, Y, args.in[14], args.in[13], args.in[13] + 64, lds, tid, wave, r32, hi, Bx, Gd); PH_END
#endif
#endif
#ifndef NO_DIFF
            const float lam_init = 0.8f - 0.6f * 0.7408182206817179f;
            PH_BEGIN diff_phase(QKV, VdT, Y, T5T, t5raw, args.in[16], args.in[17], args.in[15], lam_init, (float*)CST, lds, tid, wave, lane, r32, hi, Bx, Gd); PH_END
#ifdef PROBE_A
            __syncthreads();
            PH_BEGIN diff_phase(QKV, VdT, Y, T5T, t5raw, args.in[16], args.in[17], args.in[15], lam_init, (float*)CST, lds, tid, wave, lane, r32, hi, Bx, Gd); PH_END
#endif
#endif
        }
        GSYNC();
#ifndef NO_GEMM
        PH_BEGIN EpiResid E{l == 0 ? (const void*)x_in : (const void*)XB, l == 0 ? 0 : 1, XB, 1, DM, HN, args.in[4] + l * DM, RSB(l == 0 ? 0 : 3)}; run_gemm(lds, Y, (const bf16_t*)(WSP + (l == 0 ? WS_WOUT0 : WS_WOUT1)), MTOK, 1024, 1024, E, tid, Bx, Gd); PH_END
#endif
        GSYNC();
#ifndef NO_GEMM
        PH_BEGIN EpiBf16G E{QC, 512, nullptr, nullptr, 0, RSB(l == 0 ? 0 : 3)}; run_gemm(lds, HN, (const bf16_t*)(WSP + WS_WQ + l * MiB), MTOK, 512, 1024, E, tid, Bx, Gd); PH_END
#endif
        GSYNC();
#ifndef NO_CROSS
        PH_BEGIN cross_phase(QC, KVC(l), VTC(l), OC, args.in[21] + l * 256, lds, tid, wave, r32, hi, Bx, Gd); PH_END
#if defined(PROBE_B) || defined(PROBE_CROSS)
        __syncthreads();
        PH_BEGIN cross_phase(QC, KVC(l), VTC(l), OC, args.in[21] + l * 256, lds, tid, wave, r32, hi, Bx, Gd); PH_END
#endif
#endif
        GSYNC();
#ifndef NO_GEMM
        PH_BEGIN EpiResid E{XB, 1, l == 0 ? XB : XB2, 1, DM, HN, args.in[6] + l * DM, RSB(l == 0 ? 1 : 4)}; run_gemm(lds, OC, (const bf16_t*)(WSP + WS_WO + l * MiB), MTOK, 1024, 512, E, tid, Bx, Gd); PH_END
#endif
        GSYNC();
#ifndef NO_GEMM
        PH_BEGIN EpiConvAct E{ACT, SIDEB, args.in[24] + (size_t)l * 3 * 2 * DFF, args.in[25] + (size_t)l * 2 * DFF, RSB(l == 0 ? 1 : 4)};
                 run_gemm(lds, HN, (const bf16_t*)(WSP + WS_WUP + 11 * l * MiB), MTOK, 2 * DFF, 1024, E, tid, Bx, Gd); PH_END
#endif
        GSYNC();
#ifndef NO_GEMM
        PH_BEGIN EpiResid E{l == 0 ? XB : XB2, 1, l == 0 ? (void*)XB : (void*)out, l == 0 ? 1 : 0, DM, l == 0 ? HN : nullptr, args.in[3] + DM, RSB(2)};
                 run_gemm_fix(lds, ACT, (const bf16_t*)(WSP + WS_WDN + 6 * l * MiB), MTOK, 1024, DFF, E, tid, Bx, Gd, ACT, SIDEB, args.in[24] + (size_t)l * 3 * 2 * DFF, args.in[25] + (size_t)l * 2 * DFF); PH_END
#endif
        GSYNC();
    }
}

#undef WSP
#undef HN
#undef XB
#undef XB2
#undef GPB
#undef WCB
#undef RSB
#undef QKV
#undef VT
#undef Y
#undef CST
#undef Gt
#undef NST
#undef SC
#undef MST
#undef QC
#undef KVC
#undef VTC
#undef MEMN
#undef OC
#undef SIDEB
#undef ACT
#undef T5T
#undef ROPEC
#undef ROPES
#undef x_in
#undef mem
#undef t5raw
#undef out
extern "C" void kernel_launch(void* const* d_in, const int* in_sizes, int n_in, void* d_out, int out_size, void* d_ws, size_t ws_size, hipStream_t stream) {
    static int grid_blocks = 0;
    if (grid_blocks == 0) {
        int dev = 0, cus = 0, per_cu = 0;
        (void)hipGetDevice(&dev);
        (void)hipDeviceGetAttribute(&cus, hipDeviceAttributeMultiprocessorCount, dev);
        (void)hipFuncSetAttribute((const void*)fwd_megakernel, hipFuncAttributeMaxDynamicSharedMemorySize, LDS_BYTES);
        (void)hipOccupancyMaxActiveBlocksPerMultiprocessor(&per_cu, (const void*)fwd_megakernel, NTHR, LDS_BYTES);
        if (per_cu < 1) per_cu = 1;
        grid_blocks = cus * per_cu;
        if (n_in != 27 || ws_size < 1000 * MiB) fprintf(stderr, "kernel_launch: unexpected n_in %d / ws_size %zu\n", n_in, ws_size);
    }
    Args a{};
    for (int i = 0; i < 27; ++i) a.in[i] = (const float*)d_in[i];
    a.out = (float*)d_out; a.ws = (unsigned char*)d_ws;
    (void)hipMemsetAsync(d_ws, 0, 16384, stream);
    void* kargs[] = {&a};
    hipError_t e = hipLaunchCooperativeKernel((const void*)fwd_megakernel, dim3(grid_blocks), dim3(NTHR), kargs, LDS_BYTES, stream);
    if (e != hipSuccess) fprintf(stderr, "cooperative launch failed: %s (grid %d)\n", hipGetErrorString(e), grid_blocks);
}
```
